# Optimizing an MI355X kernel written in HIP

```python
import math
import jax, jax.numpy as jnp
from jax import lax
import numpy as np

D_MODEL = 1024
BATCH = 4
SEQ = 8192
DEPTH = 4

GRID_W = 64
CTX_LEN = 256
N_MIXERS = 3
N_POOL_LAYERS = len(range(0, DEPTH, N_MIXERS))
N_DIFF_LAYERS = len(range(1, DEPTH, N_MIXERS))
N_NAT_LAYERS = len(range(2, DEPTH, N_MIXERS))
D_FF = ((8 * D_MODEL // 3 + 255) // 256) * 256
N_MOD = 9
POOL_WINDOWS = (2, 4, 8, 16)
POOL_GROUPS = len(POOL_WINDOWS)
POOL_GW = D_MODEL // POOL_GROUPS
DIFF_HEADS = 8
DIFF_HD = D_MODEL // DIFF_HEADS // 2
NAT_HEADS = 16
NAT_HD = D_MODEL // NAT_HEADS
NAT_WIN_ROWS = 8
NAT_WIN_COLS = 16
ROPE_THETA = 10000.0
Q_BLOCK = 128
NORM_EPS = 1e-6

kernel_name = 'hybrid_pool_diffattn_natten_macaron_dit'


def rms_norm(x, g):
    xf = x.astype(jnp.float32)
    y = xf * lax.rsqrt(jnp.mean(xf * xf, axis=-1, keepdims=True) + NORM_EPS)
    return (y * g.astype(jnp.float32)).astype(x.dtype)


def modulate(h, shift, scale):
    return h * (1 + scale) + shift


def swiglu(h, w_in, w_out):
    g, u = jnp.split(h @ w_in, 2, axis=-1)
    return (jax.nn.silu(g) * u) @ w_out


def ffn_step(s, g, shift, scale, gate, w_in, w_out):
    return s + 0.5 * gate * swiglu(modulate(rms_norm(s, g), shift, scale), w_in, w_out)


def pool_mix(h, w, scale):
    b, n, d = h.shape
    hf = h.astype(jnp.float32)
    cs = jnp.concatenate([jnp.zeros((b, 1, d), jnp.float32), jnp.cumsum(hf, axis=1)], axis=1)
    t = jnp.arange(n)
    outs = []
    for gi, win in enumerate(POOL_WINDOWS):
        lo = jnp.clip(t - win // 2, 0, n - 1)
        hi = jnp.clip(t - win // 2 + win - 1, 0, n - 1)
        sl = slice(gi * POOL_GW, (gi + 1) * POOL_GW)
        csg = cs[:, :, sl]
        mean = (csg[:, hi + 1] - csg[:, lo]) / (hi - lo + 1).astype(jnp.float32)[None, :, None]
        outs.append(mean - hf[:, :, sl])
    diff = jnp.stack(outs, axis=2).astype(h.dtype)
    y = jnp.einsum('bngc,gce->bnge', diff, w).reshape(b, n, d)
    return y * scale


def axial_angles(n):
    t = jnp.arange(n)
    rows = (t // GRID_W).astype(jnp.float32)
    cols = (t % GRID_W).astype(jnp.float32)
    per_axis = DIFF_HD // 2
    inv = ROPE_THETA ** (-jnp.arange(0, per_axis, 2, dtype=jnp.float32) / per_axis)
    return rows[:, None] * inv, cols[:, None] * inv


def rotate(x, ang):
    m = x.shape[-1] // 2
    x1, x2 = x[..., :m], x[..., m:]
    cos, sin = jnp.cos(ang), jnp.sin(ang)
    return jnp.concatenate([x1 * cos - x2 * sin, x2 * cos + x1 * sin], axis=-1)


def rope_2d(x, row_ang, col_ang):
    shape = (1, x.shape[1]) + (1,) * (x.ndim - 3) + (row_ang.shape[-1],)
    ra, ca = row_ang.reshape(shape), col_ang.reshape(shape)
    xf = x.astype(jnp.float32)
    half = x.shape[-1] // 2
    out = jnp.concatenate([rotate(xf[..., :half], ra), rotate(xf[..., half:], ca)], axis=-1)
    return out.astype(x.dtype)


def diff_attention(h_lat, h_ctx, w_qkv, lam, subln_g, w_o, lam_init, want_ctx):
    b, n, d = h_lat.shape
    scale = DIFF_HD ** -0.5

    def proj(h):
        q, k, v = jnp.split(h @ w_qkv, 3, axis=-1)
        s = h.shape[:2]
        return (q.reshape(s + (DIFF_HEADS, 2, DIFF_HD)), k.reshape(s + (DIFF_HEADS, 2, DIFF_HD)),
                v.reshape(s + (DIFF_HEADS, 2 * DIFF_HD)))

    q_l, k_l, v_l = proj(h_lat)
    q_c, k_c, v_c = proj(h_ctx)
    ra, ca = axial_angles(n)
    q_l = rope_2d(q_l, ra, ca)
    k_l = rope_2d(k_l, ra, ca)
    lf = lam.astype(jnp.float32)
    lam_full = jnp.exp(jnp.sum(lf[0] * lf[1])) - jnp.exp(jnp.sum(lf[2] * lf[3])) + lam_init

    def attend(q, k, v):
        s = jnp.einsum('bqhjd,bkhjd->bhjqk', q, k).astype(jnp.float32) * scale
        p = jax.nn.softmax(s, axis=-1)
        a = p[:, :, 0] - lam_full * p[:, :, 1]
        return jnp.einsum('bhqk,bkhe->bqhe', a.astype(v.dtype), v)

    k_all = jnp.concatenate([k_l, k_c], axis=1)
    v_all = jnp.concatenate([v_l, v_c], axis=1)
    nb = n // Q_BLOCK
    q_blocks = jnp.moveaxis(q_l.reshape(b, nb, Q_BLOCK, DIFF_HEADS, 2, DIFF_HD), 1, 0)
    o_l = lax.map(lambda qb: attend(qb, k_all, v_all), q_blocks)
    o_l = jnp.moveaxis(o_l, 0, 1).reshape(b, n, DIFF_HEADS, 2 * DIFF_HD)

    def finish(o):
        o = rms_norm(o, subln_g) * (1 - lam_init)
        return o.reshape(o.shape[:2] + (d,)) @ w_o

    out_l = finish(o_l)
    out_c = finish(attend(q_c, k_c, v_c)) if want_ctx else None
    return out_l, out_c


def neighbourhood_attention(h_lat, h_ctx, w_qkv, b_qkv, rpb, w_o, b_o, want_ctx):
    b, n, d = h_lat.shape
    n_rows = n // GRID_W
    wr = min(NAT_WIN_ROWS, n_rows)
    wc = min(NAT_WIN_COLS, GRID_W)
    scale = NAT_HD ** -0.5

    def proj(h):
        q, k, v = jnp.split(h @ w_qkv + b_qkv, 3, axis=-1)
        s = h.shape[:2] + (NAT_HEADS, NAT_HD)
        return q.reshape(s) * scale, k.reshape(s), v.reshape(s)

    q_l, k_l, v_l = proj(h_lat)
    q_c, k_c, v_c = proj(h_ctx)
    gshape = (b, n_rows, GRID_W, NAT_HEADS, NAT_HD)
    k_g = k_l.reshape(gshape)
    v_g = v_l.reshape(gshape)
    q_rows = jnp.moveaxis(q_l.reshape(gshape), 1, 0)
    qcol = jnp.arange(GRID_W)
    col_start = jnp.clip(qcol - wc // 2, 0, GRID_W - wc)
    col_idx = col_start[:, None] + jnp.arange(wc)[None, :]
    col_off = col_idx - qcol[:, None] + (NAT_WIN_COLS - 1)

    def row_block(args):
        r, q = args
        rs = jnp.clip(r - wr // 2, 0, n_rows - wr)
        k_band = lax.dynamic_slice_in_dim(k_g, rs, wr, axis=1)
        v_band = lax.dynamic_slice_in_dim(v_g, rs, wr, axis=1)
        k_win = k_band[:, :, col_idx]
        v_win = v_band[:, :, col_idx]
        row_off = rs + jnp.arange(wr) - r + (NAT_WIN_ROWS - 1)
        bias = rpb[:, row_off[:, None, None], col_off[None, :, :]]
        bias = jnp.transpose(bias, (0, 2, 1, 3)).astype(jnp.float32)
        s_win = jnp.einsum('bqhd,bwqchd->bhqwc', q, k_win).astype(jnp.float32) + bias[None]
        s_ctx = jnp.einsum('bqhd,bkhd->bhqk', q, k_c).astype(jnp.float32)
        s = jnp.concatenate([s_win.reshape(b, NAT_HEADS, GRID_W, wr * wc), s_ctx], axis=-1)
        p = jax.nn.softmax(s, axis=-1).astype(v_win.dtype)
        p_win = p[..., :wr * wc].reshape(b, NAT_HEADS, GRID_W, wr, wc)
        p_ctx = p[..., wr * wc:]
        return (jnp.einsum('bhqwc,bwqchd->bqhd', p_win, v_win)
                + jnp.einsum('bhqk,bkhd->bqhd', p_ctx, v_c))

    o = lax.map(row_block, (jnp.arange(n_rows), q_rows))
    out_l = jnp.moveaxis(o, 0, 1).reshape(b, n, d) @ w_o + b_o
    out_c = None
    if want_ctx:
        s = jnp.einsum('bqhd,bkhd->bhqk', q_c, k_c).astype(jnp.float32)
        p = jax.nn.softmax(s, axis=-1).astype(v_c.dtype)
        o_c = jnp.einsum('bhqk,bkhd->bqhd', p, v_c)
        out_c = o_c.reshape(o_c.shape[0], o_c.shape[1], d) @ w_o + b_o
    return out_l, out_c


def setup_inputs(seed: int = 0) -> dict:
    key = jax.random.key(seed)
    ks = jax.random.split(key, 24)
    D = D_MODEL

    def nrm(k, shape, std):
        return jax.random.normal(k, shape, jnp.float32) * std

    return {
        'x': nrm(ks[0], (BATCH, SEQ, D), 1.0),
        'c': nrm(ks[1], (BATCH, D), 1.0),
        'ctx': nrm(ks[2], (BATCH, CTX_LEN, D), 1.0),
        'c_ctx': nrm(ks[3], (D,), 1.0),
        'ada_w': nrm(ks[4], (DEPTH, D, N_MOD * D), 0.5 * D ** -0.5),
        'ada_b': nrm(ks[5], (DEPTH, N_MOD * D), 0.01),
        'norm_g': 1.0 + nrm(ks[6], (DEPTH, 3, D), 0.1),
        'ffn_w_in': nrm(ks[7], (DEPTH, 2, D, 2 * D_FF), D ** -0.5),
        'ffn_w_out': nrm(ks[8], (DEPTH, 2, D_FF, D), D_FF ** -0.5),
        'pool_w': nrm(ks[9], (N_POOL_LAYERS, POOL_GROUPS, POOL_GW, POOL_GW), POOL_GW ** -0.5),
        'pool_scale': 1.0 + nrm(ks[10], (N_POOL_LAYERS, D), 0.1),
        'diff_w_qkv': nrm(ks[11], (N_DIFF_LAYERS, D, 3 * D), D ** -0.5),
        'diff_lam': nrm(ks[12], (N_DIFF_LAYERS, 4, DIFF_HD), 0.1),
        'diff_subln_g': 1.0 + nrm(ks[13], (N_DIFF_LAYERS, 2 * DIFF_HD), 0.1),
        'diff_w_o': nrm(ks[14], (N_DIFF_LAYERS, D, D), D ** -0.5),
        'nat_w_qkv': nrm(ks[15], (N_NAT_LAYERS, D, 3 * D), D ** -0.5),
        'nat_b_qkv': nrm(ks[16], (N_NAT_LAYERS, 3 * D), 0.01),
        'nat_rpb': nrm(ks[17], (N_NAT_LAYERS, NAT_HEADS, 2 * NAT_WIN_ROWS - 1, 2 * NAT_WIN_COLS - 1), 0.1),
        'nat_w_o': nrm(ks[18], (N_NAT_LAYERS, D, D), D ** -0.5),
        'nat_b_o': nrm(ks[19], (N_NAT_LAYERS, D), 0.01),
        'final_g': 1.0 + nrm(ks[20], (D,), 0.1),
    }


def reference(x, c, ctx, c_ctx, ada_w, ada_b, norm_g, ffn_w_in, ffn_w_out, pool_w, pool_scale,
              diff_w_qkv, diff_lam, diff_subln_g, diff_w_o, nat_w_qkv, nat_b_qkv, nat_rpb,
              nat_w_o, nat_b_o, final_g):
    xc = ctx
    s_c = jax.nn.silu(c)
    s_cc = jax.nn.silu(c_ctx)
    for i in range(DEPTH):
        kind = i % N_MIXERS
        j = i // N_MIXERS
        last = i == DEPTH - 1
        update_ctx = not last
        ctx_needed = update_ctx or kind != 0
        mx = jnp.split((s_c @ ada_w[i] + ada_b[i])[:, None, :], N_MOD, axis=-1)
        mc = jnp.split((s_cc @ ada_w[i] + ada_b[i])[None, None, :], N_MOD, axis=-1)
        x = ffn_step(x, norm_g[i, 0], mx[0], mx[1], mx[2], ffn_w_in[i, 0], ffn_w_out[i, 0])
        if ctx_needed:
            xc = ffn_step(xc, norm_g[i, 0], mc[0], mc[1], mc[2], ffn_w_in[i, 0], ffn_w_out[i, 0])
        hx = modulate(rms_norm(x, norm_g[i, 1]), mx[3], mx[4])
        hc = modulate(rms_norm(xc, norm_g[i, 1]), mc[3], mc[4]) if ctx_needed else None
        if kind == 0:
            ox = pool_mix(hx, pool_w[j], pool_scale[j])
            oc = pool_mix(hc, pool_w[j], pool_scale[j]) if update_ctx else None
        elif kind == 1:
            lam_init = 0.8 - 0.6 * math.exp(-0.3 * i)
            ox, oc = diff_attention(hx, hc, diff_w_qkv[j], diff_lam[j], diff_subln_g[j], diff_w_o[j],
                                    lam_init, update_ctx)
        else:
            ox, oc = neighbourhood_attention(hx, hc, nat_w_qkv[j], nat_b_qkv[j], nat_rpb[j],
                                             nat_w_o[j], nat_b_o[j], update_ctx)
        x = x + mx[5] * ox
        if update_ctx:
            xc = xc + mc[5] * oc
        x = ffn_step(x, norm_g[i, 2], mx[6], mx[7], mx[8], ffn_w_in[i, 1], ffn_w_out[i, 1])
        if update_ctx:
            xc = ffn_step(xc, norm_g[i, 2], mc[6], mc[7], mc[8], ffn_w_in[i, 1], ffn_w_out[i, 1])
    return rms_norm(x, final_g)
```

```cpp
#include <hip/hip_runtime.h>
#include <hip/hip_cooperative_groups.h>
#include <cstdio>
#include <cstdint>
namespace cg = cooperative_groups;

#define LAS __attribute__((address_space(3)))
typedef unsigned short bf16_t;
typedef short bf16x8 __attribute__((ext_vector_type(8)));
typedef short s16x4 __attribute__((ext_vector_type(4)));
typedef float f32x2 __attribute__((ext_vector_type(2)));
typedef float f32x4 __attribute__((ext_vector_type(4)));
typedef float f32x16 __attribute__((ext_vector_type(16)));
typedef unsigned u32x2 __attribute__((ext_vector_type(2)));
typedef _Float16 h16_t;
typedef _Float16 f16x4 __attribute__((ext_vector_type(4)));
typedef _Float16 f16x8 __attribute__((ext_vector_type(8)));
typedef float f32x8 __attribute__((ext_vector_type(8)));
typedef unsigned u32x4 __attribute__((ext_vector_type(4)));

constexpr int DM = 1024, NB = 4, SEQ = 8192, CTXL = 256, DFF = 2816, NMODV = 9 * 1024;
constexpr int TL = NB * SEQ, TC = NB * CTXL, TA = TL + TC;
constexpr float NORM_EPS = 1e-6f;
constexpr float LOG2E = 1.4426950408889634f;
constexpr float QSCALE = 0.125f * LOG2E;
constexpr float NEG_BIG = -1e30f;

constexpr size_t MiB = 1u << 20;
constexpr size_t WS_MOD = 1 * MiB;
constexpr size_t WS_ROPE = 2 * MiB;
constexpr size_t WS_CONST = 3 * MiB;
constexpr size_t WS_WIN = 4 * MiB;
constexpr size_t WS_WOUT = 92 * MiB;
constexpr size_t WS_WQKV = 136 * MiB;
constexpr size_t WS_WO = 148 * MiB;
constexpr size_t WS_WPOOL = 152 * MiB;
constexpr size_t WS_X = 154 * MiB;
constexpr size_t WS_H = 286 * MiB;
constexpr size_t WS_BIG = 352 * MiB;
constexpr size_t WS_PART = 550 * MiB;
constexpr size_t WS_END = 596 * MiB;
constexpr size_t QKV_STRIDE = 66 * MiB;

#ifndef REP_DIFF
#define REP_DIFF 1
#endif
#ifndef REP_NAT
#define REP_NAT 1
#endif
#ifndef REP_NORM
#define REP_NORM 1
#endif
#ifndef REP_G1
#define REP_G1 1
#endif
constexpr int LDS_BYTES = 147456;

typedef __bf16 bf16x2_t __attribute__((ext_vector_type(2)));
__device__ __forceinline__ unsigned cvt_pk_bf16(float lo, float hi) { f32x2 v = {lo, hi}; bf16x2_t b = __builtin_convertvector(v, bf16x2_t); return __builtin_bit_cast(unsigned, b); }
__device__ __forceinline__ float bf2f(unsigned short b) { return __uint_as_float(((unsigned)b) << 16); }
__device__ __forceinline__ float dpp_f(float v, int ctrl_sel) {
    const int x = __float_as_int(v); int r;
    if (ctrl_sel == 0) r = __builtin_amdgcn_update_dpp(x, x, 0xB1, 0xF, 0xF, false);
    else if (ctrl_sel == 1) r = __builtin_amdgcn_update_dpp(x, x, 0x4E, 0xF, 0xF, false);
    else if (ctrl_sel == 2) r = __builtin_amdgcn_update_dpp(x, x, 0x141, 0xF, 0xF, false);
    else r = __builtin_amdgcn_update_dpp(x, x, 0x140, 0xF, 0xF, false);
    return __int_as_float(r);
}
__device__ __forceinline__ float wave_sum(float v) {
    v += dpp_f(v, 0); v += dpp_f(v, 1); v += dpp_f(v, 2); v += dpp_f(v, 3);
    { auto rr = __builtin_amdgcn_permlane16_swap(__float_as_uint(v), __float_as_uint(v), false, false); v = __uint_as_float(rr[0]) + __uint_as_float(rr[1]); }
    { auto rr = __builtin_amdgcn_permlane32_swap(__float_as_uint(v), __float_as_uint(v), false, false); v = __uint_as_float(rr[0]) + __uint_as_float(rr[1]); }
    return v;
}
__device__ __forceinline__ int opaque_tid(int wave_s) { int l; asm volatile("v_mbcnt_lo_u32_b32 %0, -1, 0\n\tv_mbcnt_hi_u32_b32 %0, -1, %0" : "=v"(l)); return wave_s * 64 + l; }
__device__ __forceinline__ float silu_f(float v) { return v / (1.0f + __expf(-v)); }
__device__ __forceinline__ float fast_silu(float v) { return v * __builtin_amdgcn_rcpf(1.0f + __builtin_amdgcn_exp2f(-v * LOG2E)); }

namespace pg8 {
constexpr int BM = 256, BK = 64, HALF = 128, HTB = HALF * BK * 2, STAGE_BYTES = 8 * HTB, NXCD = 8, WGM = 8;
__device__ __forceinline__ int lds_byte(int r, int c) { const int st = (r >> 4) * 2 + (c >> 5), rr = r & 15, cc = c & 31, ob = rr * 64 + cc * 2; return st * 1024 + (ob ^ (((ob >> 9) & 1) << 5)); }
__device__ __forceinline__ void stage_rc(int b, int& R, int& C) { const int st = b / 1024, sb = b % 1024, swz = sb ^ (((sb >> 9) & 1) << 5); R = (st >> 1) * 16 + swz / 64; C = (st & 1) * 32 + (swz % 64) / 2; }
__device__ __forceinline__ int perm32(int rho) { const int n = rho >> 4, i = rho & 15; return 8 * (i >> 2) + 4 * n + (i & 3); }

struct Unit { int pm, pn; };
struct Gemm { const bf16_t* A; const bf16_t* Bt; int lda, ldb, K; int a_pn_off; };

struct StaticOrder {
    int nM, nN, nwg, G, c, pm0;
    __device__ void init(int M, int N, int G_, int c_, int pm0_ = 0) { nM = M / BM; nN = N / BM; nwg = nM * nN; G = G_; c = c_; pm0 = pm0_; }
    __device__ bool next(int i, Unit& u) const {
        const long L = (long)i * G + c; if (L >= nwg) return false;
        int wgid = (int)L; { const int q = nwg / NXCD, r = nwg % NXCD, xcd = wgid % NXCD, off = wgid / NXCD; wgid = (xcd < r ? xcd * (q + 1) : r * (q + 1) + (xcd - r) * q) + off; }
        const int nig = WGM * nN, gid = wgid / nig, fm = gid * WGM, gsz = (nM - fm) < WGM ? (nM - fm) : WGM;
        u.pm = pm0 + fm + ((wgid % nig) % gsz); u.pn = (wgid % nig) / gsz; return true;
    }
};

template <class Epi, int KSD = 0, int KSO = 0>
__device__ __forceinline__ void gemm_phase(LAS unsigned char* lds, int wave_s, const Gemm g, const StaticOrder& S, const Epi& E) {
    const int tid = opaque_tid(wave_s), wid = __builtin_amdgcn_readfirstlane(tid >> 6), lane = tid & 63, wr = wid >> 2, wc = wid & 3, fr = lane & 15, fq = lane >> 4;
    const int K = g.K, nt = K / BK;
    unsigned voffA[2], voffB[2];
#pragma unroll
    for (int i = 0; i < 2; ++i) { int R, C; stage_rc(tid * 16 + i * 8192, R, C); const int Rb = Epi::PERM ? ((R & ~31) + perm32(R & 31)) : R;
        voffA[i] = (unsigned)(R * g.lda + C) * 2u; voffB[i] = (unsigned)(Rb * g.ldb + C) * 2u; }
    const size_t kstep = (size_t)(BK * 2);
    const size_t hstepA = (size_t)HALF * g.lda * 2, hstepB = (size_t)HALF * g.ldb * 2;
    const size_t tstepA = 2 * hstepA, tstepB = 2 * hstepB;
    const unsigned ldsw = (unsigned)wid * 1024u;
    const int aoff = lds_byte(wr * 64 + fr, fq * 8), boff = lds_byte(wc * 32 + fr, fq * 8);
#define PG8_SA(b, h) (((b) * 2 + (h)) * HTB)
#define PG8_SB(b, h) ((4 + (b) * 2 + (h)) * HTB)
#define PG8_STAGE(bufoff, gbase, voff) do { _Pragma("unroll") for (int _i = 0; _i < 2; ++_i) \
        __builtin_amdgcn_global_load_lds((const unsigned*)((const char*)(gbase) + (voff)[_i]), (LAS unsigned*)(lds + (bufoff) + ldsw + _i * 8192), 16, 0, 0); } while (0)
#define PG8_LDA(dst, b, h) do { _Pragma("unroll") for (int m = 0; m < 4; ++m) _Pragma("unroll") for (int k = 0; k < 2; ++k) dst[m][k] = *(const LAS bf16x8*)(lds + PG8_SA(b, h) + aoff + m * 2048 + k * 1024); } while (0)
#define PG8_LDB(dst, b, h) do { _Pragma("unroll") for (int n = 0; n < 2; ++n) _Pragma("unroll") for (int k = 0; k < 2; ++k) dst[n][k] = *(const LAS bf16x8*)(lds + PG8_SB(b, h) + boff + n * 2048 + k * 1024); } while (0)
#define PG8_MMA(ai, bj, At, Bt) do { __builtin_amdgcn_s_setprio(1); _Pragma("unroll") for (int m = 0; m < 4; ++m) _Pragma("unroll") for (int n = 0; n < 2; ++n) _Pragma("unroll") for (int k = 0; k < 2; ++k) \
        acc[ai][bj][m][n] = __builtin_amdgcn_mfma_f32_16x16x32_bf16(Bt[n][k], At[m][k], acc[ai][bj][m][n], 0, 0, 0); __builtin_amdgcn_s_setprio(0); } while (0)
#define PG8_WAIT_V(n) asm volatile("s_waitcnt vmcnt(" #n ")" ::: "memory")
#define PG8_WAIT_L(n) asm volatile("s_waitcnt lgkmcnt(" #n ")" ::: "memory")
#define PG8_BAR __builtin_amdgcn_s_barrier()
#define PG8_SCHED __builtin_amdgcn_sched_barrier(0)
    Unit cur, nxt; int ui = 0;
    if (!S.next(0, cur)) return;
    f32x4 acc[2][2][4][2];
#pragma unroll
    for (int a = 0; a < 2; ++a)
#pragma unroll
        for (int b = 0; b < 2; ++b)
#pragma unroll
            for (int m = 0; m < 4; ++m)
#pragma unroll
                for (int n = 0; n < 2; ++n) acc[a][b][m][n] = (f32x4){0.f, 0.f, 0.f, 0.f};
    bf16x8 At[4][2], B0[2][2], B1[2][2];
    const char* cA; const char* cB;
    if constexpr (KSD == 0) { cA = (const char*)g.A + (size_t)cur.pm * tstepA + (size_t)cur.pn * g.a_pn_off; cB = (const char*)g.Bt + (size_t)cur.pn * tstepB; }
    else { cA = (const char*)g.A + (size_t)cur.pm * tstepA + (size_t)(cur.pn / KSD) * KSO; cB = (const char*)g.Bt + (size_t)(cur.pn % KSD) * tstepB + (size_t)(cur.pn / KSD) * KSO; }
    PG8_STAGE(PG8_SB(0, 0), cB, voffB); PG8_STAGE(PG8_SB(0, 1), cB + hstepB, voffB); PG8_STAGE(PG8_SA(0, 0), cA, voffA); PG8_STAGE(PG8_SA(0, 1), cA + hstepA, voffA);
    if (wr == 1) PG8_BAR;
    PG8_WAIT_V(2); PG8_BAR;
    PG8_STAGE(PG8_SB(1, 0), cB + kstep, voffB); PG8_STAGE(PG8_SA(1, 0), cA + kstep, voffA); PG8_STAGE(PG8_SB(1, 1), cB + hstepB + kstep, voffB);
    PG8_WAIT_V(6); PG8_BAR;
    for (;;) {
        const bool has_next = S.next(ui + 1, nxt);
        const char* nA = cA; const char* nB = cB;
        if (has_next) {
            if constexpr (KSD == 0) { nA = (const char*)g.A + (size_t)nxt.pm * tstepA + (size_t)nxt.pn * g.a_pn_off; nB = (const char*)g.Bt + (size_t)nxt.pn * tstepB; }
            else { nA = (const char*)g.A + (size_t)nxt.pm * tstepA + (size_t)(nxt.pn / KSD) * KSO; nB = (const char*)g.Bt + (size_t)(nxt.pn % KSD) * tstepB + (size_t)(nxt.pn / KSD) * KSO; } }
        for (int t = 0; t < nt; t += 2) {
            const bool last = (t == nt - 2);
            const char* a1 = cA + (size_t)(t + 1) * kstep;
            const char* a2 = last ? nA : cA + (size_t)(t + 2) * kstep; const char* b2 = last ? nB : cB + (size_t)(t + 2) * kstep;
            const char* a3 = a2 + kstep; const char* b3 = b2 + kstep;
            PG8_LDB(B0, 0, 0); PG8_LDB(B1, 0, 1); PG8_SCHED; PG8_LDA(At, 0, 0); PG8_STAGE(PG8_SA(1, 1), a1 + hstepA, voffA);
            PG8_WAIT_V(8); PG8_WAIT_L(0); PG8_BAR; PG8_MMA(0, 0, At, B0); PG8_MMA(0, 1, At, B1); PG8_BAR; PG8_SCHED;
            PG8_LDA(At, 0, 1); PG8_STAGE(PG8_SB(0, 0), b2, voffB); PG8_STAGE(PG8_SB(0, 1), b2 + hstepB, voffB); PG8_STAGE(PG8_SA(0, 0), a2, voffA);
            PG8_WAIT_V(8); PG8_WAIT_L(0); PG8_BAR; PG8_MMA(1, 0, At, B0); PG8_MMA(1, 1, At, B1); PG8_BAR; PG8_SCHED;
            PG8_LDB(B0, 1, 0); PG8_LDB(B1, 1, 1); PG8_SCHED; PG8_LDA(At, 1, 0); PG8_STAGE(PG8_SA(0, 1), a2 + hstepA, voffA);
            PG8_WAIT_V(8); PG8_WAIT_L(0); PG8_BAR; PG8_MMA(0, 0, At, B0); PG8_MMA(0, 1, At, B1); PG8_BAR; PG8_SCHED;
            PG8_LDA(At, 1, 1); PG8_STAGE(PG8_SB(1, 0), b3, voffB); PG8_STAGE(PG8_SB(1, 1), b3 + hstepB, voffB); PG8_STAGE(PG8_SA(1, 0), a3, voffA);
            PG8_WAIT_V(8); PG8_WAIT_L(0); PG8_BAR; PG8_MMA(1, 0, At, B0); PG8_MMA(1, 1, At, B1); PG8_BAR; PG8_SCHED;
        }
        if (wr == 0) PG8_BAR;
        { const int l2_ = opaque_tid(wave_s) & 63; E(acc, cur, wr, wc, l2_ & 15, l2_ >> 4); }
        if (!has_next) break;
#pragma unroll
        for (int a = 0; a < 2; ++a)
#pragma unroll
            for (int b = 0; b < 2; ++b)
#pragma unroll
                for (int m = 0; m < 4; ++m)
#pragma unroll
                    for (int n = 0; n < 2; ++n) acc[a][b][m][n] = (f32x4){0.f, 0.f, 0.f, 0.f};
        cur = nxt; cA = nA; cB = nB; ++ui;
        if (wr == 1) PG8_BAR;
    }
    PG8_WAIT_V(0);
    PG8_BAR;
#undef PG8_SA
#undef PG8_SB
#undef PG8_STAGE
#undef PG8_LDA
#undef PG8_LDB
#undef PG8_MMA
#undef PG8_WAIT_V
#undef PG8_WAIT_L
#undef PG8_BAR
#undef PG8_SCHED
}

struct EpiSwiglu {
    static constexpr bool PERM = true;
    bf16_t* O; int ldc;
    static __device__ __forceinline__ float hs(float g, float u) { return g * u * __builtin_amdgcn_rcpf(1.0f + __builtin_amdgcn_exp2f(-g)); }
    __device__ __forceinline__ void operator()(const f32x4 (&acc)[2][2][4][2], const Unit& u, int wr, int wc, int fr, int fq) const {
        const int row0 = u.pm * BM + wr * 64 + fr, col0 = u.pn * 128 + wc * 32 + 8 * fq;
#pragma unroll
        for (int ai = 0; ai < 2; ++ai)
#pragma unroll
            for (int m = 0; m < 4; ++m) {
                bf16_t* rowp = O + (size_t)(row0 + ai * HALF + m * 16) * ldc + col0;
                const f32x4 g0 = acc[ai][0][m][0], g1 = acc[ai][0][m][1], u0 = acc[ai][1][m][0], u1 = acc[ai][1][m][1];
                u32x4 w;
                w.x = cvt_pk_bf16(hs(g0[0], u0[0]), hs(g0[1], u0[1]));
                w.y = cvt_pk_bf16(hs(g0[2], u0[2]), hs(g0[3], u0[3]));
                w.z = cvt_pk_bf16(hs(g1[0], u1[0]), hs(g1[1], u1[1]));
                w.w = cvt_pk_bf16(hs(g1[2], u1[2]), hs(g1[3], u1[3]));
                *(u32x4*)rowp = w;
            }
    }
};
struct EpiResid {
    static constexpr bool PERM = true;
    h16_t* X; const float* gate_base; const float* bias; const float* cscale;
    __device__ __forceinline__ void operator()(const f32x4 (&acc)[2][2][4][2], const Unit& u, int wr, int wc, int fr, int fq) const {
        const int midx = u.pm < 128 ? (u.pm >> 5) : 4;
        const float* gate = gate_base + midx * NMODV;
        asm volatile("" : "+v"(fr), "+v"(fq));
        const int col0 = u.pn * BM + wc * 32 + 8 * fq;
#pragma unroll
        for (int bj = 0; bj < 2; ++bj) {
            const int c = col0 + bj * HALF;
            const f32x4 g0 = *(const f32x4*)(gate + c) * *(const f32x4*)(cscale + c), g1 = *(const f32x4*)(gate + c + 4) * *(const f32x4*)(cscale + c + 4);
            const f32x4 b0 = *(const f32x4*)(bias + c), b1 = *(const f32x4*)(bias + c + 4);
#pragma unroll
            for (int ai = 0; ai < 2; ++ai) {
                h16_t* p0 = X + (size_t)(u.pm * BM + ai * HALF + wr * 64 + fr) * DM + c;
                f16x8 xv[4];
#pragma unroll
                for (int m = 0; m < 4; ++m) xv[m] = *(const f16x8*)(p0 + (size_t)m * 16 * DM);
                asm volatile("" ::: "memory");
#pragma unroll
                for (int m = 0; m < 4; ++m) {
                    const f32x8 xf = __builtin_convertvector(xv[m], f32x8);
                    const f32x4 lo = (f32x4){xf[0], xf[1], xf[2], xf[3]} + g0 * (acc[ai][bj][m][0] + b0);
                    const f32x4 hh = (f32x4){xf[4], xf[5], xf[6], xf[7]} + g1 * (acc[ai][bj][m][1] + b1);
                    const f32x8 o = (f32x8){lo[0], lo[1], lo[2], lo[3], hh[0], hh[1], hh[2], hh[3]};
                    *(f16x8*)(p0 + (size_t)m * 16 * DM) = __builtin_convertvector(o, f16x8);
                }
                asm volatile("" ::: "memory");
            }
        }
    }
};
struct EpiQK {
    static constexpr bool PERM = false;
    bf16_t* Q; bf16_t* Kb; const float* rope; const float* bias; int mode;
    __device__ __forceinline__ void operator()(const f32x4 (&acc)[2][2][4][2], const Unit& u, int wr, int wc, int fr, int fq) const {
        const bool isq = u.pn < 4;
        bf16_t* base = isq ? Q : Kb;
        const float sc = isq ? QSCALE : 1.0f;
        const int colt = (u.pn & 3) * BM + wc * 32 + 4 * fq;
        const bool dorope = (mode == 0) && (u.pm < 128);
#pragma unroll
        for (int ai = 0; ai < 2; ++ai)
#pragma unroll
            for (int m = 0; m < 4; ++m) {
                const int row = u.pm * BM + ai * HALF + wr * 64 + m * 16 + fr;
                f32x4 cv = (f32x4){1.f, 1.f, 1.f, 1.f}, sv = (f32x4){0.f, 0.f, 0.f, 0.f};
                if (dorope) {
                    const int t = row & (SEQ - 1); const int pos = (wc & 1) ? (t & 63) : (t >> 6);
                    const f32x4 t0 = *(const f32x4*)(rope + (pos * 16 + 4 * fq) * 2), t1 = *(const f32x4*)(rope + (pos * 16 + 4 * fq) * 2 + 4);
                    cv = (f32x4){t0[0], t0[2], t1[0], t1[2]}; sv = (f32x4){t0[1], t0[3], t1[1], t1[3]};
                }
#pragma unroll
                for (int bj = 0; bj < 2; ++bj) {
                    const int bc = u.pn * BM + bj * HALF + wc * 32 + 4 * fq;
                    const f32x4 x1 = acc[ai][bj][m][0] + *(const f32x4*)(bias + bc), x2 = acc[ai][bj][m][1] + *(const f32x4*)(bias + bc + 16);
                    const f32x4 o1 = (x1 * cv - x2 * sv) * sc, o2 = (x2 * cv + x1 * sv) * sc;
                    bf16_t* p = base + (size_t)row * DM + colt + bj * HALF;
                    u32x2 w1, w2; w1.x = cvt_pk_bf16(o1[0], o1[1]); w1.y = cvt_pk_bf16(o1[2], o1[3]); w2.x = cvt_pk_bf16(o2[0], o2[1]); w2.y = cvt_pk_bf16(o2[2], o2[3]);
                    *(u32x2*)p = w1; *(u32x2*)(p + 16) = w2;
                }
                asm volatile("" ::: "memory");
            }
    }
};
struct EpiPartial {
    static constexpr bool PERM = false;
    float* O; int ldc;
    __device__ __forceinline__ void operator()(const f32x4 (&acc)[2][2][4][2], const Unit& u, int wr, int wc, int fr, int fq) const {
        asm volatile("" : "+v"(fr), "+v"(fq));
        const unsigned base = (unsigned)(((u.pm - 128) * BM + wr * 64 + fr) * ldc + u.pn * BM + wc * 32 + 4 * fq) * 4u;
#pragma unroll
        for (int ai = 0; ai < 2; ++ai)
#pragma unroll
            for (int m = 0; m < 4; ++m) {
                char* rp = (char*)O + (base + (unsigned)((ai * HALF + m * 16) * ldc) * 4u);
#pragma unroll
                for (int bj = 0; bj < 2; ++bj)
#pragma unroll
                    for (int n = 0; n < 2; ++n) *(f32x4*)(rp + (bj * HALF + n * 16) * 4) = acc[ai][bj][m][n];
                asm volatile("" ::: "memory");
            }
    }
};
struct EpiVt {
    static constexpr bool PERM = true;
    bf16_t* O; int ldc; const float* rbias;
    __device__ __forceinline__ void operator()(const f32x4 (&acc)[2][2][4][2], const Unit& u, int wr, int wc, int fr, int fq) const {
        const int row0 = u.pm * BM + wr * 64 + fr, col0 = u.pn * BM + wc * 32 + 8 * fq;
#pragma unroll
        for (int ai = 0; ai < 2; ++ai)
#pragma unroll
            for (int m = 0; m < 4; ++m) {
                const int row = row0 + ai * HALF + m * 16;
                const float b = rbias[row];
                bf16_t* rowp = O + (size_t)row * ldc + col0;
#pragma unroll
                for (int bj = 0; bj < 2; ++bj) {
                    const f32x4 v0 = acc[ai][bj][m][0] + b, v1 = acc[ai][bj][m][1] + b;
                    u32x4 w; w.x = cvt_pk_bf16(v0[0], v0[1]); w.y = cvt_pk_bf16(v0[2], v0[3]); w.z = cvt_pk_bf16(v1[0], v1[1]); w.w = cvt_pk_bf16(v1[2], v1[3]);
                    *(u32x4*)(rowp + bj * HALF) = w;
                }
            }
    }
};
}

struct Args { const float* in[21]; float* out; unsigned char* ws; };

struct Ctx {
    LAS unsigned char* lds;
    int tid, lane, wave, G, bid, wave_s;
    __device__ __forceinline__ void refresh() { tid = opaque_tid(wave_s); lane = tid & 63; wave = __builtin_amdgcn_readfirstlane(tid >> 6); }
};

__device__ __forceinline__ void transpose_item(const float* W, int ldw, int k0, int n0, bf16_t* WT, int ldt, int dst_row0, LAS float* scr, int lane, float wscale = 1.0f) {
#pragma unroll 8
    for (int i = 0; i < 32; ++i) { const int kk = 2 * i + (lane >> 5); scr[kk * 33 + (lane & 31)] = W[(size_t)(k0 + kk) * ldw + n0 + (lane & 31)] * wscale; }
    asm volatile("s_waitcnt lgkmcnt(0)" ::: "memory");
    const int c = lane & 7;
#pragma unroll
    for (int j = 0; j < 4; ++j) { const int n = (lane >> 3) + 8 * j; const LAS float* s = scr + (8 * c) * 33 + n;
        u32x4 o; o.x = cvt_pk_bf16(s[0 * 33], s[1 * 33]); o.y = cvt_pk_bf16(s[2 * 33], s[3 * 33]); o.z = cvt_pk_bf16(s[4 * 33], s[5 * 33]); o.w = cvt_pk_bf16(s[6 * 33], s[7 * 33]);
        *(u32x4*)(WT + (size_t)(dst_row0 + n) * ldt + k0 + 8 * c) = o; }
    asm volatile("s_waitcnt lgkmcnt(0)" ::: "memory");
}

__device__ __forceinline__ void prologue_phase(const Ctx& F0, const Args& a) {
    Ctx F = F0; F.refresh();
    unsigned char* ws = a.ws;
    {
        LAS float* sv = (LAS float*)F.lds;
        LAS float* red = (LAS float*)(F.lds + 20480);
        for (int i = F.tid; i < 5 * 1024; i += 512) { const int m = i >> 10, k = i & 1023; const float v = m < 4 ? a.in[1][m * 1024 + k] : a.in[3][k]; sv[i] = silu_f(v); }
        __syncthreads();
        float* mod = (float*)(ws + WS_MOD);
        for (int u = F.bid; u < 4 * 72; u += F.G) {
            const int layer = u / 72, col0 = (u % 72) * 128;
            const float* W = a.in[4] + (size_t)layer * 1024 * NMODV + col0 + 2 * F.lane;
            float acc[5][2];
#pragma unroll
            for (int m = 0; m < 5; ++m) { acc[m][0] = 0.f; acc[m][1] = 0.f; }
            const int kb = F.wave * 128;
#pragma unroll 4
            for (int k = 0; k < 128; ++k) {
                const f32x2 w = *(const f32x2*)(W + (size_t)(kb + k) * NMODV);
#pragma unroll
                for (int m = 0; m < 5; ++m) { const float s = sv[m * 1024 + kb + k]; acc[m][0] += s * w.x; acc[m][1] += s * w.y; }
            }
#pragma unroll
            for (int m = 0; m < 5; ++m) { red[(F.wave * 5 + m) * 128 + 2 * F.lane] = acc[m][0]; red[(F.wave * 5 + m) * 128 + 2 * F.lane + 1] = acc[m][1]; }
            __syncthreads();
            for (int i = F.tid; i < 640; i += 512) { const int m = i >> 7, cc = i & 127; float s = a.in[5][layer * NMODV + col0 + cc];
#pragma unroll
                for (int w = 0; w < 8; ++w) s += red[(w * 5 + m) * 128 + cc];
                mod[((size_t)layer * 5 + m) * NMODV + col0 + cc] = s; }
            __syncthreads();
        }
    }
    {
        h16_t* X = (h16_t*)(ws + WS_X);
        const size_t n8 = (size_t)TA * DM / 8, nl8 = (size_t)TL * DM / 8;
        for (size_t i = (size_t)F.bid * 512 + F.tid; i < n8; i += (size_t)F.G * 512) {
            const float* sp = i < nl8 ? a.in[0] + i * 8 : a.in[2] + (i - nl8) * 8;
            const f32x4 p = *(const f32x4*)sp, q = *(const f32x4*)(sp + 4);
            const f32x8 o = (f32x8){p[0], p[1], p[2], p[3], q[0], q[1], q[2], q[3]};
            *(f16x8*)(X + i * 8) = __builtin_convertvector(o, f16x8);
        }
    }
    if (F.bid == 0) { float* cz = (float*)(ws + WS_CONST); for (int i = F.tid; i < 5120; i += 512) cz[i] = i < 3072 ? 0.f : (i < 4096 ? 1.f : 0.5f); }
    {
        float* rope = (float*)(ws + WS_ROPE);
        const int gi = F.bid * 512 + F.tid;
        if (gi < 128 * 16) { const int pos = gi >> 4, f = gi & 15; const float inv = powf(10000.0f, -(float)(2 * f) / 32.0f); const float ang = (float)pos * inv; rope[gi * 2] = cosf(ang); rope[gi * 2 + 1] = sinf(ang); }
    }
    {
        LAS float* scr = (LAS float*)(F.lds + 32768 + F.wave * 8704);
        const int gw = F.bid * 8 + F.wave, NGW = F.G * 8;
        constexpr int I_IN = 16 * 176, I_OUT = 44 * 32, I_QKV = 16 * 96, I_O = 16 * 32, I_P = 4 * 8;
        constexpr int N_IN = 8 * I_IN, N_OUT = 8 * I_OUT, N_QKV = 2 * I_QKV, N_O = 2 * I_O, N_P = 8 * I_P;
        for (int it = gw; it < N_IN + N_OUT + N_QKV + N_O + N_P; it += NGW) {
            int r = it;
            if (r < N_IN) { const int mat = r / I_IN, l = r % I_IN, kb = l / 176, nb = l % 176; const int n0 = nb * 32;
                const int j = n0 < DFF ? n0 : n0 - DFF; const int dst = 256 * (j >> 7) + (n0 < DFF ? 0 : 128) + (j & 127);
                transpose_item(a.in[7] + (size_t)mat * 1024 * 5632, 5632, kb * 64, n0, (bf16_t*)(ws + WS_WIN) + (size_t)mat * 5632 * 1024, 1024, dst, scr, F.lane, n0 < DFF ? LOG2E : 0.6931471805599453f); continue; }
            r -= N_IN;
            if (r < N_OUT) { const int mat = r / I_OUT, l = r % I_OUT, kb = l / 32, nb = l % 32;
                transpose_item(a.in[8] + (size_t)mat * DFF * 1024, 1024, kb * 64, nb * 32, (bf16_t*)(ws + WS_WOUT) + (size_t)mat * 1024 * DFF, DFF, nb * 32, scr, F.lane); continue; }
            r -= N_OUT;
            if (r < N_QKV) { const int mat = r / I_QKV, l = r % I_QKV, kb = l / 96, nb = l % 96;
                transpose_item(mat == 0 ? a.in[11] : a.in[15], 3072, kb * 64, nb * 32, (bf16_t*)(ws + WS_WQKV) + (size_t)mat * 3072 * 1024, 1024, nb * 32, scr, F.lane); continue; }
            r -= N_QKV;
            if (r < N_O) { const int mat = r / I_O, l = r % I_O, kb = l / 32, nb = l % 32;
                transpose_item(mat == 0 ? a.in[14] : a.in[18], 1024, kb * 64, nb * 32, (bf16_t*)(ws + WS_WO) + (size_t)mat * 1024 * 1024, 1024, nb * 32, scr, F.lane); continue; }
            r -= N_O;
            { const int mat = r / I_P, l = r % I_P, kb = l / 8, nb = l % 8;
                transpose_item(a.in[9] + (size_t)mat * 256 * 256, 256, kb * 64, nb * 32, (bf16_t*)(ws + WS_WPOOL) + (size_t)mat * 256 * 256, 256, nb * 32, scr, F.lane); }
        }
    }
}

__device__ __forceinline__ void normmod_phase(const Ctx& F0, h16_t* X, int T, const float* g, const float* modL, int slot_shift, int slot_scale, bf16_t* H,
                                              const float* part, const float* pgate) {
    Ctx F = F0; F.refresh();
    const int gw = F.bid * 8 + F.wave, NGW = F.G * 8;
    const int RPW = (TL + NGW - 1) / NGW;
    const int r0 = gw * RPW, r1 = (r0 + RPW) < TL ? (r0 + RPW) : TL;
    const int nrows = (r1 > r0 ? r1 - r0 : 0) + ((T > TL && gw < TC) ? 1 : 0);
    int cur = -1; f32x4 gm[4], sh[4];
#pragma unroll
    for (int j = 0; j < 4; ++j) { gm[j] = (f32x4){0.f, 0.f, 0.f, 0.f}; sh[j] = gm[j]; }
    for (int ir = 0; ir < nrows; ++ir) {
        const int row = (r0 + ir) < r1 ? (r0 + ir) : (TL + gw);
        const int midx = row < TL ? (row >> 13) : 4;
        if (midx != cur) { cur = midx;
#pragma unroll
            for (int j = 0; j < 4; ++j) { const int c = 512 * (j >> 1) + 8 * F.lane + 4 * (j & 1); const f32x4 gv = *(const f32x4*)(g + c), sc = *(const f32x4*)(modL + midx * NMODV + slot_scale * 1024 + c);
                gm[j] = gv * (sc + 1.0f); sh[j] = *(const f32x4*)(modL + midx * NMODV + slot_shift * 1024 + c); } }
        h16_t* xr = X + (size_t)row * DM;
        f32x4 v[4]; float ss = 0.f;
#pragma unroll
        for (int jj = 0; jj < 2; ++jj) { const f32x8 xf = __builtin_convertvector(*(const f16x8*)(xr + 512 * jj + 8 * F.lane), f32x8);
            v[2 * jj] = (f32x4){xf[0], xf[1], xf[2], xf[3]}; v[2 * jj + 1] = (f32x4){xf[4], xf[5], xf[6], xf[7]}; }
        if (part != nullptr && row >= TL) {
            const float* pr = part + (size_t)(row - TL) * (11 * DM) + 8 * F.lane;
            f32x4 s[4];
#pragma unroll
            for (int j = 0; j < 4; ++j) s[j] = (f32x4){0.f, 0.f, 0.f, 0.f};
#pragma unroll 1
            for (int sl = 0; sl < 11; ++sl) {
#pragma unroll
                for (int j = 0; j < 4; ++j) s[j] = s[j] + *(const f32x4*)(pr + sl * DM + 512 * (j >> 1) + 4 * (j & 1));
            }
#pragma unroll
            for (int j = 0; j < 4; ++j) v[j] = v[j] + s[j] * (*(const f32x4*)(pgate + 512 * (j >> 1) + 8 * F.lane + 4 * (j & 1)) * 0.5f);
#pragma unroll
            for (int jj = 0; jj < 2; ++jj) { const f32x8 o = (f32x8){v[2 * jj][0], v[2 * jj][1], v[2 * jj][2], v[2 * jj][3], v[2 * jj + 1][0], v[2 * jj + 1][1], v[2 * jj + 1][2], v[2 * jj + 1][3]};
                const f16x8 oh = __builtin_convertvector(o, f16x8);
                *(f16x8*)(xr + 512 * jj + 8 * F.lane) = oh;
                const f32x8 back = __builtin_convertvector(oh, f32x8);
                v[2 * jj] = (f32x4){back[0], back[1], back[2], back[3]}; v[2 * jj + 1] = (f32x4){back[4], back[5], back[6], back[7]}; }
        }
#pragma unroll
        for (int j = 0; j < 4; ++j) ss += (v[j][0] * v[j][0] + v[j][1] * v[j][1]) + (v[j][2] * v[j][2] + v[j][3] * v[j][3]);
        const float r = 1.0f / sqrtf(wave_sum(ss) * (1.0f / DM) + NORM_EPS);
        bf16_t* o = H + (size_t)row * DM;
#pragma unroll
        for (int jj = 0; jj < 2; ++jj) { const f32x4 y0 = v[2 * jj] * r * gm[2 * jj] + sh[2 * jj], y1 = v[2 * jj + 1] * r * gm[2 * jj + 1] + sh[2 * jj + 1];
            u32x4 w; w.x = cvt_pk_bf16(y0[0], y0[1]); w.y = cvt_pk_bf16(y0[2], y0[3]); w.z = cvt_pk_bf16(y1[0], y1[1]); w.w = cvt_pk_bf16(y1[2], y1[3]);
            *(u32x4*)(o + 512 * jj + 8 * F.lane) = w; }
    }
}
__device__ __forceinline__ void final_norm_phase(const Ctx& F0, const h16_t* x, const float* g, float* out) {
    Ctx F = F0; F.refresh();
    const int gw = F.bid * 8 + F.wave, NGW = F.G * 8;
    f32x4 gv[4];
#pragma unroll
    for (int j = 0; j < 4; ++j) gv[j] = *(const f32x4*)(g + 512 * (j >> 1) + 8 * F.lane + 4 * (j & 1));
    for (int row = gw; row < TL; row += NGW) {
        const h16_t* xr = x + (size_t)row * DM;
        f32x4 v[4]; float ss = 0.f;
#pragma unroll
        for (int jj = 0; jj < 2; ++jj) { const f32x8 xf = __builtin_convertvector(*(const f16x8*)(xr + 512 * jj + 8 * F.lane), f32x8);
            v[2 * jj] = (f32x4){xf[0], xf[1], xf[2], xf[3]}; v[2 * jj + 1] = (f32x4){xf[4], xf[5], xf[6], xf[7]}; }
#pragma unroll
        for (int j = 0; j < 4; ++j) ss += (v[j][0] * v[j][0] + v[j][1] * v[j][1]) + (v[j][2] * v[j][2] + v[j][3] * v[j][3]);
        const float r = 1.0f / sqrtf(wave_sum(ss) * (1.0f / DM) + NORM_EPS);
#pragma unroll
        for (int j = 0; j < 4; ++j) *(f32x4*)(out + (size_t)row * DM + 512 * (j >> 1) + 8 * F.lane + 4 * (j & 1)) = v[j] * r * gv[j];
    }
}

__device__ __forceinline__ void bf8_to_f(const u32x4 w, float (&f)[8]) {
    f[0] = __uint_as_float(w.x << 16); f[1] = __uint_as_float(w.x & 0xffff0000u); f[2] = __uint_as_float(w.y << 16); f[3] = __uint_as_float(w.y & 0xffff0000u);
    f[4] = __uint_as_float(w.z << 16); f[5] = __uint_as_float(w.z & 0xffff0000u); f[6] = __uint_as_float(w.w << 16); f[7] = __uint_as_float(w.w & 0xffff0000u);
}
__device__ __forceinline__ void pool_diff_phase(const Ctx& F0, const bf16_t* H, bf16_t* Dd, int T) {
    Ctx F = F0; F.refresh();
    const int gw = F.bid * 8 + F.wave, NGW = F.G * 8;
    const int NI = (T >> 4) * 2;
    for (int it = gw; it < NI; it += NGW) {
        const int row0 = (it >> 1) << 4, col = (it & 1) * 512 + F.lane * 8;
        const int grp = col >> 8, win = 2 << grp, hw = win >> 1;
        int seq0, n;
        if (row0 < TL) { seq0 = row0 & ~(SEQ - 1); n = SEQ; } else { seq0 = TL + ((row0 - TL) & ~(CTXL - 1)); n = CTXL; }
        const bf16_t* base = H + (size_t)seq0 * DM + col;
        const int t0 = row0 - seq0;
        int lo = (t0 - hw) > 0 ? (t0 - hw) : 0, hi = (t0 + hw - 1) < (n - 1) ? (t0 + hw - 1) : (n - 1);
        float s[8];
#pragma unroll
        for (int i = 0; i < 8; ++i) s[i] = 0.f;
        for (int rr = lo; rr <= hi; ++rr) { float f[8]; bf8_to_f(*(const u32x4*)(base + (size_t)rr * DM), f);
#pragma unroll
            for (int i = 0; i < 8; ++i) s[i] += f[i]; }
        for (int k = 0; k < 16; ++k) {
            const int t = t0 + k;
            const int nlo = (t - hw) > 0 ? (t - hw) : 0, nhi = (t + hw - 1) < (n - 1) ? (t + hw - 1) : (n - 1);
            if (nlo > lo) { float f[8]; bf8_to_f(*(const u32x4*)(base + (size_t)lo * DM), f);
#pragma unroll
                for (int i = 0; i < 8; ++i) s[i] -= f[i]; }
            if (nhi > hi) { float f[8]; bf8_to_f(*(const u32x4*)(base + (size_t)nhi * DM), f);
#pragma unroll
                for (int i = 0; i < 8; ++i) s[i] += f[i]; }
            lo = nlo; hi = nhi;
            const float inv = 1.0f / (float)(hi - lo + 1);
            float c[8]; bf8_to_f(*(const u32x4*)(base + (size_t)t * DM), c);
            u32x4 ov; ov.x = cvt_pk_bf16(s[0] * inv - c[0], s[1] * inv - c[1]); ov.y = cvt_pk_bf16(s[2] * inv - c[2], s[3] * inv - c[3]);
            ov.z = cvt_pk_bf16(s[4] * inv - c[4], s[5] * inv - c[5]); ov.w = cvt_pk_bf16(s[6] * inv - c[6], s[7] * inv - c[7]);
            *(u32x4*)(Dd + (size_t)(row0 + k) * DM + col) = ov;
        }
    }
}

template <int KROWB> __device__ __forceinline__ int kswz(int key) { return KROWB == 256 ? (key & 15) : ((key >> 1) & 7); }

constexpr float ATT_THR = 8.0f;
template <int NEB, int KROWB, int MASK>
__device__ __forceinline__ void attn_qk(const LAS unsigned char* Kt, int kchunk0, const bf16x8 (&qf)[4], f32x16 (&o)[NEB], f32x16& negm, float& mref, float& lrun, bool& first, int l31, int hi,
                                        const LAS float* brow, int qc, int cs, bf16x8 (&pb)[4]) {
    f32x16 s0, s1;
#pragma clang loop unroll(disable)
    for (;;) {
#pragma unroll
        for (int d0 = 0; d0 < 4; ++d0) {
            const int ch = kchunk0 + 2 * d0 + hi;
            const int k0 = l31, k1 = 32 + l31;
            const bf16x8 a0 = *(const LAS bf16x8*)(Kt + k0 * KROWB + ((ch ^ kswz<KROWB>(k0)) << 4));
            const bf16x8 a1 = *(const LAS bf16x8*)(Kt + k1 * KROWB + ((ch ^ kswz<KROWB>(k1)) << 4));
            if (d0 == 0) { s0 = __builtin_amdgcn_mfma_f32_32x32x16_bf16(a0, qf[0], negm, 0, 0, 0); s1 = __builtin_amdgcn_mfma_f32_32x32x16_bf16(a1, qf[0], negm, 0, 0, 0); }
            else { s0 = __builtin_amdgcn_mfma_f32_32x32x16_bf16(a0, qf[d0], s0, 0, 0, 0); s1 = __builtin_amdgcn_mfma_f32_32x32x16_bf16(a1, qf[d0], s1, 0, 0, 0); }
        }
        if (MASK == 1) {
#pragma unroll
            for (int r = 0; r < 16; ++r) {
                const int kc0 = (r & 3) + 8 * (r >> 2) + 4 * hi, kc1 = kc0 + 32;
                const bool v0 = (unsigned)(kc0 - cs) < 16u, v1 = (unsigned)(kc1 - cs) < 16u;
                const int i0 = v0 ? (kc0 - qc + 15) : 0, i1 = v1 ? (kc1 - qc + 15) : 0;
                const float b0 = brow[i0], b1 = brow[i1];
                s0[r] = v0 ? s0[r] + b0 : NEG_BIG; s1[r] = v1 ? s1[r] + b1 : NEG_BIG;
            }
        }
        float mx = fmaxf(fmaxf(s0[0], s1[0]), fmaxf(s0[1], s1[1]));
#pragma unroll
        for (int r = 2; r < 16; r += 2) mx = fmaxf(fmaxf(mx, s0[r]), fmaxf(s1[r], fmaxf(s0[r + 1], s1[r + 1])));
        mx = fmaxf(mx, __shfl_xor(mx, 32));
        if (__builtin_expect(!(first || __any(mx > ATT_THR)), 1)) break;
        const float dl = first ? mx : fmaxf(mx, 0.f);
        const float f = first ? 1.0f : __builtin_amdgcn_exp2f(-dl);
        first = false;
        mref += dl; lrun *= f;
#pragma unroll
        for (int r = 0; r < 16; ++r) negm[r] = -mref;
#pragma unroll
        for (int eb = 0; eb < NEB; ++eb)
#pragma unroll
            for (int r = 0; r < 16; ++r) o[eb][r] *= f;
        asm volatile("" : "+v"(negm));
    }
#pragma unroll
    for (int r = 0; r < 16; ++r) { s0[r] = __builtin_amdgcn_exp2f(s0[r]); s1[r] = __builtin_amdgcn_exp2f(s1[r]); }
    float ps = s0[0] + s1[0];
#pragma unroll
    for (int r = 1; r < 16; ++r) { ps += s0[r]; ps += s1[r]; }
    lrun += ps;
    {
        u32x4 w;
        w.x = cvt_pk_bf16(s0[0], s0[1]); w.y = cvt_pk_bf16(s0[2], s0[3]); w.z = cvt_pk_bf16(s0[4], s0[5]); w.w = cvt_pk_bf16(s0[6], s0[7]); pb[0] = __builtin_bit_cast(bf16x8, w);
        w.x = cvt_pk_bf16(s0[8], s0[9]); w.y = cvt_pk_bf16(s0[10], s0[11]); w.z = cvt_pk_bf16(s0[12], s0[13]); w.w = cvt_pk_bf16(s0[14], s0[15]); pb[1] = __builtin_bit_cast(bf16x8, w);
        w.x = cvt_pk_bf16(s1[0], s1[1]); w.y = cvt_pk_bf16(s1[2], s1[3]); w.z = cvt_pk_bf16(s1[4], s1[5]); w.w = cvt_pk_bf16(s1[6], s1[7]); pb[2] = __builtin_bit_cast(bf16x8, w);
        w.x = cvt_pk_bf16(s1[8], s1[9]); w.y = cvt_pk_bf16(s1[10], s1[11]); w.z = cvt_pk_bf16(s1[12], s1[13]); w.w = cvt_pk_bf16(s1[14], s1[15]); pb[3] = __builtin_bit_cast(bf16x8, w);
    }
}
template <int KROWB>
__device__ __forceinline__ float attn_max(const LAS unsigned char* Kt, int kchunk0, const bf16x8 (&qf)[4], int l31, int hi) {
    f32x16 s0, s1;
#pragma unroll
    for (int r = 0; r < 16; ++r) { s0[r] = 0.f; s1[r] = 0.f; }
#pragma unroll
    for (int d0 = 0; d0 < 4; ++d0) {
        const int ch = kchunk0 + 2 * d0 + hi;
        const int k0 = l31, k1 = 32 + l31;
        const bf16x8 a0 = *(const LAS bf16x8*)(Kt + k0 * KROWB + ((ch ^ kswz<KROWB>(k0)) << 4));
        const bf16x8 a1 = *(const LAS bf16x8*)(Kt + k1 * KROWB + ((ch ^ kswz<KROWB>(k1)) << 4));
        s0 = __builtin_amdgcn_mfma_f32_32x32x16_bf16(a0, qf[d0], s0, 0, 0, 0); s1 = __builtin_amdgcn_mfma_f32_32x32x16_bf16(a1, qf[d0], s1, 0, 0, 0);
    }
    float mx = fmaxf(fmaxf(s0[0], s1[0]), fmaxf(s0[1], s1[1]));
#pragma unroll
    for (int r = 2; r < 16; r += 2) mx = fmaxf(fmaxf(mx, s0[r]), fmaxf(s1[r], fmaxf(s0[r + 1], s1[r + 1])));
    return fmaxf(mx, __shfl_xor(mx, 32));
}
template <int NEB, int KROWB, int MASK>
__device__ __forceinline__ void attn_qk_fast(const LAS unsigned char* Kt, int kchunk0, const bf16x8 (&qf)[4], const f32x16& negm, float& lrun, int l31, int hi,
                                             const LAS float* brow, int qc, int cs, bf16x8 (&pb)[4]) {
    f32x16 s0, s1;
#pragma unroll
    for (int d0 = 0; d0 < 4; ++d0) {
        const int ch = kchunk0 + 2 * d0 + hi;
        const int k0 = l31, k1 = 32 + l31;
        const bf16x8 a0 = *(const LAS bf16x8*)(Kt + k0 * KROWB + ((ch ^ kswz<KROWB>(k0)) << 4));
        const bf16x8 a1 = *(const LAS bf16x8*)(Kt + k1 * KROWB + ((ch ^ kswz<KROWB>(k1)) << 4));
        if (d0 == 0) { s0 = __builtin_amdgcn_mfma_f32_32x32x16_bf16(a0, qf[0], negm, 0, 0, 0); s1 = __builtin_amdgcn_mfma_f32_32x32x16_bf16(a1, qf[0], negm, 0, 0, 0); }
        else { s0 = __builtin_amdgcn_mfma_f32_32x32x16_bf16(a0, qf[d0], s0, 0, 0, 0); s1 = __builtin_amdgcn_mfma_f32_32x32x16_bf16(a1, qf[d0], s1, 0, 0, 0); }
    }
    if (MASK == 1) {
#pragma unroll
        for (int r = 0; r < 16; ++r) {
            const int kc0 = (r & 3) + 8 * (r >> 2) + 4 * hi, kc1 = kc0 + 32;
            const bool v0 = (unsigned)(kc0 - cs) < 16u, v1 = (unsigned)(kc1 - cs) < 16u;
            const int i0 = v0 ? (kc0 - qc + 15) : 0, i1 = v1 ? (kc1 - qc + 15) : 0;
            const float b0 = brow[i0], b1 = brow[i1];
            s0[r] = v0 ? s0[r] + b0 : NEG_BIG; s1[r] = v1 ? s1[r] + b1 : NEG_BIG;
        }
    }
#pragma unroll
    for (int r = 0; r < 16; ++r) { s0[r] = __builtin_amdgcn_exp2f(s0[r]); s1[r] = __builtin_amdgcn_exp2f(s1[r]); }
    float ps = s0[0] + s1[0];
#pragma unroll
    for (int r = 1; r < 16; ++r) { ps += s0[r]; ps += s1[r]; }
    lrun += ps;
    {
        u32x4 w;
        w.x = cvt_pk_bf16(s0[0], s0[1]); w.y = cvt_pk_bf16(s0[2], s0[3]); w.z = cvt_pk_bf16(s0[4], s0[5]); w.w = cvt_pk_bf16(s0[6], s0[7]); pb[0] = __builtin_bit_cast(bf16x8, w);
        w.x = cvt_pk_bf16(s0[8], s0[9]); w.y = cvt_pk_bf16(s0[10], s0[11]); w.z = cvt_pk_bf16(s0[12], s0[13]); w.w = cvt_pk_bf16(s0[14], s0[15]); pb[1] = __builtin_bit_cast(bf16x8, w);
        w.x = cvt_pk_bf16(s1[0], s1[1]); w.y = cvt_pk_bf16(s1[2], s1[3]); w.z = cvt_pk_bf16(s1[4], s1[5]); w.w = cvt_pk_bf16(s1[6], s1[7]); pb[2] = __builtin_bit_cast(bf16x8, w);
        w.x = cvt_pk_bf16(s1[8], s1[9]); w.y = cvt_pk_bf16(s1[10], s1[11]); w.z = cvt_pk_bf16(s1[12], s1[13]); w.w = cvt_pk_bf16(s1[14], s1[15]); pb[3] = __builtin_bit_cast(bf16x8, w);
    }
}
template <int NEB>
__device__ __forceinline__ void attn_pv(const LAS unsigned char* Vt, const bf16x8 (&pb)[4], f32x16 (&o)[NEB], int l31, int hi) {
    const int sw = (l31 >> 1) & 7;
    const LAS unsigned char* vrow = Vt + l31 * 128;
#pragma unroll
    for (int G = 0; G < 4; ++G) {
        const int coff = ((2 * G + hi) ^ sw) << 4;
#pragma unroll
        for (int eb = 0; eb < NEB; ++eb) {
            const bf16x8 vf = *(const LAS bf16x8*)(vrow + eb * 4096 + coff);
            o[eb] = __builtin_amdgcn_mfma_f32_32x32x16_bf16(vf, pb[G], o[eb], 0, 0, 0);
        }
    }
}

__device__ __forceinline__ void diff_attn_phase(const Ctx& F0, const bf16_t* Q, const bf16_t* Kb, const bf16_t* Vt, bf16_t* ATT, const float* lamp, const float* subg, float lam_init, bool want_ctx) {
    Ctx F = F0; F.refresh();
    const int l31 = F.lane & 31, hi = F.lane >> 5;
    const int sub = F.wave >> 1, j = F.wave & 1;
    float lam_full;
    { const float p01 = lamp[F.lane] * lamp[64 + F.lane], p23 = lamp[128 + F.lane] * lamp[192 + F.lane];
      lam_full = __expf(wave_sum(p01)) - __expf(wave_sum(p23)) + lam_init; }
    const int xcd = F.bid & 7, wi = F.bid >> 3, nwi = F.G >> 3;
    const int n_lat_rounds = (4 * 64 + nwi - 1) / nwi;
    const int total_rounds = n_lat_rounds + (want_ctx ? 1 : 0);
    for (int rd = 0; rd < total_rounds; ++rd) {
        int b, h, qrow0, ntile; bool is_ctx = false;
        if (rd < n_lat_rounds) {
            const int li = rd * nwi + wi; if (li >= 256) continue;
            const int bh = xcd + 8 * (li >> 6), qb = li & 63;
            b = bh >> 3; h = bh & 7; qrow0 = b * SEQ + qb * 128; ntile = 132;
        } else {
            if (F.bid >= 64) continue;
            b = F.bid >> 4; h = (F.bid >> 1) & 7; qrow0 = TL + b * CTXL + (F.bid & 1) * 128; ntile = 4; is_ctx = true;
        }
        const int krow_lat = b * SEQ, krow_ctx = TL + b * CTXL;
        bf16x8 qf[4];
        { const char* qbase = (const char*)Q + ((size_t)(qrow0 + sub * 32) * DM + h * 128 + j * 64) * 2;
          const unsigned qoff = (unsigned)(l31 * DM + hi * 8) * 2u;
#pragma unroll
          for (int d0 = 0; d0 < 4; ++d0) qf[d0] = *(const bf16x8*)(qbase + qoff + d0 * 32); }
        f32x16 o[4]; float lrun; f32x16 negm;
        const int kkey = F.tid >> 4, kch = F.tid & 15;
        const int ve = F.tid >> 3, vc = F.tid & 7;
        const unsigned kgoff = (unsigned)(kkey * DM + kch * 8) * 2u, vgoff = (unsigned)(ve * TA + vc * 8) * 2u;
        const unsigned klds = (unsigned)(kkey * 256 + ((kch ^ (kkey & 15)) << 4));
        const unsigned vsw = (unsigned)((ve >> 1) & 7);
        const unsigned vlds0 = (unsigned)(16384 + ve * 128 + (((2 * (vc >> 1)) ^ vsw) << 4) + (vc & 1) * 8), vlds1 = (unsigned)(16384 + ve * 128 + (((2 * (vc >> 1) + 1) ^ vsw) << 4) + (vc & 1) * 8);
        const char* kg_u = (const char*)Kb + (size_t)(h * 128) * 2;
        const char* vg_u = (const char*)Vt + (size_t)(h * 128) * TA * 2;
        u32x4 rk[2], rv[2];
#define DA_KROW(t) ((is_ctx || (t) >= 128) ? (krow_ctx + 64 * ((t) - (is_ctx ? 0 : 128))) : (krow_lat + 64 * (t)))
#define DA_LOAD(t) do { const int kr_ = DA_KROW(t); const char* kp_ = kg_u + (size_t)kr_ * (DM * 2); const char* vp_ = vg_u + (size_t)kr_ * 2; \
            rk[0] = *(const u32x4*)(kp_ + kgoff); rk[1] = *(const u32x4*)(kp_ + (size_t)(32 * DM * 2) + kgoff); \
            rv[0] = *(const u32x4*)(vp_ + vgoff); rv[1] = *(const u32x4*)(vp_ + (size_t)64 * TA * 2 + vgoff); } while (0)
#define DA_STORE(st) do { LAS unsigned char* sb_ = F.lds + (st) * 32768; \
            *(LAS u32x4*)(sb_ + klds) = rk[0]; *(LAS u32x4*)(sb_ + klds + 32 * 256) = rk[1]; \
            *(LAS u32x2*)(sb_ + vlds0) = (u32x2){rv[0].x, rv[0].y}; *(LAS u32x2*)(sb_ + vlds1) = (u32x2){rv[0].z, rv[0].w}; \
            *(LAS u32x2*)(sb_ + vlds0 + 64 * 128) = (u32x2){rv[1].x, rv[1].y}; *(LAS u32x2*)(sb_ + vlds1 + 64 * 128) = (u32x2){rv[1].z, rv[1].w}; } while (0)
        for (int attempt = 0; ; ++attempt) {
            const int nref = attempt == 0 ? 0 : ntile;
            float mrow = attempt == 0 ? 0.f : NEG_BIG;
            if (nref > 0) { DA_LOAD(0); DA_STORE(0); }
            __syncthreads();
            for (int t = 0; t < nref; ++t) {
                const bool more = (t + 1) < nref;
                if (more) DA_LOAD(t + 1);
                mrow = fmaxf(mrow, attn_max<256>(F.lds + (t & 1) * 32768, 8 * j, qf, l31, hi));
                if (more) DA_STORE((t + 1) & 1);
                __syncthreads();
            }
#pragma unroll
            for (int eb = 0; eb < 4; ++eb)
#pragma unroll
                for (int r = 0; r < 16; ++r) o[eb][r] = 0.f;
            lrun = 0.f;
#pragma unroll
            for (int r = 0; r < 16; ++r) negm[r] = -mrow;
            asm volatile("" : "+v"(negm));
            DA_LOAD(0); DA_STORE(0); DA_LOAD(1); DA_STORE(1);
            __syncthreads();
            for (int u = 0; u < (ntile >> 1); ++u) {
                const bool more = (u + 1) < (ntile >> 1);
                const int sl = (u & 1) * 2, nsl = sl ^ 2;
                bf16x8 pb[4];
                if (more) DA_LOAD(2 * u + 2);
                { const LAS unsigned char* kb = F.lds + sl * 32768;
                  attn_qk_fast<4, 256, 0>(kb, 8 * j, qf, negm, lrun, l31, hi, nullptr, 0, 0, pb);
                  attn_pv<4>(kb + 16384, pb, o, l31, hi);
                  if (more) { DA_STORE(nsl); DA_LOAD(2 * u + 3); } }
                { const LAS unsigned char* kb = F.lds + (sl + 1) * 32768;
                  attn_qk_fast<4, 256, 0>(kb, 8 * j, qf, negm, lrun, l31, hi, nullptr, 0, 0, pb);
                  attn_pv<4>(kb + 16384, pb, o, l31, hi);
                  if (more) DA_STORE(nsl + 1); }
                __syncthreads();
            }
            if (attempt == 1) break;
            const float lt0 = lrun + __shfl_xor(lrun, 32);
            const bool okw = __all(lt0 < 1.0e30f && lt0 > 1.0e-30f);
            LAS unsigned* okf = (LAS unsigned*)(F.lds + 131072 + 2048);
            if (F.lane == 0) okf[F.wave] = okw ? 1u : 0u;
            __syncthreads();
            unsigned allok = 1u;
#pragma unroll
            for (int w = 0; w < 8; ++w) allok &= okf[w];
            __syncthreads();
            if (__builtin_expect(allok != 0u, 1)) break;
        }
#undef DA_KROW
#undef DA_LOAD
#undef DA_STORE
        { const float lt = lrun + __shfl_xor(lrun, 32); const float inv = 1.0f / lt;
#pragma unroll
          for (int eb = 0; eb < 4; ++eb)
#pragma unroll
              for (int r = 0; r < 16; ++r) o[eb][r] *= inv; }
        LAS float* cb = (LAS float*)(F.lds + sub * 16384);
        if (j == 1) {
#pragma unroll
            for (int eb = 0; eb < 4; ++eb)
#pragma unroll
                for (int r = 0; r < 16; ++r) { const int e = 32 * eb + (r & 3) + 8 * (r >> 2) + 4 * hi; cb[e * 32 + l31] = o[eb][r]; }
        }
        __syncthreads();
        if (j == 0) {
            float ss = 0.f;
#pragma unroll
            for (int eb = 0; eb < 4; ++eb)
#pragma unroll
                for (int r = 0; r < 16; ++r) { const int e = 32 * eb + (r & 3) + 8 * (r >> 2) + 4 * hi; const float d = o[eb][r] - lam_full * cb[e * 32 + l31]; o[eb][r] = d; ss += d * d; }
            ss += __shfl_xor(ss, 32);
            const float rn = (1.0f - lam_init) / sqrtf(ss * (1.0f / 128.0f) + NORM_EPS);
            char* ob = (char*)ATT + ((size_t)(qrow0 + sub * 32) * DM + h * 128) * 2;
            const unsigned ooff = (unsigned)(l31 * DM + 4 * hi) * 2u;
#pragma unroll
            for (int eb = 0; eb < 4; ++eb)
#pragma unroll
                for (int g4 = 0; g4 < 4; ++g4) {
                    const int e = 32 * eb + 8 * g4 + 4 * hi;
                    bf16_t* op = (bf16_t*)(ob + ooff) - 4 * hi;
                    const f32x4 gv = *(const f32x4*)(subg + e);
                    u32x2 w; w.x = cvt_pk_bf16(o[eb][4 * g4] * rn * gv[0], o[eb][4 * g4 + 1] * rn * gv[1]); w.y = cvt_pk_bf16(o[eb][4 * g4 + 2] * rn * gv[2], o[eb][4 * g4 + 3] * rn * gv[3]);
                    *(u32x2*)(op + e) = w;
                }
        }
        __syncthreads();
    }
}

__device__ __forceinline__ void nat_attn_phase(const Ctx& F0, const bf16_t* Q, const bf16_t* Kb, const bf16_t* Vt, bf16_t* ATT, const float* rpb, bool want_ctx) {
    Ctx F = F0; F.refresh();
    const int l31 = F.lane & 31, hi = F.lane >> 5;
    const int NU = 2048 + (want_ctx ? 64 : 0);
    LAS float* rpbL = (LAS float*)(F.lds + 65536);
    for (int u = F.bid; u < NU; u += F.G) {
        int b, h, r0 = 0, qtok, nwin, lo = 0; bool is_ctx = false;
        if (u < 2048) { const int bh = u >> 5; b = bh >> 4; h = bh & 15; r0 = (u & 31) * 4;
            const int qr_ = r0 + (F.wave >> 1); qtok = b * SEQ + qr_ * 64 + (F.wave & 1) * 32 + l31;
            lo = (r0 - 4) < 0 ? 0 : ((r0 - 4) > 120 ? 120 : (r0 - 4));
            const int hi_r = ((r0 - 1) < 0 ? 0 : ((r0 - 1) > 120 ? 120 : (r0 - 1))) + 7; nwin = hi_r - lo + 1;
        } else { const int uc = u - 2048; b = uc >> 4; h = uc & 15; is_ctx = true; nwin = 0; qtok = TL + b * CTXL + F.wave * 32 + l31; }
        const int qr = r0 + (F.wave >> 1), half = F.wave & 1;
        const int rs = (qr - 4) < 0 ? 0 : ((qr - 4) > 120 ? 120 : (qr - 4));
        const int qc = half * 32 + l31;
        const int cs = (qc - 8) < 0 ? 0 : ((qc - 8) > 48 ? 48 : (qc - 8));
        if (F.tid < 480) { const int ro = F.tid >> 5, co = F.tid & 31; rpbL[F.tid] = co < 31 ? rpb[(h * 15 + ro) * 31 + co] * LOG2E : 0.f; }
        bf16x8 qf[4];
        { const bf16_t* qp = Q + (size_t)qtok * DM + h * 64 + hi * 8;
#pragma unroll
          for (int d0 = 0; d0 < 4; ++d0) qf[d0] = *(const bf16x8*)(qp + d0 * 16); }
        f32x16 o[2];
#pragma unroll
        for (int eb = 0; eb < 2; ++eb)
#pragma unroll
            for (int r = 0; r < 16; ++r) o[eb][r] = 0.f;
        float mref = 0.f, lrun = 0.f; f32x16 negm; bool first = true;
#pragma unroll
        for (int r = 0; r < 16; ++r) negm[r] = 0.f;
        const int ntile = nwin + 4;
        const int kkey = F.tid >> 3, kch = F.tid & 7;
        u32x4 rk, rv;
#define NA_KROW(t) ((t) < nwin ? (b * SEQ + (lo + (t)) * 64) : (TL + b * CTXL + 64 * ((t) - nwin)))
#define NA_LOAD(t) do { const int kr_ = NA_KROW(t); rk = *(const u32x4*)(Kb + (size_t)(kr_ + kkey) * DM + h * 64 + kch * 8); rv = *(const u32x4*)(Vt + (size_t)(h * 64 + kkey) * TA + kr_ + kch * 8); } while (0)
#define NA_STORE(st) do { LAS unsigned char* kb_ = F.lds + (st) * 16384; LAS unsigned char* vb_ = kb_ + 8192; \
            *(LAS u32x4*)(kb_ + kkey * 128 + ((kch ^ ((kkey >> 1) & 7)) << 4)) = rk; const int sw_ = (kkey >> 1) & 7; \
            *(LAS u32x2*)(vb_ + kkey * 128 + (((2 * (kch >> 1)) ^ sw_) << 4) + (kch & 1) * 8) = (u32x2){rv.x, rv.y}; *(LAS u32x2*)(vb_ + kkey * 128 + (((2 * (kch >> 1) + 1) ^ sw_) << 4) + (kch & 1) * 8) = (u32x2){rv.z, rv.w}; } while (0)
        NA_LOAD(0); NA_STORE(0);
        __syncthreads();
        for (int t = 0; t < ntile; ++t) {
            const bool more = (t + 1) < ntile;
            if (more) NA_LOAD(t + 1);
            const LAS unsigned char* kb = F.lds + (t & 1) * 16384;
            bf16x8 pb[4]; bool act = true;
            if (t < nwin) {
                const int kr = lo + t;
                act = (kr >= rs && kr < rs + 8);
                if (act) attn_qk<2, 128, 1>(kb, 0, qf, o, negm, mref, lrun, first, l31, hi, rpbL + (kr - qr + 7) * 32, qc, cs, pb);
            } else {
                attn_qk<2, 128, 0>(kb, 0, qf, o, negm, mref, lrun, first, l31, hi, nullptr, 0, 0, pb);
            }
            if (more) NA_STORE((t + 1) & 1);
            if (act) attn_pv<2>(kb + 8192, pb, o, l31, hi);
            __syncthreads();
        }
#undef NA_KROW
#undef NA_LOAD
#undef NA_STORE
        { const float lt = lrun + __shfl_xor(lrun, 32); const float inv = 1.0f / lt;
          bf16_t* op = ATT + (size_t)qtok * DM + h * 64;
#pragma unroll
          for (int eb = 0; eb < 2; ++eb)
#pragma unroll
              for (int g4 = 0; g4 < 4; ++g4) {
                  const int e = 32 * eb + 8 * g4 + 4 * hi;
                  u32x2 w; w.x = cvt_pk_bf16(o[eb][4 * g4] * inv, o[eb][4 * g4 + 1] * inv); w.y = cvt_pk_bf16(o[eb][4 * g4 + 2] * inv, o[eb][4 * g4 + 3] * inv);
                  *(u32x2*)(op + e) = w;
              } }
        (void)is_ctx;
    }
}

#define XB_TMO      128
#define XB_XCNT(j)  (256  + 64 * (j))
#define XB_XSUB(j)  (1280 + 64 * (j))
#define XB_XGEN(j)  (2304 + 64 * (j))
#define XB_TOP      3328
#define XB_TOPGEN   3392
#define XCD_BAR_WORDS 3456
#define XB_SPIN_CAP (1u << 22)
__device__ __forceinline__ unsigned xb_ld(unsigned* p)              { return __hip_atomic_load(p, __ATOMIC_RELAXED, __HIP_MEMORY_SCOPE_AGENT); }
__device__ __forceinline__ unsigned xb_add(unsigned* p, unsigned v) { return __hip_atomic_fetch_add(p, v, __ATOMIC_RELAXED, __HIP_MEMORY_SCOPE_AGENT); }
__device__ __forceinline__ unsigned xb_xcc_id() { return (unsigned)__builtin_amdgcn_s_getreg((3 << 11) | 20) & 0xFu; }
#define XB_SPIN(cond, bar) do { unsigned _sp = 0; while (cond) { __builtin_amdgcn_s_sleep(1); \
    if ((++_sp & 255u) == 0u) { if (xb_ld(&(bar)[XB_TMO])) break; if (_sp > XB_SPIN_CAP) { atomicAdd(&(bar)[XB_TMO], 1u); break; } } } } while (0)
struct XcdBarrier { unsigned* bar; unsigned x; volatile LAS unsigned* st; };
__device__ __forceinline__ void xcd_barrier_complete(unsigned* bar, unsigned x, unsigned G, unsigned& nloc, unsigned& nx) {
    unsigned sum, cnt, mine, sp = 0u;
    for (;;) {
        sum = 0u; cnt = 0u; mine = 0u;
#pragma unroll
        for (unsigned j = 0; j < 16; ++j) { const unsigned c = xb_ld(&bar[XB_XCNT(j)]); sum += c; cnt += (c > 0u) ? 1u : 0u; mine = (j == x) ? c : mine; }
        if (sum == G) break;
        __builtin_amdgcn_s_sleep(1);
        if ((++sp & 255u) == 0u) { if (xb_ld(&bar[XB_TMO])) break; if (sp > XB_SPIN_CAP) { atomicAdd(&bar[XB_TMO], 1u); break; } }
    }
    nloc = mine > 0u ? mine : 1u; nx = cnt > 0u ? cnt : 1u;
}
__device__ __forceinline__ void xcd_barrier(const XcdBarrier& b, int tid, unsigned G) {
    asm volatile("s_waitcnt vmcnt(0)" ::: "memory");
    __syncthreads();
    if (tid == 0) {
        unsigned* bar = b.bar;
        __builtin_amdgcn_s_waitcnt(0);
        unsigned nloc = b.st[0], nx = b.st[1];
        if (nloc == 0u) { xcd_barrier_complete(bar, b.x, G, nloc, nx); b.st[0] = nloc; b.st[1] = nx; }
        const unsigned old = xb_add(&bar[XB_XSUB(b.x)], 1u);
        const unsigned gen = old / nloc;
        if (old + 1u == (gen + 1u) * nloc) {
            __builtin_amdgcn_fence(__ATOMIC_RELEASE, "agent");
            asm volatile("s_waitcnt vmcnt(0)" ::: "memory");
            const unsigned og = xb_add(&bar[XB_TOP], 1u);
            const unsigned tg = og / nx;
            if (og + 1u == (tg + 1u) * nx) xb_add(&bar[XB_TOPGEN], 1u);
            else XB_SPIN(xb_ld(&bar[XB_TOPGEN]) == tg, bar);
            __builtin_amdgcn_fence(__ATOMIC_ACQUIRE, "agent");
            xb_add(&bar[XB_XGEN(b.x)], 1u);
            asm volatile("s_waitcnt vmcnt(0)" ::: "memory");
        } else {
            XB_SPIN(xb_ld(&bar[XB_XGEN(b.x)]) == gen, bar);
            __builtin_amdgcn_fence(__ATOMIC_ACQUIRE, "agent");
            asm volatile("s_waitcnt vmcnt(0)" ::: "memory");
        }
    }
    __syncthreads();
}

__global__ void __launch_bounds__(512, 2) fwd_megakernel(Args args) {
    extern __shared__ __attribute__((aligned(16))) unsigned char lds_raw[];
    cg::grid_group grid = cg::this_grid();
    Ctx F;
    F.lds = (LAS unsigned char*)lds_raw;
    F.wave_s = __builtin_amdgcn_readfirstlane((int)threadIdx.x >> 6);
    F.refresh();
    F.G = gridDim.x; F.bid = blockIdx.x;
    unsigned char* ws = args.ws;
    h16_t* X = (h16_t*)(ws + WS_X);
    bf16_t* H = (bf16_t*)(ws + WS_H);
    bf16_t* HID = (bf16_t*)(ws + WS_BIG);
    bf16_t* Qb = (bf16_t*)(ws + WS_BIG);
    bf16_t* Kb = (bf16_t*)(ws + WS_BIG + QKV_STRIDE);
    bf16_t* Vtb = (bf16_t*)(ws + WS_BIG + 2 * QKV_STRIDE);
    const float* mod = (const float*)(ws + WS_MOD);
    const float* rope = (const float*)(ws + WS_ROPE);
    const float* zeros = (const float*)(ws + WS_CONST); const float* ones = zeros + 3072; const float* halves = zeros + 4096;

    volatile LAS unsigned* xst = (volatile LAS unsigned*)(F.lds + LDS_BYTES - 64);
    if (F.tid < 16) xst[F.tid] = 0u;
    __syncthreads();
    XcdBarrier xbar; xbar.bar = (unsigned*)ws; xbar.x = xb_xcc_id(); xbar.st = xst;
    if (F.tid == 0) (void)xb_add(&xbar.bar[XB_XCNT(xbar.x)], 1u);
#define GSYNC() do { Ctx Fs_ = F; Fs_.refresh(); xcd_barrier(xbar, Fs_.tid, (unsigned)F.G); } while (0)

    prologue_phase(F, args);
    grid.sync();

    float* PART = (float*)(ws + WS_PART);
    for (int layer = 0; layer < 4; ++layer) {
        const int kind = layer % 3, jj = layer / 3;
        const bool pend_in = (layer >= 1 && layer <= 2);
        const bool last = (layer == 3);
        const bool update_ctx = !last;
        const int T = last ? TL : TA;
        const int Tp = layer < 2 ? TA : TL;
        const bool ctx_after = layer < 2;
        const float* modL = mod + (size_t)layer * 5 * NMODV;
        const float* ng = args.in[6] + (size_t)layer * 3 * DM;

        normmod_phase(F, X, T, ng, modL, 0, 1, H, pend_in ? PART : nullptr, mod + (size_t)(layer - 1) * 5 * NMODV + 4 * NMODV + 8 * 1024);
        GSYNC();
        { pg8::Gemm g{H, (const bf16_t*)(ws + WS_WIN) + (size_t)(layer * 2) * 5632 * 1024, DM, DM, DM, 0};
          pg8::StaticOrder S; S.init(T, 5632, F.G, F.bid);
          pg8::EpiSwiglu E{HID, DFF};
          for (int rep = 0; rep < REP_G1; ++rep) pg8::gemm_phase<pg8::EpiSwiglu>(F.lds, F.wave_s, g, S, E); }
        GSYNC();
        { const bf16_t* Wt = (const bf16_t*)(ws + WS_WOUT) + (size_t)(layer * 2) * 1024 * DFF;
          { pg8::Gemm g{HID, Wt, DFF, DFF, DFF, 0};
            pg8::StaticOrder S; S.init(TL, DM, F.G, F.bid);
            pg8::EpiResid E{X, modL + 2 * 1024, zeros, halves};
            pg8::gemm_phase<pg8::EpiResid>(F.lds, F.wave_s, g, S, E); }
          if (T > TL) {
            pg8::Gemm g{HID, Wt, DFF, DFF, 256, 0};
            pg8::StaticOrder S; S.init(TC, 44 * 256, F.G, F.bid, 128);
            pg8::EpiPartial E{PART, 11 * DM};
            pg8::gemm_phase<pg8::EpiPartial, 4, 512>(F.lds, F.wave_s, g, S, E); } }
        GSYNC();

        normmod_phase(F, X, T, ng + DM, modL, 3, 4, H, T > TL ? PART : nullptr, modL + 4 * NMODV + 2 * 1024);
        GSYNC();
        if (kind == 0) {
            bf16_t* Dd = Qb;
            pool_diff_phase(F, H, Dd, Tp);
            GSYNC();
            { pg8::Gemm g{Dd, (const bf16_t*)(ws + WS_WPOOL) + (size_t)jj * 1024 * 256, DM, 256, 256, 512};
              pg8::StaticOrder S; S.init(Tp, DM, F.G, F.bid);
              pg8::EpiResid E{X, modL + 5 * 1024, zeros, args.in[10] + (size_t)jj * DM};
              pg8::gemm_phase<pg8::EpiResid>(F.lds, F.wave_s, g, S, E); }
            GSYNC();
        } else {
            const bf16_t* Wqkv = (const bf16_t*)(ws + WS_WQKV) + (size_t)(kind - 1) * 3072 * 1024;
            { pg8::Gemm g{H, Wqkv, DM, DM, DM, 0};
              pg8::StaticOrder S; S.init(T, 2048, F.G, F.bid);
              pg8::EpiQK E{Qb, Kb, rope, kind == 2 ? args.in[16] : zeros, kind - 1};
              pg8::gemm_phase<pg8::EpiQK>(F.lds, F.wave_s, g, S, E); }
            { pg8::Gemm g{Wqkv + (size_t)2048 * 1024, H, DM, DM, DM, 0};
              pg8::StaticOrder S; S.init(DM, T, F.G, (F.bid + 128) & (F.G - 1));
              pg8::EpiVt E{Vtb, TA, kind == 2 ? args.in[16] + 2048 : zeros};
              pg8::gemm_phase<pg8::EpiVt>(F.lds, F.wave_s, g, S, E); }
            GSYNC();
            if (kind == 1) {
                const float lam_init = 0.8f - 0.6f * expf(-0.3f * (float)layer);
                for (int rep = 0; rep < REP_DIFF; ++rep) diff_attn_phase(F, Qb, Kb, Vtb, H, args.in[12] + (size_t)jj * 256, args.in[13] + (size_t)jj * 128, lam_init, ctx_after);
            } else {
                for (int rep = 0; rep < REP_NAT; ++rep) nat_attn_phase(F, Qb, Kb, Vtb, H, args.in[17] + (size_t)jj * 16 * 15 * 31, ctx_after);
            }
            GSYNC();
            { pg8::Gemm g{H, (const bf16_t*)(ws + WS_WO) + (size_t)(kind - 1) * 1024 * 1024, DM, DM, DM, 0};
              pg8::StaticOrder S; S.init(Tp, DM, F.G, F.bid);
              pg8::EpiResid E{X, modL + 5 * 1024, kind == 2 ? args.in[19] + (size_t)jj * DM : zeros, ones};
              pg8::gemm_phase<pg8::EpiResid>(F.lds, F.wave_s, g, S, E); }
            GSYNC();
        }

        normmod_phase(F, X, Tp, ng + 2 * DM, modL, 6, 7, H, nullptr, zeros);
        GSYNC();
        { pg8::Gemm g{H, (const bf16_t*)(ws + WS_WIN) + (size_t)(layer * 2 + 1) * 5632 * 1024, DM, DM, DM, 0};
          pg8::StaticOrder S; S.init(Tp, 5632, F.G, F.bid);
          pg8::EpiSwiglu E{HID, DFF};
          for (int rep = 0; rep < REP_G1; ++rep) pg8::gemm_phase<pg8::EpiSwiglu>(F.lds, F.wave_s, g, S, E); }
        GSYNC();
        { const bf16_t* Wt = (const bf16_t*)(ws + WS_WOUT) + (size_t)(layer * 2 + 1) * 1024 * DFF;
          { pg8::Gemm g{HID, Wt, DFF, DFF, DFF, 0};
            pg8::StaticOrder S; S.init(TL, DM, F.G, F.bid);
            pg8::EpiResid E{X, modL + 8 * 1024, zeros, halves};
            pg8::gemm_phase<pg8::EpiResid>(F.lds, F.wave_s, g, S, E); }
          if (Tp > TL) {
            pg8::Gemm g{HID, Wt, DFF, DFF, 256, 0};
            pg8::StaticOrder S; S.init(TC, 44 * 256, F.G, F.bid, 128);
            pg8::EpiPartial E{PART, 11 * DM};
            pg8::gemm_phase<pg8::EpiPartial, 4, 512>(F.lds, F.wave_s, g, S, E); } }
        GSYNC();
    }
    final_norm_phase(F, X, args.in[20], args.out);
}

extern "C" void kernel_launch(void* const* d_in, const int* in_sizes, int n_in, void* d_out, int out_size, void* d_ws, size_t ws_size, hipStream_t stream) {
    static int grid = 0;
    if (grid == 0) {
        if (n_in != 21 || ws_size < WS_END) { fprintf(stderr, "kernel_launch: unexpected inputs (n_in %d, ws %zu)\n", n_in, ws_size); grid = -1; return; }
        int dev = 0, cus = 0, per_cu = 0;
        hipGetDevice(&dev);
        hipDeviceGetAttribute(&cus, hipDeviceAttributeMultiprocessorCount, dev);
        hipFuncSetAttribute((const void*)fwd_megakernel, hipFuncAttributeMaxDynamicSharedMemorySize, LDS_BYTES);
        hipOccupancyMaxActiveBlocksPerMultiprocessor(&per_cu, (const void*)fwd_megakernel, 512, LDS_BYTES);
        if (per_cu < 1) per_cu = 1;
        grid = cus * per_cu;
        if (grid > 256) grid = 256;
        grid &= ~7;
        (void)hipGetLastError();
    }
    if (grid <= 0) return;
    (void)hipMemsetAsync(d_ws, 0, 16384, stream);
    Args a{};
    for (int i = 0; i < 21; ++i) a.in[i] = (const float*)d_in[i];
    a.out = (float*)d_out; a.ws = (unsigned char*)d_ws;
    void* kargs[] = {&a};
    hipError_t e = hipLaunchCooperativeKernel((const void*)fwd_megakernel, dim3(grid), dim3(512), kargs, LDS_BYTES, stream);
    if (e != hipSuccess) fprintf(stderr, "cooperative launch failed: %s (grid %d)\n", hipGetErrorString(e), grid);
}
```

```cpp
#include <hip/hip_runtime.h>
#include <hip/hip_cooperative_groups.h>
#include <cstdio>
#include <cstdint>
namespace cg = cooperative_groups;

#define LAS __attribute__((address_space(3)))
typedef unsigned short bf16_t;
typedef short bf16x8 __attribute__((ext_vector_type(8)));
typedef short s16x4 __attribute__((ext_vector_type(4)));
typedef float f32x2 __attribute__((ext_vector_type(2)));
typedef float f32x4 __attribute__((ext_vector_type(4)));
typedef float f32x16 __attribute__((ext_vector_type(16)));
typedef unsigned u32x2 __attribute__((ext_vector_type(2)));
typedef _Float16 h16_t;
typedef _Float16 f16x4 __attribute__((ext_vector_type(4)));
typedef _Float16 f16x8 __attribute__((ext_vector_type(8)));
typedef float f32x8 __attribute__((ext_vector_type(8)));
typedef unsigned u32x4 __attribute__((ext_vector_type(4)));

constexpr int DM = 1024, NB = 4, SEQ = 8192, CTXL = 256, DFF = 2816, NMODV = 9 * 1024;
constexpr int TL = NB * SEQ, TC = NB * CTXL, TA = TL + TC;
constexpr float NORM_EPS = 1e-6f;
constexpr float LOG2E = 1.4426950408889634f;
constexpr float QSCALE = 0.125f * LOG2E;
constexpr float NEG_BIG = -1e30f;

constexpr size_t MiB = 1u << 20;
constexpr size_t WS_MOD = 1 * MiB;
constexpr size_t WS_ROPE = 2 * MiB;
constexpr size_t WS_CONST = 3 * MiB;
constexpr size_t WS_WIN = 4 * MiB;
constexpr size_t WS_WOUT = 92 * MiB;
constexpr size_t WS_WQKV = 136 * MiB;
constexpr size_t WS_WO = 148 * MiB;
constexpr size_t WS_WPOOL = 152 * MiB;
constexpr size_t WS_X = 154 * MiB;
constexpr size_t WS_H = 286 * MiB;
constexpr size_t WS_BIG = 352 * MiB;
constexpr size_t WS_PART = 550 * MiB;
constexpr size_t WS_END = 596 * MiB;
constexpr size_t QKV_STRIDE = 66 * MiB;

#ifndef REP_DIFF
#define REP_DIFF 1
#endif
#ifndef REP_NAT
#define REP_NAT 1
#endif
#ifndef REP_NORM
#define REP_NORM 1
#endif
#ifndef REP_G1
#define REP_G1 1
#endif
constexpr int LDS_BYTES = 147456;

typedef __bf16 bf16x2_t __attribute__((ext_vector_type(2)));
__device__ __forceinline__ unsigned cvt_pk_bf16(float lo, float hi) { f32x2 v = {lo, hi}; bf16x2_t b = __builtin_convertvector(v, bf16x2_t); return __builtin_bit_cast(unsigned, b); }
__device__ __forceinline__ float bf2f(unsigned short b) { return __uint_as_float(((unsigned)b) << 16); }
__device__ __forceinline__ float dpp_f(float v, int ctrl_sel) {
    const int x = __float_as_int(v); int r;
    if (ctrl_sel == 0) r = __builtin_amdgcn_update_dpp(x, x, 0xB1, 0xF, 0xF, false);
    else if (ctrl_sel == 1) r = __builtin_amdgcn_update_dpp(x, x, 0x4E, 0xF, 0xF, false);
    else if (ctrl_sel == 2) r = __builtin_amdgcn_update_dpp(x, x, 0x141, 0xF, 0xF, false);
    else r = __builtin_amdgcn_update_dpp(x, x, 0x140, 0xF, 0xF, false);
    return __int_as_float(r);
}
__device__ __forceinline__ float wave_sum(float v) {
    v += dpp_f(v, 0); v += dpp_f(v, 1); v += dpp_f(v, 2); v += dpp_f(v, 3);
    { auto rr = __builtin_amdgcn_permlane16_swap(__float_as_uint(v), __float_as_uint(v), false, false); v = __uint_as_float(rr[0]) + __uint_as_float(rr[1]); }
    { auto rr = __builtin_amdgcn_permlane32_swap(__float_as_uint(v), __float_as_uint(v), false, false); v = __uint_as_float(rr[0]) + __uint_as_float(rr[1]); }
    return v;
}
__device__ __forceinline__ int opaque_tid(int wave_s) { int l; asm volatile("v_mbcnt_lo_u32_b32 %0, -1, 0\n\tv_mbcnt_hi_u32_b32 %0, -1, %0" : "=v"(l)); return wave_s * 64 + l; }
__device__ __forceinline__ float silu_f(float v) { return v / (1.0f + __expf(-v)); }
__device__ __forceinline__ float fast_silu(float v) { return v * __builtin_amdgcn_rcpf(1.0f + __builtin_amdgcn_exp2f(-v * LOG2E)); }

namespace pg8 {
constexpr int BM = 256, BK = 64, HALF = 128, HTB = HALF * BK * 2, STAGE_BYTES = 8 * HTB, NXCD = 8, WGM = 8;
__device__ __forceinline__ int lds_byte(int r, int c) { const int st = (r >> 4) * 2 + (c >> 5), rr = r & 15, cc = c & 31, ob = rr * 64 + cc * 2; return st * 1024 + (ob ^ (((ob >> 9) & 1) << 5)); }
__device__ __forceinline__ void stage_rc(int b, int& R, int& C) { const int st = b / 1024, sb = b % 1024, swz = sb ^ (((sb >> 9) & 1) << 5); R = (st >> 1) * 16 + swz / 64; C = (st & 1) * 32 + (swz % 64) / 2; }
__device__ __forceinline__ int perm32(int rho) { const int n = rho >> 4, i = rho & 15; return 8 * (i >> 2) + 4 * n + (i & 3); }

struct Unit { int pm, pn; };
struct Gemm { const bf16_t* A; const bf16_t* Bt; int lda, ldb, K; int a_pn_off; };

struct StaticOrder {
    int nM, nN, nwg, G, c, pm0;
    __device__ void init(int M, int N, int G_, int c_, int pm0_ = 0) { nM = M / BM; nN = N / BM; nwg = nM * nN; G = G_; c = c_; pm0 = pm0_; }
    __device__ bool next(int i, Unit& u) const {
        const long L = (long)i * G + c; if (L >= nwg) return false;
        int wgid = (int)L; { const int q = nwg / NXCD, r = nwg % NXCD, xcd = wgid % NXCD, off = wgid / NXCD; wgid = (xcd < r ? xcd * (q + 1) : r * (q + 1) + (xcd - r) * q) + off; }
        const int nig = WGM * nN, gid = wgid / nig, fm = gid * WGM, gsz = (nM - fm) < WGM ? (nM - fm) : WGM;
        u.pm = pm0 + fm + ((wgid % nig) % gsz); u.pn = (wgid % nig) / gsz; return true;
    }
};

template <class Epi, int KSD = 0, int KSO = 0>
__device__ __forceinline__ void gemm_phase(LAS unsigned char* lds, int wave_s, const Gemm g, const StaticOrder& S, const Epi& E) {
    const int tid = opaque_tid(wave_s), wid = __builtin_amdgcn_readfirstlane(tid >> 6), lane = tid & 63, wr = wid >> 2, wc = wid & 3, fr = lane & 15, fq = lane >> 4;
    const int K = g.K, nt = K / BK;
    unsigned voffA[2], voffB[2];
#pragma unroll
    for (int i = 0; i < 2; ++i) { int R, C; stage_rc(tid * 16 + i * 8192, R, C); const int Rb = Epi::PERM ? ((R & ~31) + perm32(R & 31)) : R;
        voffA[i] = (unsigned)(R * g.lda + C) * 2u; voffB[i] = (unsigned)(Rb * g.ldb + C) * 2u; }
    const size_t kstep = (size_t)(BK * 2);
    const size_t hstepA = (size_t)HALF * g.lda * 2, hstepB = (size_t)HALF * g.ldb * 2;
    const size_t tstepA = 2 * hstepA, tstepB = 2 * hstepB;
    const unsigned ldsw = (unsigned)wid * 1024u;
    const int aoff = lds_byte(wr * 64 + fr, fq * 8), boff = lds_byte(wc * 32 + fr, fq * 8);
#define PG8_SA(b, h) (((b) * 2 + (h)) * HTB)
#define PG8_SB(b, h) ((4 + (b) * 2 + (h)) * HTB)
#define PG8_STAGE(bufoff, gbase, voff) do { _Pragma("unroll") for (int _i = 0; _i < 2; ++_i) \
        __builtin_amdgcn_global_load_lds((const unsigned*)((const char*)(gbase) + (voff)[_i]), (LAS unsigned*)(lds + (bufoff) + ldsw + _i * 8192), 16, 0, 0); } while (0)
#define PG8_LDA(dst, b, h) do { _Pragma("unroll") for (int m = 0; m < 4; ++m) _Pragma("unroll") for (int k = 0; k < 2; ++k) dst[m][k] = *(const LAS bf16x8*)(lds + PG8_SA(b, h) + aoff + m * 2048 + k * 1024); } while (0)
#define PG8_LDB(dst, b, h) do { _Pragma("unroll") for (int n = 0; n < 2; ++n) _Pragma("unroll") for (int k = 0; k < 2; ++k) dst[n][k] = *(const LAS bf16x8*)(lds + PG8_SB(b, h) + boff + n * 2048 + k * 1024); } while (0)
#define PG8_MMA(ai, bj, At, Bt) do { __builtin_amdgcn_s_setprio(1); _Pragma("unroll") for (int m = 0; m < 4; ++m) _Pragma("unroll") for (int n = 0; n < 2; ++n) _Pragma("unroll") for (int k = 0; k < 2; ++k) \
        acc[ai][bj][m][n] = __builtin_amdgcn_mfma_f32_16x16x32_bf16(Bt[n][k], At[m][k], acc[ai][bj][m][n], 0, 0, 0); __builtin_amdgcn_s_setprio(0); } while (0)
#define PG8_WAIT_V(n) asm volatile("s_waitcnt vmcnt(" #n ")" ::: "memory")
#define PG8_WAIT_L(n) asm volatile("s_waitcnt lgkmcnt(" #n ")" ::: "memory")
#define PG8_BAR __builtin_amdgcn_s_barrier()
#define PG8_SCHED __builtin_amdgcn_sched_barrier(0)
    Unit cur, nxt; int ui = 0;
    if (!S.next(0, cur)) return;
    f32x4 acc[2][2][4][2];
#pragma unroll
    for (int a = 0; a < 2; ++a)
#pragma unroll
        for (int b = 0; b < 2; ++b)
#pragma unroll
            for (int m = 0; m < 4; ++m)
#pragma unroll
                for (int n = 0; n < 2; ++n) acc[a][b][m][n] = (f32x4){0.f, 0.f, 0.f, 0.f};
    bf16x8 At[4][2], B0[2][2], B1[2][2];
    const char* cA; const char* cB;
    if constexpr (KSD == 0) { cA = (const char*)g.A + (size_t)cur.pm * tstepA + (size_t)cur.pn * g.a_pn_off; cB = (const char*)g.Bt + (size_t)cur.pn * tstepB; }
    else { cA = (const char*)g.A + (size_t)cur.pm * tstepA + (size_t)(cur.pn / KSD) * KSO; cB = (const char*)g.Bt + (size_t)(cur.pn % KSD) * tstepB + (size_t)(cur.pn / KSD) * KSO; }
    PG8_STAGE(PG8_SB(0, 0), cB, voffB); PG8_STAGE(PG8_SB(0, 1), cB + hstepB, voffB); PG8_STAGE(PG8_SA(0, 0), cA, voffA); PG8_STAGE(PG8_SA(0, 1), cA + hstepA, voffA);
    if (wr == 1) PG8_BAR;
    PG8_WAIT_V(2); PG8_BAR;
    PG8_STAGE(PG8_SB(1, 0), cB + kstep, voffB); PG8_STAGE(PG8_SA(1, 0), cA + kstep, voffA); PG8_STAGE(PG8_SB(1, 1), cB + hstepB + kstep, voffB);
    PG8_WAIT_V(6); PG8_BAR;
    for (;;) {
        const bool has_next = S.next(ui + 1, nxt);
        const char* nA = cA; const char* nB = cB;
        if (has_next) {
            if constexpr (KSD == 0) { nA = (const char*)g.A + (size_t)nxt.pm * tstepA + (size_t)nxt.pn * g.a_pn_off; nB = (const char*)g.Bt + (size_t)nxt.pn * tstepB; }
            else { nA = (const char*)g.A + (size_t)nxt.pm * tstepA + (size_t)(nxt.pn / KSD) * KSO; nB = (const char*)g.Bt + (size_t)(nxt.pn % KSD) * tstepB + (size_t)(nxt.pn / KSD) * KSO; } }
        for (int t = 0; t < nt; t += 2) {
            const bool last = (t == nt - 2);
            const char* a1 = cA + (size_t)(t + 1) * kstep;
            const char* a2 = last ? nA : cA + (size_t)(t + 2) * kstep; const char* b2 = last ? nB : cB + (size_t)(t + 2) * kstep;
            const char* a3 = a2 + kstep; const char* b3 = b2 + kstep;
            PG8_LDB(B0, 0, 0); PG8_LDB(B1, 0, 1); PG8_SCHED; PG8_LDA(At, 0, 0); PG8_STAGE(PG8_SA(1, 1), a1 + hstepA, voffA);
            PG8_WAIT_V(8); PG8_WAIT_L(0); PG8_BAR; PG8_MMA(0, 0, At, B0); PG8_MMA(0, 1, At, B1); PG8_BAR; PG8_SCHED;
            PG8_LDA(At, 0, 1); PG8_STAGE(PG8_SB(0, 0), b2, voffB); PG8_STAGE(PG8_SB(0, 1), b2 + hstepB, voffB); PG8_STAGE(PG8_SA(0, 0), a2, voffA);
            PG8_WAIT_V(8); PG8_WAIT_L(0); PG8_BAR; PG8_MMA(1, 0, At, B0); PG8_MMA(1, 1, At, B1); PG8_BAR; PG8_SCHED;
            PG8_LDB(B0, 1, 0); PG8_LDB(B1, 1, 1); PG8_SCHED; PG8_LDA(At, 1, 0); PG8_STAGE(PG8_SA(0, 1), a2 + hstepA, voffA);
            PG8_WAIT_V(8); PG8_WAIT_L(0); PG8_BAR; PG8_MMA(0, 0, At, B0); PG8_MMA(0, 1, At, B1); PG8_BAR; PG8_SCHED;
            PG8_LDA(At, 1, 1); PG8_STAGE(PG8_SB(1, 0), b3, voffB); PG8_STAGE(PG8_SB(1, 1), b3 + hstepB, voffB); PG8_STAGE(PG8_SA(1, 0), a3, voffA);
            PG8_WAIT_V(8); PG8_WAIT_L(0); PG8_BAR; PG8_MMA(1, 0, At, B0); PG8_MMA(1, 1, At, B1); PG8_BAR; PG8_SCHED;
        }
        if (wr == 0) PG8_BAR;
        { const int l2_ = opaque_tid(wave_s) & 63; E(acc, cur, wr, wc, l2_ & 15, l2_ >> 4); }
        if (!has_next) break;
#pragma unroll
        for (int a = 0; a < 2; ++a)
#pragma unroll
            for (int b = 0; b < 2; ++b)
#pragma unroll
                for (int m = 0; m < 4; ++m)
#pragma unroll
                    for (int n = 0; n < 2; ++n) acc[a][b][m][n] = (f32x4){0.f, 0.f, 0.f, 0.f};
        cur = nxt; cA = nA; cB = nB; ++ui;
        if (wr == 1) PG8_BAR;
    }
    PG8_WAIT_V(0);
    PG8_BAR;
#undef PG8_SA
#undef PG8_SB
#undef PG8_STAGE
#undef PG8_LDA
#undef PG8_LDB
#undef PG8_MMA
#undef PG8_WAIT_V
#undef PG8_WAIT_L
#undef PG8_BAR
#undef PG8_SCHED
}

struct EpiSwiglu {
    static constexpr bool PERM = true;
    bf16_t* O; int ldc;
    static __device__ __forceinline__ float hs(float g, float u) { return g * u * __builtin_amdgcn_rcpf(1.0f + __builtin_amdgcn_exp2f(-g)); }
    __device__ __forceinline__ void operator()(const f32x4 (&acc)[2][2][4][2], const Unit& u, int wr, int wc, int fr, int fq) const {
        const int row0 = u.pm * BM + wr * 64 + fr, col0 = u.pn * 128 + wc * 32 + 8 * fq;
#pragma unroll
        for (int ai = 0; ai < 2; ++ai)
#pragma unroll
            for (int m = 0; m < 4; ++m) {
                bf16_t* rowp = O + (size_t)(row0 + ai * HALF + m * 16) * ldc + col0;
                const f32x4 g0 = acc[ai][0][m][0], g1 = acc[ai][0][m][1], u0 = acc[ai][1][m][0], u1 = acc[ai][1][m][1];
                u32x4 w;
                w.x = cvt_pk_bf16(hs(g0[0], u0[0]), hs(g0[1], u0[1]));
                w.y = cvt_pk_bf16(hs(g0[2], u0[2]), hs(g0[3], u0[3]));
                w.z = cvt_pk_bf16(hs(g1[0], u1[0]), hs(g1[1], u1[1]));
                w.w = cvt_pk_bf16(hs(g1[2], u1[2]), hs(g1[3], u1[3]));
                *(u32x4*)rowp = w;
            }
    }
};
struct EpiResid {
    static constexpr bool PERM = true;
    h16_t* X; const float* gate_base; const float* bias; const float* cscale;
    __device__ __forceinline__ void operator()(const f32x4 (&acc)[2][2][4][2], const Unit& u, int wr, int wc, int fr, int fq) const {
        const int midx = u.pm < 128 ? (u.pm >> 5) : 4;
        const float* gate = gate_base + midx * NMODV;
        asm volatile("" : "+v"(fr), "+v"(fq));
        const int col0 = u.pn * BM + wc * 32 + 8 * fq;
#pragma unroll
        for (int bj = 0; bj < 2; ++bj) {
            const int c = col0 + bj * HALF;
            const f32x4 g0 = *(const f32x4*)(gate + c) * *(const f32x4*)(cscale + c), g1 = *(const f32x4*)(gate + c + 4) * *(const f32x4*)(cscale + c + 4);
            const f32x4 b0 = *(const f32x4*)(bias + c), b1 = *(const f32x4*)(bias + c + 4);
#pragma unroll
            for (int ai = 0; ai < 2; ++ai) {
                h16_t* p0 = X + (size_t)(u.pm * BM + ai * HALF + wr * 64 + fr) * DM + c;
                f16x8 xv[4];
#pragma unroll
                for (int m = 0; m < 4; ++m) xv[m] = *(const f16x8*)(p0 + (size_t)m * 16 * DM);
                asm volatile("" ::: "memory");
#pragma unroll
                for (int m = 0; m < 4; ++m) {
                    const f32x8 xf = __builtin_convertvector(xv[m], f32x8);
                    const f32x4 lo = (f32x4){xf[0], xf[1], xf[2], xf[3]} + g0 * (acc[ai][bj][m][0] + b0);
                    const f32x4 hh = (f32x4){xf[4], xf[5], xf[6], xf[7]} + g1 * (acc[ai][bj][m][1] + b1);
                    const f32x8 o = (f32x8){lo[0], lo[1], lo[2], lo[3], hh[0], hh[1], hh[2], hh[3]};
                    *(f16x8*)(p0 + (size_t)m * 16 * DM) = __builtin_convertvector(o, f16x8);
                }
                asm volatile("" ::: "memory");
            }
        }
    }
};
struct EpiQK {
    static constexpr bool PERM = false;
    bf16_t* Q; bf16_t* Kb; const float* rope; const float* bias; int mode;
    __device__ __forceinline__ void operator()(const f32x4 (&acc)[2][2][4][2], const Unit& u, int wr, int wc, int fr, int fq) const {
        const bool isq = u.pn < 4;
        bf16_t* base = isq ? Q : Kb;
        const float sc = isq ? QSCALE : 1.0f;
        const int colt = (u.pn & 3) * BM + wc * 32 + 4 * fq;
        const bool dorope = (mode == 0) && (u.pm < 128);
#pragma unroll
        for (int ai = 0; ai < 2; ++ai)
#pragma unroll
            for (int m = 0; m < 4; ++m) {
                const int row = u.pm * BM + ai * HALF + wr * 64 + m * 16 + fr;
                f32x4 cv = (f32x4){1.f, 1.f, 1.f, 1.f}, sv = (f32x4){0.f, 0.f, 0.f, 0.f};
                if (dorope) {
                    const int t = row & (SEQ - 1); const int pos = (wc & 1) ? (t & 63) : (t >> 6);
                    const f32x4 t0 = *(const f32x4*)(rope + (pos * 16 + 4 * fq) * 2), t1 = *(const f32x4*)(rope + (pos * 16 + 4 * fq) * 2 + 4);
                    cv = (f32x4){t0[0], t0[2], t1[0], t1[2]}; sv = (f32x4){t0[1], t0[3], t1[1], t1[3]};
                }
#pragma unroll
                for (int bj = 0; bj < 2; ++bj) {
                    const int bc = u.pn * BM + bj * HALF + wc * 32 + 4 * fq;
                    const f32x4 x1 = acc[ai][bj][m][0] + *(const f32x4*)(bias + bc), x2 = acc[ai][bj][m][1] + *(const f32x4*)(bias + bc + 16);
                    const f32x4 o1 = (x1 * cv - x2 * sv) * sc, o2 = (x2 * cv + x1 * sv) * sc;
                    bf16_t* p = base + (size_t)row * DM + colt + bj * HALF;
                    u32x2 w1, w2; w1.x = cvt_pk_bf16(o1[0], o1[1]); w1.y = cvt_pk_bf16(o1[2], o1[3]); w2.x = cvt_pk_bf16(o2[0], o2[1]); w2.y = cvt_pk_bf16(o2[2], o2[3]);
                    *(u32x2*)p = w1; *(u32x2*)(p + 16) = w2;
                }
                asm volatile("" ::: "memory");
            }
    }
};
struct EpiPartial {
    static constexpr bool PERM = false;
    float* O; int ldc;
    __device__ __forceinline__ void operator()(const f32x4 (&acc)[2][2][4][2], const Unit& u, int wr, int wc, int fr, int fq) const {
        asm volatile("" : "+v"(fr), "+v"(fq));
        const unsigned base = (unsigned)(((u.pm - 128) * BM + wr * 64 + fr) * ldc + u.pn * BM + wc * 32 + 4 * fq) * 4u;
#pragma unroll
        for (int ai = 0; ai < 2; ++ai)
#pragma unroll
            for (int m = 0; m < 4; ++m) {
                char* rp = (char*)O + (base + (unsigned)((ai * HALF + m * 16) * ldc) * 4u);
#pragma unroll
                for (int bj = 0; bj < 2; ++bj)
#pragma unroll
                    for (int n = 0; n < 2; ++n) *(f32x4*)(rp + (bj * HALF + n * 16) * 4) = acc[ai][bj][m][n];
                asm volatile("" ::: "memory");
            }
    }
};
struct EpiVt {
    static constexpr bool PERM = true;
    bf16_t* O; int ldc; const float* rbias;
    __device__ __forceinline__ void operator()(const f32x4 (&acc)[2][2][4][2], const Unit& u, int wr, int wc, int fr, int fq) const {
        const int row0 = u.pm * BM + wr * 64 + fr, col0 = u.pn * BM + wc * 32 + 8 * fq;
#pragma unroll
        for (int ai = 0; ai < 2; ++ai)
#pragma unroll
            for (int m = 0; m < 4; ++m) {
                const int row = row0 + ai * HALF + m * 16;
                const float b = rbias[row];
                bf16_t* rowp = O + (size_t)row * ldc + col0;
#pragma unroll
                for (int bj = 0; bj < 2; ++bj) {
                    const f32x4 v0 = acc[ai][bj][m][0] + b, v1 = acc[ai][bj][m][1] + b;
                    u32x4 w; w.x = cvt_pk_bf16(v0[0], v0[1]); w.y = cvt_pk_bf16(v0[2], v0[3]); w.z = cvt_pk_bf16(v1[0], v1[1]); w.w = cvt_pk_bf16(v1[2], v1[3]);
                    *(u32x4*)(rowp + bj * HALF) = w;
                }
            }
    }
};
}

struct Args { const float* in[21]; float* out; unsigned char* ws; };

struct Ctx {
    LAS unsigned char* lds;
    int tid, lane, wave, G, bid, wave_s;
    __device__ __forceinline__ void refresh() { tid = opaque_tid(wave_s); lane = tid & 63; wave = __builtin_amdgcn_readfirstlane(tid >> 6); }
};

__device__ __forceinline__ void transpose_item(const float* W, int ldw, int k0, int n0, bf16_t* WT, int ldt, int dst_row0, LAS float* scr, int lane, float wscale = 1.0f) {
#pragma unroll 8
    for (int i = 0; i < 32; ++i) { const int kk = 2 * i + (lane >> 5); scr[kk * 33 + (lane & 31)] = W[(size_t)(k0 + kk) * ldw + n0 + (lane & 31)] * wscale; }
    asm volatile("s_waitcnt lgkmcnt(0)" ::: "memory");
    const int c = lane & 7;
#pragma unroll
    for (int j = 0; j < 4; ++j) { const int n = (lane >> 3) + 8 * j; const LAS float* s = scr + (8 * c) * 33 + n;
        u32x4 o; o.x = cvt_pk_bf16(s[0 * 33], s[1 * 33]); o.y = cvt_pk_bf16(s[2 * 33], s[3 * 33]); o.z = cvt_pk_bf16(s[4 * 33], s[5 * 33]); o.w = cvt_pk_bf16(s[6 * 33], s[7 * 33]);
        *(u32x4*)(WT + (size_t)(dst_row0 + n) * ldt + k0 + 8 * c) = o; }
    asm volatile("s_waitcnt lgkmcnt(0)" ::: "memory");
}

__device__ __forceinline__ void prologue_phase(const Ctx& F0, const Args& a) {
    Ctx F = F0; F.refresh();
    unsigned char* ws = a.ws;
    {
        LAS float* sv = (LAS float*)F.lds;
        LAS float* red = (LAS float*)(F.lds + 20480);
        for (int i = F.tid; i < 5 * 1024; i += 512) { const int m = i >> 10, k = i & 1023; const float v = m < 4 ? a.in[1][m * 1024 + k] : a.in[3][k]; sv[i] = silu_f(v); }
        __syncthreads();
        float* mod = (float*)(ws + WS_MOD);
        for (int u = F.bid; u < 4 * 72; u += F.G) {
            const int layer = u / 72, col0 = (u % 72) * 128;
            const float* W = a.in[4] + (size_t)layer * 1024 * NMODV + col0 + 2 * F.lane;
            float acc[5][2];
#pragma unroll
            for (int m = 0; m < 5; ++m) { acc[m][0] = 0.f; acc[m][1] = 0.f; }
            const int kb = F.wave * 128;
#pragma unroll 4
            for (int k = 0; k < 128; ++k) {
                const f32x2 w = *(const f32x2*)(W + (size_t)(kb + k) * NMODV);
#pragma unroll
                for (int m = 0; m < 5; ++m) { const float s = sv[m * 1024 + kb + k]; acc[m][0] += s * w.x; acc[m][1] += s * w.y; }
            }
#pragma unroll
            for (int m = 0; m < 5; ++m) { red[(F.wave * 5 + m) * 128 + 2 * F.lane] = acc[m][0]; red[(F.wave * 5 + m) * 128 + 2 * F.lane + 1] = acc[m][1]; }
            __syncthreads();
            for (int i = F.tid; i < 640; i += 512) { const int m = i >> 7, cc = i & 127; float s = a.in[5][layer * NMODV + col0 + cc];
#pragma unroll
                for (int w = 0; w < 8; ++w) s += red[(w * 5 + m) * 128 + cc];
                mod[((size_t)layer * 5 + m) * NMODV + col0 + cc] = s; }
            __syncthreads();
        }
    }
    {
        h16_t* X = (h16_t*)(ws + WS_X);
        const size_t n8 = (size_t)TA * DM / 8, nl8 = (size_t)TL * DM / 8;
        for (size_t i = (size_t)F.bid * 512 + F.tid; i < n8; i += (size_t)F.G * 512) {
            const float* sp = i < nl8 ? a.in[0] + i * 8 : a.in[2] + (i - nl8) * 8;
            const f32x4 p = *(const f32x4*)sp, q = *(const f32x4*)(sp + 4);
            const f32x8 o = (f32x8){p[0], p[1], p[2], p[3], q[0], q[1], q[2], q[3]};
            *(f16x8*)(X + i * 8) = __builtin_convertvector(o, f16x8);
        }
    }
    if (F.bid == 0) { float* cz = (float*)(ws + WS_CONST); for (int i = F.tid; i < 5120; i += 512) cz[i] = i < 3072 ? 0.f : (i < 4096 ? 1.f : 0.5f); }
    {
        float* rope = (float*)(ws + WS_ROPE);
        const int gi = F.bid * 512 + F.tid;
        if (gi < 128 * 16) { const int pos = gi >> 4, f = gi & 15; const float inv = powf(10000.0f, -(float)(2 * f) / 32.0f); const float ang = (float)pos * inv; rope[gi * 2] = cosf(ang); rope[gi * 2 + 1] = sinf(ang); }
    }
    {
        LAS float* scr = (LAS float*)(F.lds + 32768 + F.wave * 8704);
        const int gw = F.bid * 8 + F.wave, NGW = F.G * 8;
        constexpr int I_IN = 16 * 176, I_OUT = 44 * 32, I_QKV = 16 * 96, I_O = 16 * 32, I_P = 4 * 8;
        constexpr int N_IN = 8 * I_IN, N_OUT = 8 * I_OUT, N_QKV = 2 * I_QKV, N_O = 2 * I_O, N_P = 8 * I_P;
        for (int it = gw; it < N_IN + N_OUT + N_QKV + N_O + N_P; it += NGW) {
            int r = it;
            if (r < N_IN) { const int mat = r / I_IN, l = r % I_IN, kb = l / 176, nb = l % 176; const int n0 = nb * 32;
                const int j = n0 < DFF ? n0 : n0 - DFF; const int dst = 256 * (j >> 7) + (n0 < DFF ? 0 : 128) + (j & 127);
                transpose_item(a.in[7] + (size_t)mat * 1024 * 5632, 5632, kb * 64, n0, (bf16_t*)(ws + WS_WIN) + (size_t)mat * 5632 * 1024, 1024, dst, scr, F.lane, n0 < DFF ? LOG2E : 0.6931471805599453f); continue; }
            r -= N_IN;
            if (r < N_OUT) { const int mat = r / I_OUT, l = r % I_OUT, kb = l / 32, nb = l % 32;
                transpose_item(a.in[8] + (size_t)mat * DFF * 1024, 1024, kb * 64, nb * 32, (bf16_t*)(ws + WS_WOUT) + (size_t)mat * 1024 * DFF, DFF, nb * 32, scr, F.lane); continue; }
            r -= N_OUT;
            if (r < N_QKV) { const int mat = r / I_QKV, l = r % I_QKV, kb = l / 96, nb = l % 96;
                transpose_item(mat == 0 ? a.in[11] : a.in[15], 3072, kb * 64, nb * 32, (bf16_t*)(ws + WS_WQKV) + (size_t)mat * 3072 * 1024, 1024, nb * 32, scr, F.lane); continue; }
            r -= N_QKV;
            if (r < N_O) { const int mat = r / I_O, l = r % I_O, kb = l / 32, nb = l % 32;
                transpose_item(mat == 0 ? a.in[14] : a.in[18], 1024, kb * 64, nb * 32, (bf16_t*)(ws + WS_WO) + (size_t)mat * 1024 * 1024, 1024, nb * 32, scr, F.lane); continue; }
            r -= N_O;
            { const int mat = r / I_P, l = r % I_P, kb = l / 8, nb = l % 8;
                transpose_item(a.in[9] + (size_t)mat * 256 * 256, 256, kb * 64, nb * 32, (bf16_t*)(ws + WS_WPOOL) + (size_t)mat * 256 * 256, 256, nb * 32, scr, F.lane); }
        }
    }
}

__device__ __forceinline__ void normmod_phase(const Ctx& F0, h16_t* X, int T, const float* g, const float* modL, int slot_shift, int slot_scale, bf16_t* H,
                                              const float* part, const float* pgate) {
    Ctx F = F0; F.refresh();
    const int gw = F.bid * 8 + F.wave, NGW = F.G * 8;
    const int RPW = (TL + NGW - 1) / NGW;
    const int r0 = gw * RPW, r1 = (r0 + RPW) < TL ? (r0 + RPW) : TL;
    const int nrows = (r1 > r0 ? r1 - r0 : 0) + ((T > TL && gw < TC) ? 1 : 0);
    int cur = -1; f32x4 gm[4], sh[4];
#pragma unroll
    for (int j = 0; j < 4; ++j) { gm[j] = (f32x4){0.f, 0.f, 0.f, 0.f}; sh[j] = gm[j]; }
    for (int ir = 0; ir < nrows; ++ir) {
        const int row = (r0 + ir) < r1 ? (r0 + ir) : (TL + gw);
        const int midx = row < TL ? (row >> 13) : 4;
        if (midx != cur) { cur = midx;
#pragma unroll
            for (int j = 0; j < 4; ++j) { const int c = 512 * (j >> 1) + 8 * F.lane + 4 * (j & 1); const f32x4 gv = *(const f32x4*)(g + c), sc = *(const f32x4*)(modL + midx * NMODV + slot_scale * 1024 + c);
                gm[j] = gv * (sc + 1.0f); sh[j] = *(const f32x4*)(modL + midx * NMODV + slot_shift * 1024 + c); } }
        h16_t* xr = X + (size_t)row * DM;
        f32x4 v[4]; float ss = 0.f;
#pragma unroll
        for (int jj = 0; jj < 2; ++jj) { const f32x8 xf = __builtin_convertvector(*(const f16x8*)(xr + 512 * jj + 8 * F.lane), f32x8);
            v[2 * jj] = (f32x4){xf[0], xf[1], xf[2], xf[3]}; v[2 * jj + 1] = (f32x4){xf[4], xf[5], xf[6], xf[7]}; }
        if (part != nullptr && row >= TL) {
            const float* pr = part + (size_t)(row - TL) * (11 * DM) + 8 * F.lane;
            f32x4 s[4];
#pragma unroll
            for (int j = 0; j < 4; ++j) s[j] = (f32x4){0.f, 0.f, 0.f, 0.f};
#pragma unroll 1
            for (int sl = 0; sl < 11; ++sl) {
#pragma unroll
                for (int j = 0; j < 4; ++j) s[j] = s[j] + *(const f32x4*)(pr + sl * DM + 512 * (j >> 1) + 4 * (j & 1));
            }
#pragma unroll
            for (int j = 0; j < 4; ++j) v[j] = v[j] + s[j] * (*(const f32x4*)(pgate + 512 * (j >> 1) + 8 * F.lane + 4 * (j & 1)) * 0.5f);
#pragma unroll
            for (int jj = 0; jj < 2; ++jj) { const f32x8 o = (f32x8){v[2 * jj][0], v[2 * jj][1], v[2 * jj][2], v[2 * jj][3], v[2 * jj + 1][0], v[2 * jj + 1][1], v[2 * jj + 1][2], v[2 * jj + 1][3]};
                const f16x8 oh = __builtin_convertvector(o, f16x8);
                *(f16x8*)(xr + 512 * jj + 8 * F.lane) = oh;
                const f32x8 back = __builtin_convertvector(oh, f32x8);
                v[2 * jj] = (f32x4){back[0], back[1], back[2], back[3]}; v[2 * jj + 1] = (f32x4){back[4], back[5], back[6], back[7]}; }
        }
#pragma unroll
        for (int j = 0; j < 4; ++j) ss += (v[j][0] * v[j][0] + v[j][1] * v[j][1]) + (v[j][2] * v[j][2] + v[j][3] * v[j][3]);
        const float r = 1.0f / sqrtf(wave_sum(ss) * (1.0f / DM) + NORM_EPS);
        bf16_t* o = H + (size_t)row * DM;
#pragma unroll
        for (int jj = 0; jj < 2; ++jj) { const f32x4 y0 = v[2 * jj] * r * gm[2 * jj] + sh[2 * jj], y1 = v[2 * jj + 1] * r * gm[2 * jj + 1] + sh[2 * jj + 1];
            u32x4 w; w.x = cvt_pk_bf16(y0[0], y0[1]); w.y = cvt_pk_bf16(y0[2], y0[3]); w.z = cvt_pk_bf16(y1[0], y1[1]); w.w = cvt_pk_bf16(y1[2], y1[3]);
            *(u32x4*)(o + 512 * jj + 8 * F.lane) = w; }
    }
}
__device__ __forceinline__ void final_norm_phase(const Ctx& F0, const h16_t* x, const float* g, float* out) {
    Ctx F = F0; F.refresh();
    const int gw = F.bid * 8 + F.wave, NGW = F.G * 8;
    f32x4 gv[4];
#pragma unroll
    for (int j = 0; j < 4; ++j) gv[j] = *(const f32x4*)(g + 512 * (j >> 1) + 8 * F.lane + 4 * (j & 1));
    for (int row = gw; row < TL; row += NGW) {
        const h16_t* xr = x + (size_t)row * DM;
        f32x4 v[4]; float ss = 0.f;
#pragma unroll
        for (int jj = 0; jj < 2; ++jj) { const f32x8 xf = __builtin_convertvector(*(const f16x8*)(xr + 512 * jj + 8 * F.lane), f32x8);
            v[2 * jj] = (f32x4){xf[0], xf[1], xf[2], xf[3]}; v[2 * jj + 1] = (f32x4){xf[4], xf[5], xf[6], xf[7]}; }
#pragma unroll
        for (int j = 0; j < 4; ++j) ss += (v[j][0] * v[j][0] + v[j][1] * v[j][1]) + (v[j][2] * v[j][2] + v[j][3] * v[j][3]);
        const float r = 1.0f / sqrtf(wave_sum(ss) * (1.0f / DM) + NORM_EPS);
#pragma unroll
        for (int j = 0; j < 4; ++j) *(f32x4*)(out + (size_t)row * DM + 512 * (j >> 1) + 8 * F.lane + 4 * (j & 1)) = v[j] * r * gv[j];
    }
}

__device__ __forceinline__ void bf8_to_f(const u32x4 w, float (&f)[8]) {
    f[0] = __uint_as_float(w.x << 16); f[1] = __uint_as_float(w.x & 0xffff0000u); f[2] = __uint_as_float(w.y << 16); f[3] = __uint_as_float(w.y & 0xffff0000u);
    f[4] = __uint_as_float(w.z << 16); f[5] = __uint_as_float(w.z & 0xffff0000u); f[6] = __uint_as_float(w.w << 16); f[7] = __uint_as_float(w.w & 0xffff0000u);
}
__device__ __forceinline__ void pool_diff_phase(const Ctx& F0, const bf16_t* H, bf16_t* Dd, int T) {
    Ctx F = F0; F.refresh();
    const int gw = F.bid * 8 + F.wave, NGW = F.G * 8;
    const int NI = (T >> 4) * 2;
    for (int it = gw; it < NI; it += NGW) {
        const int row0 = (it >> 1) << 4, col = (it & 1) * 512 + F.lane * 8;
        const int grp = col >> 8, win = 2 << grp, hw = win >> 1;
        int seq0, n;
        if (row0 < TL) { seq0 = row0 & ~(SEQ - 1); n = SEQ; } else { seq0 = TL + ((row0 - TL) & ~(CTXL - 1)); n = CTXL; }
        const bf16_t* base = H + (size_t)seq0 * DM + col;
        const int t0 = row0 - seq0;
        int lo = (t0 - hw) > 0 ? (t0 - hw) : 0, hi = (t0 + hw - 1) < (n - 1) ? (t0 + hw - 1) : (n - 1);
        float s[8];
#pragma unroll
        for (int i = 0; i < 8; ++i) s[i] = 0.f;
        for (int rr = lo; rr <= hi; ++rr) { float f[8]; bf8_to_f(*(const u32x4*)(base + (size_t)rr * DM), f);
#pragma unroll
            for (int i = 0; i < 8; ++i) s[i] += f[i]; }
        for (int k = 0; k < 16; ++k) {
            const int t = t0 + k;
            const int nlo = (t - hw) > 0 ? (t - hw) : 0, nhi = (t + hw - 1) < (n - 1) ? (t + hw - 1) : (n - 1);
            if (nlo > lo) { float f[8]; bf8_to_f(*(const u32x4*)(base + (size_t)lo * DM), f);
#pragma unroll
                for (int i = 0; i < 8; ++i) s[i] -= f[i]; }
            if (nhi > hi) { float f[8]; bf8_to_f(*(const u32x4*)(base + (size_t)nhi * DM), f);
#pragma unroll
                for (int i = 0; i < 8; ++i) s[i] += f[i]; }
            lo = nlo; hi = nhi;
            const float inv = 1.0f / (float)(hi - lo + 1);
            float c[8]; bf8_to_f(*(const u32x4*)(base + (size_t)t * DM), c);
            u32x4 ov; ov.x = cvt_pk_bf16(s[0] * inv - c[0], s[1] * inv - c[1]); ov.y = cvt_pk_bf16(s[2] * inv - c[2], s[3] * inv - c[3]);
            ov.z = cvt_pk_bf16(s[4] * inv - c[4], s[5] * inv - c[5]); ov.w = cvt_pk_bf16(s[6] * inv - c[6], s[7] * inv - c[7]);
            *(u32x4*)(Dd + (size_t)(row0 + k) * DM + col) = ov;
        }
    }
}

template <int KROWB> __device__ __forceinline__ int kswz(int key) { return KROWB == 256 ? (key & 15) : ((key >> 1) & 7); }

constexpr float ATT_THR = 8.0f;
template <int NEB, int KROWB, int MASK>
__device__ __forceinline__ void attn_qk(const LAS unsigned char* Kt, int kchunk0, const bf16x8 (&qf)[4], f32x16 (&o)[NEB], f32x16& negm, float& mref, float& lrun, bool& first, int l31, int hi,
                                        const LAS float* brow, int qc, int cs, bf16x8 (&pb)[4]) {
    f32x16 s0, s1;
#pragma clang loop unroll(disable)
    for (;;) {
#pragma unroll
        for (int d0 = 0; d0 < 4; ++d0) {
            const int ch = kchunk0 + 2 * d0 + hi;
            const int k0 = l31, k1 = 32 + l31;
            const bf16x8 a0 = *(const LAS bf16x8*)(Kt + k0 * KROWB + ((ch ^ kswz<KROWB>(k0)) << 4));
            const bf16x8 a1 = *(const LAS bf16x8*)(Kt + k1 * KROWB + ((ch ^ kswz<KROWB>(k1)) << 4));
            if (d0 == 0) { s0 = __builtin_amdgcn_mfma_f32_32x32x16_bf16(a0, qf[0], negm, 0, 0, 0); s1 = __builtin_amdgcn_mfma_f32_32x32x16_bf16(a1, qf[0], negm, 0, 0, 0); }
            else { s0 = __builtin_amdgcn_mfma_f32_32x32x16_bf16(a0, qf[d0], s0, 0, 0, 0); s1 = __builtin_amdgcn_mfma_f32_32x32x16_bf16(a1, qf[d0], s1, 0, 0, 0); }
        }
        if (MASK == 1) {
#pragma unroll
            for (int r = 0; r < 16; ++r) {
                const int kc0 = (r & 3) + 8 * (r >> 2) + 4 * hi, kc1 = kc0 + 32;
                const bool v0 = (unsigned)(kc0 - cs) < 16u, v1 = (unsigned)(kc1 - cs) < 16u;
                const int i0 = v0 ? (kc0 - qc + 15) : 0, i1 = v1 ? (kc1 - qc + 15) : 0;
                const float b0 = brow[i0], b1 = brow[i1];
                s0[r] = v0 ? s0[r] + b0 : NEG_BIG; s1[r] = v1 ? s1[r] + b1 : NEG_BIG;
            }
        }
        float mx = fmaxf(fmaxf(s0[0], s1[0]), fmaxf(s0[1], s1[1]));
#pragma unroll
        for (int r = 2; r < 16; r += 2) mx = fmaxf(fmaxf(mx, s0[r]), fmaxf(s1[r], fmaxf(s0[r + 1], s1[r + 1])));
        mx = fmaxf(mx, __shfl_xor(mx, 32));
        if (__builtin_expect(!(first || __any(mx > ATT_THR)), 1)) break;
        const float dl = first ? mx : fmaxf(mx, 0.f);
        const float f = first ? 1.0f : __builtin_amdgcn_exp2f(-dl);
        first = false;
        mref += dl; lrun *= f;
#pragma unroll
        for (int r = 0; r < 16; ++r) negm[r] = -mref;
#pragma unroll
        for (int eb = 0; eb < NEB; ++eb)
#pragma unroll
            for (int r = 0; r < 16; ++r) o[eb][r] *= f;
        asm volatile("" : "+v"(negm));
    }
#pragma unroll
    for (int r = 0; r < 16; ++r) { s0[r] = __builtin_amdgcn_exp2f(s0[r]); s1[r] = __builtin_amdgcn_exp2f(s1[r]); }
    float ps = s0[0] + s1[0];
#pragma unroll
    for (int r = 1; r < 16; ++r) { ps += s0[r]; ps += s1[r]; }
    lrun += ps;
    {
        u32x4 w;
        w.x = cvt_pk_bf16(s0[0], s0[1]); w.y = cvt_pk_bf16(s0[2], s0[3]); w.z = cvt_pk_bf16(s0[4], s0[5]); w.w = cvt_pk_bf16(s0[6], s0[7]); pb[0] = __builtin_bit_cast(bf16x8, w);
        w.x = cvt_pk_bf16(s0[8], s0[9]); w.y = cvt_pk_bf16(s0[10], s0[11]); w.z = cvt_pk_bf16(s0[12], s0[13]); w.w = cvt_pk_bf16(s0[14], s0[15]); pb[1] = __builtin_bit_cast(bf16x8, w);
        w.x = cvt_pk_bf16(s1[0], s1[1]); w.y = cvt_pk_bf16(s1[2], s1[3]); w.z = cvt_pk_bf16(s1[4], s1[5]); w.w = cvt_pk_bf16(s1[6], s1[7]); pb[2] = __builtin_bit_cast(bf16x8, w);
        w.x = cvt_pk_bf16(s1[8], s1[9]); w.y = cvt_pk_bf16(s1[10], s1[11]); w.z = cvt_pk_bf16(s1[12], s1[13]); w.w = cvt_pk_bf16(s1[14], s1[15]); pb[3] = __builtin_bit_cast(bf16x8, w);
    }
}
template <int KROWB>
__device__ __forceinline__ float attn_max(const LAS unsigned char* Kt, int kchunk0, const bf16x8 (&qf)[4], int l31, int hi) {
    f32x16 s0, s1;
#pragma unroll
    for (int r = 0; r < 16; ++r) { s0[r] = 0.f; s1[r] = 0.f; }
#pragma unroll
    for (int d0 = 0; d0 < 4; ++d0) {
        const int ch = kchunk0 + 2 * d0 + hi;
        const int k0 = l31, k1 = 32 + l31;
        const bf16x8 a0 = *(const LAS bf16x8*)(Kt + k0 * KROWB + ((ch ^ kswz<KROWB>(k0)) << 4));
        const bf16x8 a1 = *(const LAS bf16x8*)(Kt + k1 * KROWB + ((ch ^ kswz<KROWB>(k1)) << 4));
        s0 = __builtin_amdgcn_mfma_f32_32x32x16_bf16(a0, qf[d0], s0, 0, 0, 0); s1 = __builtin_amdgcn_mfma_f32_32x32x16_bf16(a1, qf[d0], s1, 0, 0, 0);
    }
    float mx = fmaxf(fmaxf(s0[0], s1[0]), fmaxf(s0[1], s1[1]));
#pragma unroll
    for (int r = 2; r < 16; r += 2) mx = fmaxf(fmaxf(mx, s0[r]), fmaxf(s1[r], fmaxf(s0[r + 1], s1[r + 1])));
    return fmaxf(mx, __shfl_xor(mx, 32));
}
template <int NEB, int KROWB, int MASK>
__device__ __forceinline__ void attn_qk_fast(const LAS unsigned char* Kt, int kchunk0, const bf16x8 (&qf)[4], const f32x16& negm, float& lrun, int l31, int hi,
                                             const LAS float* brow, int qc, int cs, bf16x8 (&pb)[4]) {
    f32x16 s0, s1;
#pragma unroll
    for (int d0 = 0; d0 < 4; ++d0) {
        const int ch = kchunk0 + 2 * d0 + hi;
        const int k0 = l31, k1 = 32 + l31;
        const bf16x8 a0 = *(const LAS bf16x8*)(Kt + k0 * KROWB + ((ch ^ kswz<KROWB>(k0)) << 4));
        const bf16x8 a1 = *(const LAS bf16x8*)(Kt + k1 * KROWB + ((ch ^ kswz<KROWB>(k1)) << 4));
        if (d0 == 0) { s0 = __builtin_amdgcn_mfma_f32_32x32x16_bf16(a0, qf[0], negm, 0, 0, 0); s1 = __builtin_amdgcn_mfma_f32_32x32x16_bf16(a1, qf[0], negm, 0, 0, 0); }
        else { s0 = __builtin_amdgcn_mfma_f32_32x32x16_bf16(a0, qf[d0], s0, 0, 0, 0); s1 = __builtin_amdgcn_mfma_f32_32x32x16_bf16(a1, qf[d0], s1, 0, 0, 0); }
    }
    if (MASK == 1) {
#pragma unroll
        for (int r = 0; r < 16; ++r) {
            const int kc0 = (r & 3) + 8 * (r >> 2) + 4 * hi, kc1 = kc0 + 32;
            const bool v0 = (unsigned)(kc0 - cs) < 16u, v1 = (unsigned)(kc1 - cs) < 16u;
            const int i0 = v0 ? (kc0 - qc + 15) : 0, i1 = v1 ? (kc1 - qc + 15) : 0;
            const float b0 = brow[i0], b1 = brow[i1];
            s0[r] = v0 ? s0[r] + b0 : NEG_BIG; s1[r] = v1 ? s1[r] + b1 : NEG_BIG;
        }
    }
#pragma unroll
    for (int r = 0; r < 16; ++r) { s0[r] = __builtin_amdgcn_exp2f(s0[r]); s1[r] = __builtin_amdgcn_exp2f(s1[r]); }
    float ps = s0[0] + s1[0];
#pragma unroll
    for (int r = 1; r < 16; ++r) { ps += s0[r]; ps += s1[r]; }
    lrun += ps;
    {
        u32x4 w;
        w.x = cvt_pk_bf16(s0[0], s0[1]); w.y = cvt_pk_bf16(s0[2], s0[3]); w.z = cvt_pk_bf16(s0[4], s0[5]); w.w = cvt_pk_bf16(s0[6], s0[7]); pb[0] = __builtin_bit_cast(bf16x8, w);
        w.x = cvt_pk_bf16(s0[8], s0[9]); w.y = cvt_pk_bf16(s0[10], s0[11]); w.z = cvt_pk_bf16(s0[12], s0[13]); w.w = cvt_pk_bf16(s0[14], s0[15]); pb[1] = __builtin_bit_cast(bf16x8, w);
        w.x = cvt_pk_bf16(s1[0], s1[1]); w.y = cvt_pk_bf16(s1[2], s1[3]); w.z = cvt_pk_bf16(s1[4], s1[5]); w.w = cvt_pk_bf16(s1[6], s1[7]); pb[2] = __builtin_bit_cast(bf16x8, w);
        w.x = cvt_pk_bf16(s1[8], s1[9]); w.y = cvt_pk_bf16(s1[10], s1[11]); w.z = cvt_pk_bf16(s1[12], s1[13]); w.w = cvt_pk_bf16(s1[14], s1[15]); pb[3] = __builtin_bit_cast(bf16x8, w);
    }
}
template <int NEB>
__device__ __forceinline__ void attn_pv(const LAS unsigned char* Vt, const bf16x8 (&pb)[4], f32x16 (&o)[NEB], int l31, int hi) {
    const int sw = (l31 >> 1) & 7;
    const LAS unsigned char* vrow = Vt + l31 * 128;
#pragma unroll
    for (int G = 0; G < 4; ++G) {
        const int coff = ((2 * G + hi) ^ sw) << 4;
#pragma unroll
        for (int eb = 0; eb < NEB; ++eb) {
            const bf16x8 vf = *(const LAS bf16x8*)(vrow + eb * 4096 + coff);
            o[eb] = __builtin_amdgcn_mfma_f32_32x32x16_bf16(vf, pb[G], o[eb], 0, 0, 0);
        }
    }
}

__device__ __forceinline__ void diff_attn_phase(const Ctx& F0, const bf16_t* Q, const bf16_t* Kb, const bf16_t* Vt, bf16_t* ATT, const float* lamp, const float* subg, float lam_init, bool want_ctx) {
    Ctx F = F0; F.refresh();
    const int l31 = F.lane & 31, hi = F.lane >> 5;
    const int sub = F.wave >> 1, j = F.wave & 1;
    float lam_full;
    { const float p01 = lamp[F.lane] * lamp[64 + F.lane], p23 = lamp[128 + F.lane] * lamp[192 + F.lane];
      lam_full = __expf(wave_sum(p01)) - __expf(wave_sum(p23)) + lam_init; }
    const int xcd = F.bid & 7, wi = F.bid >> 3, nwi = F.G >> 3;
    const int n_lat_rounds = (4 * 64 + nwi - 1) / nwi;
    const int total_rounds = n_lat_rounds + (want_ctx ? 1 : 0);
    for (int rd = 0; rd < total_rounds; ++rd) {
        int b, h, qrow0, ntile; bool is_ctx = false;
        if (rd < n_lat_rounds) {
            const int li = rd * nwi + wi; if (li >= 256) continue;
            const int bh = xcd + 8 * (li >> 6), qb = li & 63;
            b = bh >> 3; h = bh & 7; qrow0 = b * SEQ + qb * 128; ntile = 132;
        } else {
            if (F.bid >= 64) continue;
            b = F.bid >> 4; h = (F.bid >> 1) & 7; qrow0 = TL + b * CTXL + (F.bid & 1) * 128; ntile = 4; is_ctx = true;
        }
        const int krow_lat = b * SEQ, krow_ctx = TL + b * CTXL;
        bf16x8 qf[4];
        { const char* qbase = (const char*)Q + ((size_t)(qrow0 + sub * 32) * DM + h * 128 + j * 64) * 2;
          const unsigned qoff = (unsigned)(l31 * DM + hi * 8) * 2u;
#pragma unroll
          for (int d0 = 0; d0 < 4; ++d0) qf[d0] = *(const bf16x8*)(qbase + qoff + d0 * 32); }
        f32x16 o[4]; float lrun; f32x16 negm;
        const int kkey = F.tid >> 4, kch = F.tid & 15;
        const int ve = F.tid >> 3, vc = F.tid & 7;
        const unsigned kgoff = (unsigned)(kkey * DM + kch * 8) * 2u, vgoff = (unsigned)(ve * TA + vc * 8) * 2u;
        const unsigned klds = (unsigned)(kkey * 256 + ((kch ^ (kkey & 15)) << 4));
        const unsigned vsw = (unsigned)((ve >> 1) & 7);
        const unsigned vlds0 = (unsigned)(16384 + ve * 128 + (((2 * (vc >> 1)) ^ vsw) << 4) + (vc & 1) * 8), vlds1 = (unsigned)(16384 + ve * 128 + (((2 * (vc >> 1) + 1) ^ vsw) << 4) + (vc & 1) * 8);
        const char* kg_u = (const char*)Kb + (size_t)(h * 128) * 2;
        const char* vg_u = (const char*)Vt + (size_t)(h * 128) * TA * 2;
        u32x4 rk[2], rv[2];
#define DA_KROW(t) ((is_ctx || (t) >= 128) ? (krow_ctx + 64 * ((t) - (is_ctx ? 0 : 128))) : (krow_lat + 64 * (t)))
#define DA_LOAD(t) do { const int kr_ = DA_KROW(t); const char* kp_ = kg_u + (size_t)kr_ * (DM * 2); const char* vp_ = vg_u + (size_t)kr_ * 2; \
            rk[0] = *(const u32x4*)(kp_ + kgoff); rk[1] = *(const u32x4*)(kp_ + (size_t)(32 * DM * 2) + kgoff); \
            rv[0] = *(const u32x4*)(vp_ + vgoff); rv[1] = *(const u32x4*)(vp_ + (size_t)64 * TA * 2 + vgoff); } while (0)
#define DA_STORE(st) do { LAS unsigned char* sb_ = F.lds + (st) * 32768; \
            *(LAS u32x4*)(sb_ + klds) = rk[0]; *(LAS u32x4*)(sb_ + klds + 32 * 256) = rk[1]; \
            *(LAS u32x2*)(sb_ + vlds0) = (u32x2){rv[0].x, rv[0].y}; *(LAS u32x2*)(sb_ + vlds1) = (u32x2){rv[0].z, rv[0].w}; \
            *(LAS u32x2*)(sb_ + vlds0 + 64 * 128) = (u32x2){rv[1].x, rv[1].y}; *(LAS u32x2*)(sb_ + vlds1 + 64 * 128) = (u32x2){rv[1].z, rv[1].w}; } while (0)
        for (int attempt = 0; ; ++attempt) {
            const int nref = attempt == 0 ? 0 : ntile;
            float mrow = attempt == 0 ? 0.f : NEG_BIG;
            if (nref > 0) { DA_LOAD(0); DA_STORE(0); }
            __syncthreads();
            for (int t = 0; t < nref; ++t) {
                const bool more = (t + 1) < nref;
                if (more) DA_LOAD(t + 1);
                mrow = fmaxf(mrow, attn_max<256>(F.lds + (t & 1) * 32768, 8 * j, qf, l31, hi));
                if (more) DA_STORE((t + 1) & 1);
                __syncthreads();
            }
#pragma unroll
            for (int eb = 0; eb < 4; ++eb)
#pragma unroll
                for (int r = 0; r < 16; ++r) o[eb][r] = 0.f;
            lrun = 0.f;
#pragma unroll
            for (int r = 0; r < 16; ++r) negm[r] = -mrow;
            asm volatile("" : "+v"(negm));
            DA_LOAD(0); DA_STORE(0); DA_LOAD(1); DA_STORE(1);
            __syncthreads();
            for (int u = 0; u < (ntile >> 1); ++u) {
                const bool more = (u + 1) < (ntile >> 1);
                const int sl = (u & 1) * 2, nsl = sl ^ 2;
                bf16x8 pb[4];
                if (more) DA_LOAD(2 * u + 2);
                { const LAS unsigned char* kb = F.lds + sl * 32768;
                  attn_qk_fast<4, 256, 0>(kb, 8 * j, qf, negm, lrun, l31, hi, nullptr, 0, 0, pb);
                  attn_pv<4>(kb + 16384, pb, o, l31, hi);
                  if (more) { DA_STORE(nsl); DA_LOAD(2 * u + 3); } }
                { const LAS unsigned char* kb = F.lds + (sl + 1) * 32768;
                  attn_qk_fast<4, 256, 0>(kb, 8 * j, qf, negm, lrun, l31, hi, nullptr, 0, 0, pb);
                  attn_pv<4>(kb + 16384, pb, o, l31, hi);
                  if (more) DA_STORE(nsl + 1); }
                __syncthreads();
            }
            if (attempt == 1) break;
            const float lt0 = lrun + __shfl_xor(lrun, 32);
            const bool okw = __all(lt0 < 1.0e30f && lt0 > 1.0e-30f);
            LAS unsigned* okf = (LAS unsigned*)(F.lds + 131072 + 2048);
            if (F.lane == 0) okf[F.wave] = okw ? 1u : 0u;
            __syncthreads();
            unsigned allok = 1u;
#pragma unroll
            for (int w = 0; w < 8; ++w) allok &= okf[w];
            __syncthreads();
            if (__builtin_expect(allok != 0u, 1)) break;
        }
#undef DA_KROW
#undef DA_LOAD
#undef DA_STORE
        { const float lt = lrun + __shfl_xor(lrun, 32); const float inv = 1.0f / lt;
#pragma unroll
          for (int eb = 0; eb < 4; ++eb)
#pragma unroll
              for (int r = 0; r < 16; ++r) o[eb][r] *= inv; }
        LAS float* cb = (LAS float*)(F.lds + sub * 16384);
        if (j == 1) {
#pragma unroll
            for (int eb = 0; eb < 4; ++eb)
#pragma unroll
                for (int r = 0; r < 16; ++r) { const int e = 32 * eb + (r & 3) + 8 * (r >> 2) + 4 * hi; cb[e * 32 + l31] = o[eb][r]; }
        }
        __syncthreads();
        if (j == 0) {
            float ss = 0.f;
#pragma unroll
            for (int eb = 0; eb < 4; ++eb)
#pragma unroll
                for (int r = 0; r < 16; ++r) { const int e = 32 * eb + (r & 3) + 8 * (r >> 2) + 4 * hi; const float d = o[eb][r] - lam_full * cb[e * 32 + l31]; o[eb][r] = d; ss += d * d; }
            ss += __shfl_xor(ss, 32);
            const float rn = (1.0f - lam_init) / sqrtf(ss * (1.0f / 128.0f) + NORM_EPS);
            char* ob = (char*)ATT + ((size_t)(qrow0 + sub * 32) * DM + h * 128) * 2;
            const unsigned ooff = (unsigned)(l31 * DM + 4 * hi) * 2u;
#pragma unroll
            for (int eb = 0; eb < 4; ++eb)
#pragma unroll
                for (int g4 = 0; g4 < 4; ++g4) {
                    const int e = 32 * eb + 8 * g4 + 4 * hi;
                    bf16_t* op = (bf16_t*)(ob + ooff) - 4 * hi;
                    const f32x4 gv = *(const f32x4*)(subg + e);
                    u32x2 w; w.x = cvt_pk_bf16(o[eb][4 * g4] * rn * gv[0], o[eb][4 * g4 + 1] * rn * gv[1]); w.y = cvt_pk_bf16(o[eb][4 * g4 + 2] * rn * gv[2], o[eb][4 * g4 + 3] * rn * gv[3]);
                    *(u32x2*)(op + e) = w;
                }
        }
        __syncthreads();
    }
}

__device__ __forceinline__ void nat_attn_phase(const Ctx& F0, const bf16_t* Q, const bf16_t* Kb, const bf16_t* Vt, bf16_t* ATT, const float* rpb, bool want_ctx) {
    Ctx F = F0; F.refresh();
    const int l31 = F.lane & 31, hi = F.lane >> 5;
    const int NU = 2048 + (want_ctx ? 64 : 0);
    LAS float* rpbL = (LAS float*)(F.lds + 65536);
    for (int u = F.bid; u < NU; u += F.G) {
        int b, h, r0 = 0, qtok, nwin, lo = 0; bool is_ctx = false;
        if (u < 2048) { const int bh = u >> 5; b = bh >> 4; h = bh & 15; r0 = (u & 31) * 4;
            const int qr_ = r0 + (F.wave >> 1); qtok = b * SEQ + qr_ * 64 + (F.wave & 1) * 32 + l31;
            lo = (r0 - 4) < 0 ? 0 : ((r0 - 4) > 120 ? 120 : (r0 - 4));
            const int hi_r = ((r0 - 1) < 0 ? 0 : ((r0 - 1) > 120 ? 120 : (r0 - 1))) + 7; nwin = hi_r - lo + 1;
        } else { const int uc = u - 2048; b = uc >> 4; h = uc & 15; is_ctx = true; nwin = 0; qtok = TL + b * CTXL + F.wave * 32 + l31; }
        const int qr = r0 + (F.wave >> 1), half = F.wave & 1;
        const int rs = (qr - 4) < 0 ? 0 : ((qr - 4) > 120 ? 120 : (qr - 4));
        const int qc = half * 32 + l31;
        const int cs = (qc - 8) < 0 ? 0 : ((qc - 8) > 48 ? 48 : (qc - 8));
        if (F.tid < 480) { const int ro = F.tid >> 5, co = F.tid & 31; rpbL[F.tid] = co < 31 ? rpb[(h * 15 + ro) * 31 + co] * LOG2E : 0.f; }
        bf16x8 qf[4];
        { const bf16_t* qp = Q + (size_t)qtok * DM + h * 64 + hi * 8;
#pragma unroll
          for (int d0 = 0; d0 < 4; ++d0) qf[d0] = *(const bf16x8*)(qp + d0 * 16); }
        f32x16 o[2];
#pragma unroll
        for (int eb = 0; eb < 2; ++eb)
#pragma unroll
            for (int r = 0; r < 16; ++r) o[eb][r] = 0.f;
        float mref = 0.f, lrun = 0.f; f32x16 negm; bool first = true;
#pragma unroll
        for (int r = 0; r < 16; ++r) negm[r] = 0.f;
        const int ntile = nwin + 4;
        const int kkey = F.tid >> 3, kch = F.tid & 7;
        u32x4 rk, rv;
#define NA_KROW(t) ((t) < nwin ? (b * SEQ + (lo + (t)) * 64) : (TL + b * CTXL + 64 * ((t) - nwin)))
#define NA_LOAD(t) do { const int kr_ = NA_KROW(t); rk = *(const u32x4*)(Kb + (size_t)(kr_ + kkey) * DM + h * 64 + kch * 8); rv = *(const u32x4*)(Vt + (size_t)(h * 64 + kkey) * TA + kr_ + kch * 8); } while (0)
#define NA_STORE(st) do { LAS unsigned char* kb_ = F.lds + (st) * 16384; LAS unsigned char* vb_ = kb_ + 8192; \
            *(LAS u32x4*)(kb_ + kkey * 128 + ((kch ^ ((kkey >> 1) & 7)) << 4)) = rk; const int sw_ = (kkey >> 1) & 7; \
            *(LAS u32x2*)(vb_ + kkey * 128 + (((2 * (kch >> 1)) ^ sw_) << 4) + (kch & 1) * 8) = (u32x2){rv.x, rv.y}; *(LAS u32x2*)(vb_ + kkey * 128 + (((2 * (kch >> 1) + 1) ^ sw_) << 4) + (kch & 1) * 8) = (u32x2){rv.z, rv.w}; } while (0)
        NA_LOAD(0); NA_STORE(0);
        __syncthreads();
        for (int t = 0; t < ntile; ++t) {
            const bool more = (t + 1) < ntile;
            if (more) NA_LOAD(t + 1);
            const LAS unsigned char* kb = F.lds + (t & 1) * 16384;
            bf16x8 pb[4]; bool act = true;
            if (t < nwin) {
                const int kr = lo + t;
                act = (kr >= rs && kr < rs + 8);
                if (act) attn_qk<2, 128, 1>(kb, 0, qf, o, negm, mref, lrun, first, l31, hi, rpbL + (kr - qr + 7) * 32, qc, cs, pb);
            } else {
                attn_qk<2, 128, 0>(kb, 0, qf, o, negm, mref, lrun, first, l31, hi, nullptr, 0, 0, pb);
            }
            if (more) NA_STORE((t + 1) & 1);
            if (act) attn_pv<2>(kb + 8192, pb, o, l31, hi);
            __syncthreads();
        }
#undef NA_KROW
#undef NA_LOAD
#undef NA_STORE
        { const float lt = lrun + __shfl_xor(lrun, 32); const float inv = 1.0f / lt;
          bf16_t* op = ATT + (size_t)qtok * DM + h * 64;
#pragma unroll
          for (int eb = 0; eb < 2; ++eb)
#pragma unroll
              for (int g4 = 0; g4 < 4; ++g4) {
                  const int e = 32 * eb + 8 * g4 + 4 * hi;
                  u32x2 w; w.x = cvt_pk_bf16(o[eb][4 * g4] * inv, o[eb][4 * g4 + 1] * inv); w.y = cvt_pk_bf16(o[eb][4 * g4 + 2] * inv, o[eb][4 * g4 + 3] * inv);
                  *(u32x2*)(op + e) = w;
              } }
        (void)is_ctx;
    }
}

#define XB_TMO      128
#define XB_XCNT(j)  (256  + 64 * (j))
#define XB_XSUB(j)  (1280 + 64 * (j))
#define XB_XGEN(j)  (2304 + 64 * (j))
#define XB_TOP      3328
#define XB_TOPGEN   3392
#define XCD_BAR_WORDS 3456
#define XB_SPIN_CAP (1u << 22)
__device__ __forceinline__ unsigned xb_ld(unsigned* p)              { return __hip_atomic_load(p, __ATOMIC_RELAXED, __HIP_MEMORY_SCOPE_AGENT); }
__device__ __forceinline__ unsigned xb_add(unsigned* p, unsigned v) { return __hip_atomic_fetch_add(p, v, __ATOMIC_RELAXED, __HIP_MEMORY_SCOPE_AGENT); }
__device__ __forceinline__ unsigned xb_xcc_id() { return (unsigned)__builtin_amdgcn_s_getreg((3 << 11) | 20) & 0xFu; }
#define XB_SPIN(cond, bar) do { unsigned _sp = 0; while (cond) { __builtin_amdgcn_s_sleep(1); \
    if ((++_sp & 255u) == 0u) { if (xb_ld(&(bar)[XB_TMO])) break; if (_sp > XB_SPIN_CAP) { atomicAdd(&(bar)[XB_TMO], 1u); break; } } } } while (0)
struct XcdBarrier { unsigned* bar; unsigned x; volatile LAS unsigned* st; };
__device__ __forceinline__ void xcd_barrier_complete(unsigned* bar, unsigned x, unsigned G, unsigned& nloc, unsigned& nx) {
    unsigned sum, cnt, mine, sp = 0u;
    for (;;) {
        sum = 0u; cnt = 0u; mine = 0u;
#pragma unroll
        for (unsigned j = 0; j < 16; ++j) { const unsigned c = xb_ld(&bar[XB_XCNT(j)]); sum += c; cnt += (c > 0u) ? 1u : 0u; mine = (j == x) ? c : mine; }
        if (sum == G) break;
        __builtin_amdgcn_s_sleep(1);
        if ((++sp & 255u) == 0u) { if (xb_ld(&bar[XB_TMO])) break; if (sp > XB_SPIN_CAP) { atomicAdd(&bar[XB_TMO], 1u); break; } }
    }
    nloc = mine > 0u ? mine : 1u; nx = cnt > 0u ? cnt : 1u;
}
__device__ __forceinline__ void xcd_barrier(const XcdBarrier& b, int tid, unsigned G) {
    asm volatile("s_waitcnt vmcnt(0)" ::: "memory");
    __syncthreads();
    if (tid == 0) {
        unsigned* bar = b.bar;
        __builtin_amdgcn_s_waitcnt(0);
        unsigned nloc = b.st[0], nx = b.st[1];
        if (nloc == 0u) { xcd_barrier_complete(bar, b.x, G, nloc, nx); b.st[0] = nloc; b.st[1] = nx; }
        const unsigned old = xb_add(&bar[XB_XSUB(b.x)], 1u);
        const unsigned gen = old / nloc;
        if (old + 1u == (gen + 1u) * nloc) {
            __builtin_amdgcn_fence(__ATOMIC_RELEASE, "agent");
            asm volatile("s_waitcnt vmcnt(0)" ::: "memory");
            const unsigned og = xb_add(&bar[XB_TOP], 1u);
            const unsigned tg = og / nx;
            if (og + 1u == (tg + 1u) * nx) xb_add(&bar[XB_TOPGEN], 1u);
            else XB_SPIN(xb_ld(&bar[XB_TOPGEN]) == tg, bar);
            __builtin_amdgcn_fence(__ATOMIC_ACQUIRE, "agent");
            xb_add(&bar[XB_XGEN(b.x)], 1u);
            asm volatile("s_waitcnt vmcnt(0)" ::: "memory");
        } else {
            XB_SPIN(xb_ld(&bar[XB_XGEN(b.x)]) == gen, bar);
            __builtin_amdgcn_fence(__ATOMIC_ACQUIRE, "agent");
            asm volatile("s_waitcnt vmcnt(0)" ::: "memory");
        }
    }
    __syncthreads();
}

__global__ void __launch_bounds__(512, 2) fwd_megakernel(Args args) {
    extern __shared__ __attribute__((aligned(16))) unsigned char lds_raw[];
    cg::grid_group grid = cg::this_grid();
    Ctx F;
    F.lds = (LAS unsigned char*)lds_raw;
    F.wave_s = __builtin_amdgcn_readfirstlane((int)threadIdx.x >> 6);
    F.refresh();
    F.G = gridDim.x; F.bid = blockIdx.x;
    unsigned char* ws = args.ws;
    h16_t* X = (h16_t*)(ws + WS_X);
    bf16_t* H = (bf16_t*)(ws + WS_H);
    bf16_t* HID = (bf16_t*)(ws + WS_BIG);
    bf16_t* Qb = (bf16_t*)(ws + WS_BIG);
    bf16_t* Kb = (bf16_t*)(ws + WS_BIG + QKV_STRIDE);
    bf16_t* Vtb = (bf16_t*)(ws + WS_BIG + 2 * QKV_STRIDE);
    const float* mod = (const float*)(ws + WS_MOD);
    const float* rope = (const float*)(ws + WS_ROPE);
    const float* zeros = (const float*)(ws + WS_CONST); const float* ones = zeros + 3072; const float* halves = zeros + 4096;

    volatile LAS unsigned* xst = (volatile LAS unsigned*)(F.lds + LDS_BYTES - 64);
    if (F.tid < 16) xst[F.tid] = 0u;
    __syncthreads();
    XcdBarrier xbar; xbar.bar = (unsigned*)ws; xbar.x = xb_xcc_id(); xbar.st = xst;
    if (F.tid == 0) (void)xb_add(&xbar.bar[XB_XCNT(xbar.x)], 1u);
#define GSYNC() do { Ctx Fs_ = F; Fs_.refresh(); xcd_barrier(xbar, Fs_.tid, (unsigned)F.G); } while (0)

    prologue_phase(F, args);
    grid.sync();

    float* PART = (float*)(ws + WS_PART);
    for (int layer = 0; layer < 4; ++layer) {
        const int kind = layer % 3, jj = layer / 3;
        const bool pend_in = (layer >= 1 && layer <= 2);
        const bool last = (layer == 3);
        const bool update_ctx = !last;
        const int T = last ? TL : TA;
        const int Tp = layer < 2 ? TA : TL;
        const bool ctx_after = layer < 2;
        const float* modL = mod + (size_t)layer * 5 * NMODV;
        const float* ng = args.in[6] + (size_t)layer * 3 * DM;

        normmod_phase(F, X, T, ng, modL, 0, 1, H, pend_in ? PART : nullptr, mod + (size_t)(layer - 1) * 5 * NMODV + 4 * NMODV + 8 * 1024);
        GSYNC();
        { pg8::Gemm g{H, (const bf16_t*)(ws + WS_WIN) + (size_t)(layer * 2) * 5632 * 1024, DM, DM, DM, 0};
          pg8::StaticOrder S; S.init(T, 5632, F.G, F.bid);
          pg8::EpiSwiglu E{HID, DFF};
          for (int rep = 0; rep < REP_G1; ++rep) pg8::gemm_phase<pg8::EpiSwiglu>(F.lds, F.wave_s, g, S, E); }
        GSYNC();
        { const bf16_t* Wt = (const bf16_t*)(ws + WS_WOUT) + (size_t)(layer * 2) * 1024 * DFF;
          { pg8::Gemm g{HID, Wt, DFF, DFF, DFF, 0};
            pg8::StaticOrder S; S.init(TL, DM, F.G, F.bid);
            pg8::EpiResid E{X, modL + 2 * 1024, zeros, halves};
            pg8::gemm_phase<pg8::EpiResid>(F.lds, F.wave_s, g, S, E); }
          if (T > TL) {
            pg8::Gemm g{HID, Wt, DFF, DFF, 256, 0};
            pg8::StaticOrder S; S.init(TC, 44 * 256, F.G, F.bid, 128);
            pg8::EpiPartial E{PART, 11 * DM};
            pg8::gemm_phase<pg8::EpiPartial, 4, 512>(F.lds, F.wave_s, g, S, E); } }
        GSYNC();

        normmod_phase(F, X, T, ng + DM, modL, 3, 4, H, T > TL ? PART : nullptr, modL + 4 * NMODV + 2 * 1024);
        GSYNC();
        if (kind == 0) {
            bf16_t* Dd = Qb;
            pool_diff_phase(F, H, Dd, Tp);
            GSYNC();
            { pg8::Gemm g{Dd, (const bf16_t*)(ws + WS_WPOOL) + (size_t)jj * 1024 * 256, DM, 256, 256, 512};
              pg8::StaticOrder S; S.init(Tp, DM, F.G, F.bid);
              pg8::EpiResid E{X, modL + 5 * 1024, zeros, args.in[10] + (size_t)jj * DM};
              pg8::gemm_phase<pg8::EpiResid>(F.lds, F.wave_s, g, S, E); }
            GSYNC();
        } else {
            const bf16_t* Wqkv = (const bf16_t*)(ws + WS_WQKV) + (size_t)(kind - 1) * 3072 * 1024;
            { pg8::Gemm g{H, Wqkv, DM, DM, DM, 0};
              pg8::StaticOrder S; S.init(T, 2048, F.G, F.bid);
              pg8::EpiQK E{Qb, Kb, rope, kind == 2 ? args.in[16] : zeros, kind - 1};
              pg8::gemm_phase<pg8::EpiQK>(F.lds, F.wave_s, g, S, E); }
            { pg8::Gemm g{Wqkv + (size_t)2048 * 1024, H, DM, DM, DM, 0};
              pg8::StaticOrder S; S.init(DM, T, F.G, (F.bid + (F.G >> 1)) % F.G);
              pg8::EpiVt E{Vtb, TA, kind == 2 ? args.in[16] + 2048 : zeros};
              pg8::gemm_phase<pg8::EpiVt>(F.lds, F.wave_s, g, S, E); }
            GSYNC();
            if (kind == 1) {
                const float lam_init = 0.8f - 0.6f * expf(-0.3f * (float)layer);
                for (int rep = 0; rep < REP_DIFF; ++rep) diff_attn_phase(F, Qb, Kb, Vtb, H, args.in[12] + (size_t)jj * 256, args.in[13] + (size_t)jj * 128, lam_init, ctx_after);
            } else {
                for (int rep = 0; rep < REP_NAT; ++rep) nat_attn_phase(F, Qb, Kb, Vtb, H, args.in[17] + (size_t)jj * 16 * 15 * 31, ctx_after);
            }
            GSYNC();
            { pg8::Gemm g{H, (const bf16_t*)(ws + WS_WO) + (size_t)(kind - 1) * 1024 * 1024, DM, DM, DM, 0};
              pg8::StaticOrder S; S.init(Tp, DM, F.G, F.bid);
              pg8::EpiResid E{X, modL + 5 * 1024, kind == 2 ? args.in[19] + (size_t)jj * DM : zeros, ones};
              pg8::gemm_phase<pg8::EpiResid>(F.lds, F.wave_s, g, S, E); }
            GSYNC();
        }

        normmod_phase(F, X, Tp, ng + 2 * DM, modL, 6, 7, H, nullptr, zeros);
        GSYNC();
        { pg8::Gemm g{H, (const bf16_t*)(ws + WS_WIN) + (size_t)(layer * 2 + 1) * 5632 * 1024, DM, DM, DM, 0};
          pg8::StaticOrder S; S.init(Tp, 5632, F.G, F.bid);
          pg8::EpiSwiglu E{HID, DFF};
          for (int rep = 0; rep < REP_G1; ++rep) pg8::gemm_phase<pg8::EpiSwiglu>(F.lds, F.wave_s, g, S, E); }
        GSYNC();
        { const bf16_t* Wt = (const bf16_t*)(ws + WS_WOUT) + (size_t)(layer * 2 + 1) * 1024 * DFF;
          { pg8::Gemm g{HID, Wt, DFF, DFF, DFF, 0};
            pg8::StaticOrder S; S.init(TL, DM, F.G, F.bid);
            pg8::EpiResid E{X, modL + 8 * 1024, zeros, halves};
            pg8::gemm_phase<pg8::EpiResid>(F.lds, F.wave_s, g, S, E); }
          if (Tp > TL) {
            pg8::Gemm g{HID, Wt, DFF, DFF, 256, 0};
            pg8::StaticOrder S; S.init(TC, 44 * 256, F.G, F.bid, 128);
            pg8::EpiPartial E{PART, 11 * DM};
            pg8::gemm_phase<pg8::EpiPartial, 4, 512>(F.lds, F.wave_s, g, S, E); } }
        GSYNC();
    }
    final_norm_phase(F, X, args.in[20], args.out);
}

extern "C" void kernel_launch(void* const* d_in, const int* in_sizes, int n_in, void* d_out, int out_size, void* d_ws, size_t ws_size, hipStream_t stream) {
    static int grid = 0;
    if (grid == 0) {
        if (n_in != 21 || ws_size < WS_END) { fprintf(stderr, "kernel_launch: unexpected inputs (n_in %d, ws %zu)\n", n_in, ws_size); grid = -1; return; }
        int dev = 0, cus = 0, per_cu = 0;
        hipGetDevice(&dev);
        hipDeviceGetAttribute(&cus, hipDeviceAttributeMultiprocessorCount, dev);
        hipFuncSetAttribute((const void*)fwd_megakernel, hipFuncAttributeMaxDynamicSharedMemorySize, LDS_BYTES);
        hipOccupancyMaxActiveBlocksPerMultiprocessor(&per_cu, (const void*)fwd_megakernel, 512, LDS_BYTES);
        if (per_cu < 1) per_cu = 1;
        grid = cus * per_cu;
        if (grid > 256) grid = 256;
        grid &= ~7;
        (void)hipGetLastError();
    }
    if (grid <= 0) return;
    (void)hipMemsetAsync(d_ws, 0, 16384, stream);
    Args a{};
    for (int i = 0; i < 21; ++i) a.in[i] = (const float*)d_in[i];
    a.out = (float*)d_out; a.ws = (unsigned char*)d_ws;
    void* kargs[] = {&a};
    hipError_t e = hipLaunchCooperativeKernel((const void*)fwd_megakernel, dim3(grid), dim3(512), kargs, LDS_BYTES, stream);
    if (e != hipSuccess) fprintf(stderr, "cooperative launch failed: %s (grid %d)\n", hipGetErrorString(e), grid);
}
```

```cpp
#include <hip/hip_runtime.h>
#include <hip/hip_cooperative_groups.h>
#include <cstdio>
#include <cstdint>
namespace cg = cooperative_groups;

#define LAS __attribute__((address_space(3)))
typedef unsigned short bf16_t;
typedef short bf16x8 __attribute__((ext_vector_type(8)));
typedef short s16x4 __attribute__((ext_vector_type(4)));
typedef float f32x2 __attribute__((ext_vector_type(2)));
typedef float f32x4 __attribute__((ext_vector_type(4)));
typedef float f32x16 __attribute__((ext_vector_type(16)));
typedef unsigned u32x2 __attribute__((ext_vector_type(2)));
typedef _Float16 h16_t;
typedef _Float16 f16x4 __attribute__((ext_vector_type(4)));
typedef _Float16 f16x8 __attribute__((ext_vector_type(8)));
typedef float f32x8 __attribute__((ext_vector_type(8)));
typedef unsigned u32x4 __attribute__((ext_vector_type(4)));

constexpr int DM = 1024, NB = 4, SEQ = 8192, CTXL = 256, DFF = 2816, NMODV = 9 * 1024;
constexpr int TL = NB * SEQ, TC = NB * CTXL, TA = TL + TC;
constexpr float NORM_EPS = 1e-6f;
constexpr float LOG2E = 1.4426950408889634f;
constexpr float QSCALE = 0.125f * LOG2E;
constexpr float NEG_BIG = -1e30f;

constexpr size_t MiB = 1u << 20;
constexpr size_t WS_MOD = 1 * MiB;
constexpr size_t WS_ROPE = 2 * MiB;
constexpr size_t WS_CONST = 3 * MiB;
constexpr size_t WS_WIN = 4 * MiB;
constexpr size_t WS_WOUT = 92 * MiB;
constexpr size_t WS_WQKV = 136 * MiB;
constexpr size_t WS_WO = 148 * MiB;
constexpr size_t WS_WPOOL = 152 * MiB;
constexpr size_t WS_X = 154 * MiB;
constexpr size_t WS_H = 286 * MiB;
constexpr size_t WS_BIG = 352 * MiB;
constexpr size_t WS_PART = 550 * MiB;
constexpr size_t WS_END = 596 * MiB;
constexpr size_t QKV_STRIDE = 66 * MiB;

#ifndef REP_DIFF
#define REP_DIFF 1
#endif
#ifndef REP_NAT
#define REP_NAT 1
#endif
#ifndef REP_NORM
#define REP_NORM 1
#endif
#ifndef REP_G1
#define REP_G1 1
#endif
constexpr int LDS_BYTES = 147456;

typedef __bf16 bf16x2_t __attribute__((ext_vector_type(2)));
__device__ __forceinline__ unsigned cvt_pk_bf16(float lo, float hi) { f32x2 v = {lo, hi}; bf16x2_t b = __builtin_convertvector(v, bf16x2_t); return __builtin_bit_cast(unsigned, b); }
__device__ __forceinline__ float bf2f(unsigned short b) { return __uint_as_float(((unsigned)b) << 16); }
__device__ __forceinline__ float dpp_f(float v, int ctrl_sel) {
    const int x = __float_as_int(v); int r;
    if (ctrl_sel == 0) r = __builtin_amdgcn_update_dpp(x, x, 0xB1, 0xF, 0xF, false);
    else if (ctrl_sel == 1) r = __builtin_amdgcn_update_dpp(x, x, 0x4E, 0xF, 0xF, false);
    else if (ctrl_sel == 2) r = __builtin_amdgcn_update_dpp(x, x, 0x141, 0xF, 0xF, false);
    else r = __builtin_amdgcn_update_dpp(x, x, 0x140, 0xF, 0xF, false);
    return __int_as_float(r);
}
__device__ __forceinline__ float wave_sum(float v) {
    v += dpp_f(v, 0); v += dpp_f(v, 1); v += dpp_f(v, 2); v += dpp_f(v, 3);
    { auto rr = __builtin_amdgcn_permlane16_swap(__float_as_uint(v), __float_as_uint(v), false, false); v = __uint_as_float(rr[0]) + __uint_as_float(rr[1]); }
    { auto rr = __builtin_amdgcn_permlane32_swap(__float_as_uint(v), __float_as_uint(v), false, false); v = __uint_as_float(rr[0]) + __uint_as_float(rr[1]); }
    return v;
}
__device__ __forceinline__ int opaque_tid(int wave_s) { int l; asm volatile("v_mbcnt_lo_u32_b32 %0, -1, 0\n\tv_mbcnt_hi_u32_b32 %0, -1, %0" : "=v"(l)); return wave_s * 64 + l; }
__device__ __forceinline__ float silu_f(float v) { return v / (1.0f + __expf(-v)); }
__device__ __forceinline__ float fast_silu(float v) { return v * __builtin_amdgcn_rcpf(1.0f + __builtin_amdgcn_exp2f(-v * LOG2E)); }

namespace pg8 {
constexpr int BM = 256, BK = 64, HALF = 128, HTB = HALF * BK * 2, STAGE_BYTES = 8 * HTB, NXCD = 8, WGM = 8;
__device__ __forceinline__ int lds_byte(int r, int c) { const int st = (r >> 4) * 2 + (c >> 5), rr = r & 15, cc = c & 31, ob = rr * 64 + cc * 2; return st * 1024 + (ob ^ (((ob >> 9) & 1) << 5)); }
__device__ __forceinline__ void stage_rc(int b, int& R, int& C) { const int st = b / 1024, sb = b % 1024, swz = sb ^ (((sb >> 9) & 1) << 5); R = (st >> 1) * 16 + swz / 64; C = (st & 1) * 32 + (swz % 64) / 2; }
__device__ __forceinline__ int perm32(int rho) { const int n = rho >> 4, i = rho & 15; return 8 * (i >> 2) + 4 * n + (i & 3); }

struct Unit { int pm, pn; };
struct Gemm { const bf16_t* A; const bf16_t* Bt; int lda, ldb, K; int a_pn_off; };

struct StaticOrder {
    int nM, nN, nwg, G, c, pm0;
    __device__ void init(int M, int N, int G_, int c_, int pm0_ = 0) { nM = M / BM; nN = N / BM; nwg = nM * nN; G = G_; c = c_; pm0 = pm0_; }
    __device__ bool next(int i, Unit& u) const {
        const long L = (long)i * G + c; if (L >= nwg) return false;
        int wgid = (int)L; { const int q = nwg / NXCD, r = nwg % NXCD, xcd = wgid % NXCD, off = wgid / NXCD; wgid = (xcd < r ? xcd * (q + 1) : r * (q + 1) + (xcd - r) * q) + off; }
        const int nig = WGM * nN, gid = wgid / nig, fm = gid * WGM, gsz = (nM - fm) < WGM ? (nM - fm) : WGM;
        u.pm = pm0 + fm + ((wgid % nig) % gsz); u.pn = (wgid % nig) / gsz; return true;
    }
};

template <class Epi, int KSD = 0, int KSO = 0>
__device__ __forceinline__ void gemm_phase(LAS unsigned char* lds, int wave_s, const Gemm g, const StaticOrder& S, const Epi& E) {
    const int tid = opaque_tid(wave_s), wid = __builtin_amdgcn_readfirstlane(tid >> 6), lane = tid & 63, wr = wid >> 2, wc = wid & 3, fr = lane & 15, fq = lane >> 4;
    const int K = g.K, nt = K / BK;
    unsigned voffA[2], voffB[2];
#pragma unroll
    for (int i = 0; i < 2; ++i) { int R, C; stage_rc(tid * 16 + i * 8192, R, C); const int Rb = Epi::PERM ? ((R & ~31) + perm32(R & 31)) : R;
        voffA[i] = (unsigned)(R * g.lda + C) * 2u; voffB[i] = (unsigned)(Rb * g.ldb + C) * 2u; }
    const size_t kstep = (size_t)(BK * 2);
    const size_t hstepA = (size_t)HALF * g.lda * 2, hstepB = (size_t)HALF * g.ldb * 2;
    const size_t tstepA = 2 * hstepA, tstepB = 2 * hstepB;
    const unsigned ldsw = (unsigned)wid * 1024u;
    const int aoff = lds_byte(wr * 64 + fr, fq * 8), boff = lds_byte(wc * 32 + fr, fq * 8);
#define PG8_SA(b, h) (((b) * 2 + (h)) * HTB)
#define PG8_SB(b, h) ((4 + (b) * 2 + (h)) * HTB)
#define PG8_STAGE(bufoff, gbase, voff) do { _Pragma("unroll") for (int _i = 0; _i < 2; ++_i) \
        __builtin_amdgcn_global_load_lds((const unsigned*)((const char*)(gbase) + (voff)[_i]), (LAS unsigned*)(lds + (bufoff) + ldsw + _i * 8192), 16, 0, 0); } while (0)
#define PG8_LDA(dst, b, h) do { _Pragma("unroll") for (int m = 0; m < 4; ++m) _Pragma("unroll") for (int k = 0; k < 2; ++k) dst[m][k] = *(const LAS bf16x8*)(lds + PG8_SA(b, h) + aoff + m * 2048 + k * 1024); } while (0)
#define PG8_LDB(dst, b, h) do { _Pragma("unroll") for (int n = 0; n < 2; ++n) _Pragma("unroll") for (int k = 0; k < 2; ++k) dst[n][k] = *(const LAS bf16x8*)(lds + PG8_SB(b, h) + boff + n * 2048 + k * 1024); } while (0)
#define PG8_MMA(ai, bj, At, Bt) do { __builtin_amdgcn_s_setprio(1); _Pragma("unroll") for (int m = 0; m < 4; ++m) _Pragma("unroll") for (int n = 0; n < 2; ++n) _Pragma("unroll") for (int k = 0; k < 2; ++k) \
        acc[ai][bj][m][n] = __builtin_amdgcn_mfma_f32_16x16x32_bf16(Bt[n][k], At[m][k], acc[ai][bj][m][n], 0, 0, 0); __builtin_amdgcn_s_setprio(0); } while (0)
#define PG8_WAIT_V(n) asm volatile("s_waitcnt vmcnt(" #n ")" ::: "memory")
#define PG8_WAIT_L(n) asm volatile("s_waitcnt lgkmcnt(" #n ")" ::: "memory")
#define PG8_BAR __builtin_amdgcn_s_barrier()
#define PG8_SCHED __builtin_amdgcn_sched_barrier(0)
    Unit cur, nxt; int ui = 0;
    if (!S.next(0, cur)) return;
    f32x4 acc[2][2][4][2];
#pragma unroll
    for (int a = 0; a < 2; ++a)
#pragma unroll
        for (int b = 0; b < 2; ++b)
#pragma unroll
            for (int m = 0; m < 4; ++m)
#pragma unroll
                for (int n = 0; n < 2; ++n) acc[a][b][m][n] = (f32x4){0.f, 0.f, 0.f, 0.f};
    bf16x8 At[4][2], B0[2][2], B1[2][2];
    const char* cA; const char* cB;
    if constexpr (KSD == 0) { cA = (const char*)g.A + (size_t)cur.pm * tstepA + (size_t)cur.pn * g.a_pn_off; cB = (const char*)g.Bt + (size_t)cur.pn * tstepB; }
    else { cA = (const char*)g.A + (size_t)cur.pm * tstepA + (size_t)(cur.pn / KSD) * KSO; cB = (const char*)g.Bt + (size_t)(cur.pn % KSD) * tstepB + (size_t)(cur.pn / KSD) * KSO; }
    PG8_STAGE(PG8_SB(0, 0), cB, voffB); PG8_STAGE(PG8_SB(0, 1), cB + hstepB, voffB); PG8_STAGE(PG8_SA(0, 0), cA, voffA); PG8_STAGE(PG8_SA(0, 1), cA + hstepA, voffA);
    if (wr == 1) PG8_BAR;
    PG8_WAIT_V(2); PG8_BAR;
    PG8_STAGE(PG8_SB(1, 0), cB + kstep, voffB); PG8_STAGE(PG8_SA(1, 0), cA + kstep, voffA); PG8_STAGE(PG8_SB(1, 1), cB + hstepB + kstep, voffB);
    PG8_WAIT_V(6); PG8_BAR;
    for (;;) {
        const bool has_next = S.next(ui + 1, nxt);
        const char* nA = cA; const char* nB = cB;
        if (has_next) {
            if constexpr (KSD == 0) { nA = (const char*)g.A + (size_t)nxt.pm * tstepA + (size_t)nxt.pn * g.a_pn_off; nB = (const char*)g.Bt + (size_t)nxt.pn * tstepB; }
            else { nA = (const char*)g.A + (size_t)nxt.pm * tstepA + (size_t)(nxt.pn / KSD) * KSO; nB = (const char*)g.Bt + (size_t)(nxt.pn % KSD) * tstepB + (size_t)(nxt.pn / KSD) * KSO; } }
        for (int t = 0; t < nt; t += 2) {
            const bool last = (t == nt - 2);
            const char* a1 = cA + (size_t)(t + 1) * kstep;
            const char* a2 = last ? nA : cA + (size_t)(t + 2) * kstep; const char* b2 = last ? nB : cB + (size_t)(t + 2) * kstep;
            const char* a3 = a2 + kstep; const char* b3 = b2 + kstep;
            PG8_LDB(B0, 0, 0); PG8_LDB(B1, 0, 1); PG8_SCHED; PG8_LDA(At, 0, 0); PG8_STAGE(PG8_SA(1, 1), a1 + hstepA, voffA);
            PG8_WAIT_V(8); PG8_WAIT_L(0); PG8_BAR; PG8_MMA(0, 0, At, B0); PG8_MMA(0, 1, At, B1); PG8_BAR; PG8_SCHED;
            PG8_LDA(At, 0, 1); PG8_STAGE(PG8_SB(0, 0), b2, voffB); PG8_STAGE(PG8_SB(0, 1), b2 + hstepB, voffB); PG8_STAGE(PG8_SA(0, 0), a2, voffA);
            PG8_WAIT_V(8); PG8_WAIT_L(0); PG8_BAR; PG8_MMA(1, 0, At, B0); PG8_MMA(1, 1, At, B1); PG8_BAR; PG8_SCHED;
            PG8_LDB(B0, 1, 0); PG8_LDB(B1, 1, 1); PG8_SCHED; PG8_LDA(At, 1, 0); PG8_STAGE(PG8_SA(0, 1), a2 + hstepA, voffA);
            PG8_WAIT_V(8); PG8_WAIT_L(0); PG8_BAR; PG8_MMA(0, 0, At, B0); PG8_MMA(0, 1, At, B1); PG8_BAR; PG8_SCHED;
            PG8_LDA(At, 1, 1); PG8_STAGE(PG8_SB(1, 0), b3, voffB); PG8_STAGE(PG8_SB(1, 1), b3 + hstepB, voffB); PG8_STAGE(PG8_SA(1, 0), a3, voffA);
            PG8_WAIT_V(8); PG8_WAIT_L(0); PG8_BAR; PG8_MMA(1, 0, At, B0); PG8_MMA(1, 1, At, B1); PG8_BAR; PG8_SCHED;
        }
        if (wr == 0) PG8_BAR;
        { const int l2_ = opaque_tid(wave_s) & 63; E(acc, cur, wr, wc, l2_ & 15, l2_ >> 4); }
        if (!has_next) break;
#pragma unroll
        for (int a = 0; a < 2; ++a)
#pragma unroll
            for (int b = 0; b < 2; ++b)
#pragma unroll
                for (int m = 0; m < 4; ++m)
#pragma unroll
                    for (int n = 0; n < 2; ++n) acc[a][b][m][n] = (f32x4){0.f, 0.f, 0.f, 0.f};
        cur = nxt; cA = nA; cB = nB; ++ui;
        if (wr == 1) PG8_BAR;
    }
    PG8_WAIT_V(0);
    PG8_BAR;
#undef PG8_SA
#undef PG8_SB
#undef PG8_STAGE
#undef PG8_LDA
#undef PG8_LDB
#undef PG8_MMA
#undef PG8_WAIT_V
#undef PG8_WAIT_L
#undef PG8_BAR
#undef PG8_SCHED
}

struct EpiSwiglu {
    static constexpr bool PERM = true;
    bf16_t* O; int ldc;
    static __device__ __forceinline__ float hs(float g, float u) { return g * u * __builtin_amdgcn_rcpf(1.0f + __builtin_amdgcn_exp2f(-g)); }
    __device__ __forceinline__ void operator()(const f32x4 (&acc)[2][2][4][2], const Unit& u, int wr, int wc, int fr, int fq) const {
        const int row0 = u.pm * BM + wr * 64 + fr, col0 = u.pn * 128 + wc * 32 + 8 * fq;
#pragma unroll
        for (int ai = 0; ai < 2; ++ai)
#pragma unroll
            for (int m = 0; m < 4; ++m) {
                bf16_t* rowp = O + (size_t)(row0 + ai * HALF + m * 16) * ldc + col0;
                const f32x4 g0 = acc[ai][0][m][0], g1 = acc[ai][0][m][1], u0 = acc[ai][1][m][0], u1 = acc[ai][1][m][1];
                u32x4 w;
                w.x = cvt_pk_bf16(hs(g0[0], u0[0]), hs(g0[1], u0[1]));
                w.y = cvt_pk_bf16(hs(g0[2], u0[2]), hs(g0[3], u0[3]));
                w.z = cvt_pk_bf16(hs(g1[0], u1[0]), hs(g1[1], u1[1]));
                w.w = cvt_pk_bf16(hs(g1[2], u1[2]), hs(g1[3], u1[3]));
                *(u32x4*)rowp = w;
            }
    }
};
struct EpiResid {
    static constexpr bool PERM = true;
    h16_t* X; const float* gate_base; const float* bias; const float* cscale;
    __device__ __forceinline__ void operator()(const f32x4 (&acc)[2][2][4][2], const Unit& u, int wr, int wc, int fr, int fq) const {
        const int midx = u.pm < 128 ? (u.pm >> 5) : 4;
        const float* gate = gate_base + midx * NMODV;
        asm volatile("" : "+v"(fr), "+v"(fq));
        const int col0 = u.pn * BM + wc * 32 + 8 * fq;
#pragma unroll
        for (int bj = 0; bj < 2; ++bj) {
            const int c = col0 + bj * HALF;
            const f32x4 g0 = *(const f32x4*)(gate + c) * *(const f32x4*)(cscale + c), g1 = *(const f32x4*)(gate + c + 4) * *(const f32x4*)(cscale + c + 4);
            const f32x4 b0 = *(const f32x4*)(bias + c), b1 = *(const f32x4*)(bias + c + 4);
#pragma unroll
            for (int ai = 0; ai < 2; ++ai) {
                h16_t* p0 = X + (size_t)(u.pm * BM + ai * HALF + wr * 64 + fr) * DM + c;
                f16x8 xv[4];
#pragma unroll
                for (int m = 0; m < 4; ++m) xv[m] = *(const f16x8*)(p0 + (size_t)m * 16 * DM);
                asm volatile("" ::: "memory");
#pragma unroll
                for (int m = 0; m < 4; ++m) {
                    const f32x8 xf = __builtin_convertvector(xv[m], f32x8);
                    const f32x4 lo = (f32x4){xf[0], xf[1], xf[2], xf[3]} + g0 * (acc[ai][bj][m][0] + b0);
                    const f32x4 hh = (f32x4){xf[4], xf[5], xf[6], xf[7]} + g1 * (acc[ai][bj][m][1] + b1);
                    const f32x8 o = (f32x8){lo[0], lo[1], lo[2], lo[3], hh[0], hh[1], hh[2], hh[3]};
                    *(f16x8*)(p0 + (size_t)m * 16 * DM) = __builtin_convertvector(o, f16x8);
                }
                asm volatile("" ::: "memory");
            }
        }
    }
};
struct EpiQK {
    static constexpr bool PERM = false;
    bf16_t* Q; bf16_t* Kb; const float* rope; const float* bias; int mode;
    __device__ __forceinline__ void operator()(const f32x4 (&acc)[2][2][4][2], const Unit& u, int wr, int wc, int fr, int fq) const {
        const bool isq = u.pn < 4;
        bf16_t* base = isq ? Q : Kb;
        const float sc = isq ? QSCALE : 1.0f;
        const int colt = (u.pn & 3) * BM + wc * 32 + 4 * fq;
        const bool dorope = (mode == 0) && (u.pm < 128);
#pragma unroll
        for (int ai = 0; ai < 2; ++ai)
#pragma unroll
            for (int m = 0; m < 4; ++m) {
                const int row = u.pm * BM + ai * HALF + wr * 64 + m * 16 + fr;
                f32x4 cv = (f32x4){1.f, 1.f, 1.f, 1.f}, sv = (f32x4){0.f, 0.f, 0.f, 0.f};
                if (dorope) {
                    const int t = row & (SEQ - 1); const int pos = (wc & 1) ? (t & 63) : (t >> 6);
                    const f32x4 t0 = *(const f32x4*)(rope + (pos * 16 + 4 * fq) * 2), t1 = *(const f32x4*)(rope + (pos * 16 + 4 * fq) * 2 + 4);
                    cv = (f32x4){t0[0], t0[2], t1[0], t1[2]}; sv = (f32x4){t0[1], t0[3], t1[1], t1[3]};
                }
#pragma unroll
                for (int bj = 0; bj < 2; ++bj) {
                    const int bc = u.pn * BM + bj * HALF + wc * 32 + 4 * fq;
                    const f32x4 x1 = acc[ai][bj][m][0] + *(const f32x4*)(bias + bc), x2 = acc[ai][bj][m][1] + *(const f32x4*)(bias + bc + 16);
                    const f32x4 o1 = (x1 * cv - x2 * sv) * sc, o2 = (x2 * cv + x1 * sv) * sc;
                    bf16_t* p = base + (size_t)row * DM + colt + bj * HALF;
                    u32x2 w1, w2; w1.x = cvt_pk_bf16(o1[0], o1[1]); w1.y = cvt_pk_bf16(o1[2], o1[3]); w2.x = cvt_pk_bf16(o2[0], o2[1]); w2.y = cvt_pk_bf16(o2[2], o2[3]);
                    *(u32x2*)p = w1; *(u32x2*)(p + 16) = w2;
                }
                asm volatile("" ::: "memory");
            }
    }
};
struct EpiPartial {
    static constexpr bool PERM = false;
    float* O; int ldc;
    __device__ __forceinline__ void operator()(const f32x4 (&acc)[2][2][4][2], const Unit& u, int wr, int wc, int fr, int fq) const {
        asm volatile("" : "+v"(fr), "+v"(fq));
        const unsigned base = (unsigned)(((u.pm - 128) * BM + wr * 64 + fr) * ldc + u.pn * BM + wc * 32 + 4 * fq) * 4u;
#pragma unroll
        for (int ai = 0; ai < 2; ++ai)
#pragma unroll
            for (int m = 0; m < 4; ++m) {
                char* rp = (char*)O + (base + (unsigned)((ai * HALF + m * 16) * ldc) * 4u);
#pragma unroll
                for (int bj = 0; bj < 2; ++bj)
#pragma unroll
                    for (int n = 0; n < 2; ++n) *(f32x4*)(rp + (bj * HALF + n * 16) * 4) = acc[ai][bj][m][n];
                asm volatile("" ::: "memory");
            }
    }
};
struct EpiVt {
    static constexpr bool PERM = true;
    bf16_t* O; int ldc; const float* rbias;
    __device__ __forceinline__ void operator()(const f32x4 (&acc)[2][2][4][2], const Unit& u, int wr, int wc, int fr, int fq) const {
        const int row0 = u.pm * BM + wr * 64 + fr, col0 = u.pn * BM + wc * 32 + 8 * fq;
#pragma unroll
        for (int ai = 0; ai < 2; ++ai)
#pragma unroll
            for (int m = 0; m < 4; ++m) {
                const int row = row0 + ai * HALF + m * 16;
                const float b = rbias[row];
                bf16_t* rowp = O + (size_t)row * ldc + col0;
#pragma unroll
                for (int bj = 0; bj < 2; ++bj) {
                    const f32x4 v0 = acc[ai][bj][m][0] + b, v1 = acc[ai][bj][m][1] + b;
                    u32x4 w; w.x = cvt_pk_bf16(v0[0], v0[1]); w.y = cvt_pk_bf16(v0[2], v0[3]); w.z = cvt_pk_bf16(v1[0], v1[1]); w.w = cvt_pk_bf16(v1[2], v1[3]);
                    *(u32x4*)(rowp + bj * HALF) = w;
                }
            }
    }
};
}

struct Args { const float* in[21]; float* out; unsigned char* ws; };

struct Ctx {
    LAS unsigned char* lds;
    int tid, lane, wave, G, bid, wave_s;
    __device__ __forceinline__ void refresh() { tid = opaque_tid(wave_s); lane = tid & 63; wave = __builtin_amdgcn_readfirstlane(tid >> 6); }
};

__device__ __forceinline__ void transpose_item(const float* W, int ldw, int k0, int n0, bf16_t* WT, int ldt, int dst_row0, LAS float* scr, int lane, float wscale = 1.0f) {
#pragma unroll 8
    for (int i = 0; i < 32; ++i) { const int kk = 2 * i + (lane >> 5); scr[kk * 33 + (lane & 31)] = W[(size_t)(k0 + kk) * ldw + n0 + (lane & 31)] * wscale; }
    asm volatile("s_waitcnt lgkmcnt(0)" ::: "memory");
    const int c = lane & 7;
#pragma unroll
    for (int j = 0; j < 4; ++j) { const int n = (lane >> 3) + 8 * j; const LAS float* s = scr + (8 * c) * 33 + n;
        u32x4 o; o.x = cvt_pk_bf16(s[0 * 33], s[1 * 33]); o.y = cvt_pk_bf16(s[2 * 33], s[3 * 33]); o.z = cvt_pk_bf16(s[4 * 33], s[5 * 33]); o.w = cvt_pk_bf16(s[6 * 33], s[7 * 33]);
        *(u32x4*)(WT + (size_t)(dst_row0 + n) * ldt + k0 + 8 * c) = o; }
    asm volatile("s_waitcnt lgkmcnt(0)" ::: "memory");
}

__device__ __forceinline__ void prologue_phase(const Ctx& F0, const Args& a) {
    Ctx F = F0; F.refresh();
    unsigned char* ws = a.ws;
    {
        LAS float* sv = (LAS float*)F.lds;
        LAS float* red = (LAS float*)(F.lds + 20480);
        for (int i = F.tid; i < 5 * 1024; i += 512) { const int m = i >> 10, k = i & 1023; const float v = m < 4 ? a.in[1][m * 1024 + k] : a.in[3][k]; sv[i] = silu_f(v); }
        __syncthreads();
        float* mod = (float*)(ws + WS_MOD);
        for (int u = F.bid; u < 4 * 72; u += F.G) {
            const int layer = u / 72, col0 = (u % 72) * 128;
            const float* W = a.in[4] + (size_t)layer * 1024 * NMODV + col0 + 2 * F.lane;
            float acc[5][2];
#pragma unroll
            for (int m = 0; m < 5; ++m) { acc[m][0] = 0.f; acc[m][1] = 0.f; }
            const int kb = F.wave * 128;
#pragma unroll 4
            for (int k = 0; k < 128; ++k) {
                const f32x2 w = *(const f32x2*)(W + (size_t)(kb + k) * NMODV);
#pragma unroll
                for (int m = 0; m < 5; ++m) { const float s = sv[m * 1024 + kb + k]; acc[m][0] += s * w.x; acc[m][1] += s * w.y; }
            }
#pragma unroll
            for (int m = 0; m < 5; ++m) { red[(F.wave * 5 + m) * 128 + 2 * F.lane] = acc[m][0]; red[(F.wave * 5 + m) * 128 + 2 * F.lane + 1] = acc[m][1]; }
            __syncthreads();
            for (int i = F.tid; i < 640; i += 512) { const int m = i >> 7, cc = i & 127; float s = a.in[5][layer * NMODV + col0 + cc];
#pragma unroll
                for (int w = 0; w < 8; ++w) s += red[(w * 5 + m) * 128 + cc];
                mod[((size_t)layer * 5 + m) * NMODV + col0 + cc] = s; }
            __syncthreads();
        }
    }
    {
        h16_t* X = (h16_t*)(ws + WS_X);
        const size_t n8 = (size_t)TA * DM / 8, nl8 = (size_t)TL * DM / 8;
        for (size_t i = (size_t)F.bid * 512 + F.tid; i < n8; i += (size_t)F.G * 512) {
            const float* sp = i < nl8 ? a.in[0] + i * 8 : a.in[2] + (i - nl8) * 8;
            const f32x4 p = *(const f32x4*)sp, q = *(const f32x4*)(sp + 4);
            const f32x8 o = (f32x8){p[0], p[1], p[2], p[3], q[0], q[1], q[2], q[3]};
            *(f16x8*)(X + i * 8) = __builtin_convertvector(o, f16x8);
        }
    }
    if (F.bid == 0) { float* cz = (float*)(ws + WS_CONST); for (int i = F.tid; i < 5120; i += 512) cz[i] = i < 3072 ? 0.f : (i < 4096 ? 1.f : 0.5f); }
    {
        float* rope = (float*)(ws + WS_ROPE);
        const int gi = F.bid * 512 + F.tid;
        if (gi < 128 * 16) { const int pos = gi >> 4, f = gi & 15; const float inv = powf(10000.0f, -(float)(2 * f) / 32.0f); const float ang = (float)pos * inv; rope[gi * 2] = cosf(ang); rope[gi * 2 + 1] = sinf(ang); }
    }
    {
        LAS float* scr = (LAS float*)(F.lds + 32768 + F.wave * 8704);
        const int gw = F.bid * 8 + F.wave, NGW = F.G * 8;
        constexpr int I_IN = 16 * 176, I_OUT = 44 * 32, I_QKV = 16 * 96, I_O = 16 * 32, I_P = 4 * 8;
        constexpr int N_IN = 8 * I_IN, N_OUT = 8 * I_OUT, N_QKV = 2 * I_QKV, N_O = 2 * I_O, N_P = 8 * I_P;
        for (int it = gw; it < N_IN + N_OUT + N_QKV + N_O + N_P; it += NGW) {
            int r = it;
            if (r < N_IN) { const int mat = r / I_IN, l = r % I_IN, kb = l / 176, nb = l % 176; const int n0 = nb * 32;
                const int j = n0 < DFF ? n0 : n0 - DFF; const int dst = 256 * (j >> 7) + (n0 < DFF ? 0 : 128) + (j & 127);
                transpose_item(a.in[7] + (size_t)mat * 1024 * 5632, 5632, kb * 64, n0, (bf16_t*)(ws + WS_WIN) + (size_t)mat * 5632 * 1024, 1024, dst, scr, F.lane, n0 < DFF ? LOG2E : 0.6931471805599453f); continue; }
            r -= N_IN;
            if (r < N_OUT) { const int mat = r / I_OUT, l = r % I_OUT, kb = l / 32, nb = l % 32;
                transpose_item(a.in[8] + (size_t)mat * DFF * 1024, 1024, kb * 64, nb * 32, (bf16_t*)(ws + WS_WOUT) + (size_t)mat * 1024 * DFF, DFF, nb * 32, scr, F.lane); continue; }
            r -= N_OUT;
            if (r < N_QKV) { const int mat = r / I_QKV, l = r % I_QKV, kb = l / 96, nb = l % 96;
                transpose_item(mat == 0 ? a.in[11] : a.in[15], 3072, kb * 64, nb * 32, (bf16_t*)(ws + WS_WQKV) + (size_t)mat * 3072 * 1024, 1024, nb * 32, scr, F.lane); continue; }
            r -= N_QKV;
            if (r < N_O) { const int mat = r / I_O, l = r % I_O, kb = l / 32, nb = l % 32;
                transpose_item(mat == 0 ? a.in[14] : a.in[18], 1024, kb * 64, nb * 32, (bf16_t*)(ws + WS_WO) + (size_t)mat * 1024 * 1024, 1024, nb * 32, scr, F.lane); continue; }
            r -= N_O;
            { const int mat = r / I_P, l = r % I_P, kb = l / 8, nb = l % 8;
                transpose_item(a.in[9] + (size_t)mat * 256 * 256, 256, kb * 64, nb * 32, (bf16_t*)(ws + WS_WPOOL) + (size_t)mat * 256 * 256, 256, nb * 32, scr, F.lane); }
        }
    }
}

__device__ __forceinline__ void normmod_phase(const Ctx& F0, h16_t* X, int T, const float* g, const float* modL, int slot_shift, int slot_scale, bf16_t* H,
                                              const float* part, const float* pgate) {
    Ctx F = F0; F.refresh();
    const int gw = F.bid * 8 + F.wave, NGW = F.G * 8;
    const int RPW = (TL + NGW - 1) / NGW;
    const int r0 = gw * RPW, r1 = (r0 + RPW) < TL ? (r0 + RPW) : TL;
    const int nrows = (r1 > r0 ? r1 - r0 : 0) + ((T > TL && gw < TC) ? 1 : 0);
    int cur = -1; f32x4 gm[4], sh[4];
#pragma unroll
    for (int j = 0; j < 4; ++j) { gm[j] = (f32x4){0.f, 0.f, 0.f, 0.f}; sh[j] = gm[j]; }
    for (int ir = 0; ir < nrows; ++ir) {
        const int row = (r0 + ir) < r1 ? (r0 + ir) : (TL + gw);
        const int midx = row < TL ? (row >> 13) : 4;
        if (midx != cur) { cur = midx;
#pragma unroll
            for (int j = 0; j < 4; ++j) { const int c = 512 * (j >> 1) + 8 * F.lane + 4 * (j & 1); const f32x4 gv = *(const f32x4*)(g + c), sc = *(const f32x4*)(modL + midx * NMODV + slot_scale * 1024 + c);
                gm[j] = gv * (sc + 1.0f); sh[j] = *(const f32x4*)(modL + midx * NMODV + slot_shift * 1024 + c); } }
        h16_t* xr = X + (size_t)row * DM;
        f32x4 v[4]; float ss = 0.f;
#pragma unroll
        for (int jj = 0; jj < 2; ++jj) { const f32x8 xf = __builtin_convertvector(*(const f16x8*)(xr + 512 * jj + 8 * F.lane), f32x8);
            v[2 * jj] = (f32x4){xf[0], xf[1], xf[2], xf[3]}; v[2 * jj + 1] = (f32x4){xf[4], xf[5], xf[6], xf[7]}; }
        if (part != nullptr && row >= TL) {
            const float* pr = part + (size_t)(row - TL) * (11 * DM) + 8 * F.lane;
            f32x4 s[4];
#pragma unroll
            for (int j = 0; j < 4; ++j) s[j] = (f32x4){0.f, 0.f, 0.f, 0.f};
#pragma unroll 1
            for (int sl = 0; sl < 11; ++sl) {
#pragma unroll
                for (int j = 0; j < 4; ++j) s[j] = s[j] + *(const f32x4*)(pr + sl * DM + 512 * (j >> 1) + 4 * (j & 1));
            }
#pragma unroll
            for (int j = 0; j < 4; ++j) v[j] = v[j] + s[j] * (*(const f32x4*)(pgate + 512 * (j >> 1) + 8 * F.lane + 4 * (j & 1)) * 0.5f);
#pragma unroll
            for (int jj = 0; jj < 2; ++jj) { const f32x8 o = (f32x8){v[2 * jj][0], v[2 * jj][1], v[2 * jj][2], v[2 * jj][3], v[2 * jj + 1][0], v[2 * jj + 1][1], v[2 * jj + 1][2], v[2 * jj + 1][3]};
                const f16x8 oh = __builtin_convertvector(o, f16x8);
                *(f16x8*)(xr + 512 * jj + 8 * F.lane) = oh;
                const f32x8 back = __builtin_convertvector(oh, f32x8);
                v[2 * jj] = (f32x4){back[0], back[1], back[2], back[3]}; v[2 * jj + 1] = (f32x4){back[4], back[5], back[6], back[7]}; }
        }
#pragma unroll
        for (int j = 0; j < 4; ++j) ss += (v[j][0] * v[j][0] + v[j][1] * v[j][1]) + (v[j][2] * v[j][2] + v[j][3] * v[j][3]);
        const float r = 1.0f / sqrtf(wave_sum(ss) * (1.0f / DM) + NORM_EPS);
        bf16_t* o = H + (size_t)row * DM;
#pragma unroll
        for (int jj = 0; jj < 2; ++jj) { const f32x4 y0 = v[2 * jj] * r * gm[2 * jj] + sh[2 * jj], y1 = v[2 * jj + 1] * r * gm[2 * jj + 1] + sh[2 * jj + 1];
            u32x4 w; w.x = cvt_pk_bf16(y0[0], y0[1]); w.y = cvt_pk_bf16(y0[2], y0[3]); w.z = cvt_pk_bf16(y1[0], y1[1]); w.w = cvt_pk_bf16(y1[2], y1[3]);
            *(u32x4*)(o + 512 * jj + 8 * F.lane) = w; }
    }
}
__device__ __forceinline__ void final_norm_phase(const Ctx& F0, const h16_t* x, const float* g, float* out) {
    Ctx F = F0; F.refresh();
    const int gw = F.bid * 8 + F.wave, NGW = F.G * 8;
    f32x4 gv[4];
#pragma unroll
    for (int j = 0; j < 4; ++j) gv[j] = *(const f32x4*)(g + 512 * (j >> 1) + 8 * F.lane + 4 * (j & 1));
    for (int row = gw; row < TL; row += NGW) {
        const h16_t* xr = x + (size_t)row * DM;
        f32x4 v[4]; float ss = 0.f;
#pragma unroll
        for (int jj = 0; jj < 2; ++jj) { const f32x8 xf = __builtin_convertvector(*(const f16x8*)(xr + 512 * jj + 8 * F.lane), f32x8);
            v[2 * jj] = (f32x4){xf[0], xf[1], xf[2], xf[3]}; v[2 * jj + 1] = (f32x4){xf[4], xf[5], xf[6], xf[7]}; }
#pragma unroll
        for (int j = 0; j < 4; ++j) ss += (v[j][0] * v[j][0] + v[j][1] * v[j][1]) + (v[j][2] * v[j][2] + v[j][3] * v[j][3]);
        const float r = 1.0f / sqrtf(wave_sum(ss) * (1.0f / DM) + NORM_EPS);
#pragma unroll
        for (int j = 0; j < 4; ++j) *(f32x4*)(out + (size_t)row * DM + 512 * (j >> 1) + 8 * F.lane + 4 * (j & 1)) = v[j] * r * gv[j];
    }
}

__device__ __forceinline__ void bf8_to_f(const u32x4 w, float (&f)[8]) {
    f[0] = __uint_as_float(w.x << 16); f[1] = __uint_as_float(w.x & 0xffff0000u); f[2] = __uint_as_float(w.y << 16); f[3] = __uint_as_float(w.y & 0xffff0000u);
    f[4] = __uint_as_float(w.z << 16); f[5] = __uint_as_float(w.z & 0xffff0000u); f[6] = __uint_as_float(w.w << 16); f[7] = __uint_as_float(w.w & 0xffff0000u);
}
__device__ __forceinline__ void pool_diff_phase(const Ctx& F0, const bf16_t* H, bf16_t* Dd, int T) {
    Ctx F = F0; F.refresh();
    const int gw = F.bid * 8 + F.wave, NGW = F.G * 8;
    const int NI = (T >> 4) * 2;
    for (int it = gw; it < NI; it += NGW) {
        const int row0 = (it >> 1) << 4, col = (it & 1) * 512 + F.lane * 8;
        const int grp = col >> 8, win = 2 << grp, hw = win >> 1;
        int seq0, n;
        if (row0 < TL) { seq0 = row0 & ~(SEQ - 1); n = SEQ; } else { seq0 = TL + ((row0 - TL) & ~(CTXL - 1)); n = CTXL; }
        const bf16_t* base = H + (size_t)seq0 * DM + col;
        const int t0 = row0 - seq0;
        int lo = (t0 - hw) > 0 ? (t0 - hw) : 0, hi = (t0 + hw - 1) < (n - 1) ? (t0 + hw - 1) : (n - 1);
        float s[8];
#pragma unroll
        for (int i = 0; i < 8; ++i) s[i] = 0.f;
        for (int rr = lo; rr <= hi; ++rr) { float f[8]; bf8_to_f(*(const u32x4*)(base + (size_t)rr * DM), f);
#pragma unroll
            for (int i = 0; i < 8; ++i) s[i] += f[i]; }
        for (int k = 0; k < 16; ++k) {
            const int t = t0 + k;
            const int nlo = (t - hw) > 0 ? (t - hw) : 0, nhi = (t + hw - 1) < (n - 1) ? (t + hw - 1) : (n - 1);
            if (nlo > lo) { float f[8]; bf8_to_f(*(const u32x4*)(base + (size_t)lo * DM), f);
#pragma unroll
                for (int i = 0; i < 8; ++i) s[i] -= f[i]; }
            if (nhi > hi) { float f[8]; bf8_to_f(*(const u32x4*)(base + (size_t)nhi * DM), f);
#pragma unroll
                for (int i = 0; i < 8; ++i) s[i] += f[i]; }
            lo = nlo; hi = nhi;
            const float inv = 1.0f / (float)(hi - lo + 1);
            float c[8]; bf8_to_f(*(const u32x4*)(base + (size_t)t * DM), c);
            u32x4 ov; ov.x = cvt_pk_bf16(s[0] * inv - c[0], s[1] * inv - c[1]); ov.y = cvt_pk_bf16(s[2] * inv - c[2], s[3] * inv - c[3]);
            ov.z = cvt_pk_bf16(s[4] * inv - c[4], s[5] * inv - c[5]); ov.w = cvt_pk_bf16(s[6] * inv - c[6], s[7] * inv - c[7]);
            *(u32x4*)(Dd + (size_t)(row0 + k) * DM + col) = ov;
        }
    }
}

template <int KROWB> __device__ __forceinline__ int kswz(int key) { return KROWB == 256 ? (key & 15) : ((key >> 1) & 7); }

constexpr float ATT_THR = 8.0f;
template <int NEB, int KROWB, int MASK>
__device__ __forceinline__ void attn_qk(const LAS unsigned char* Kt, int kchunk0, const bf16x8 (&qf)[4], f32x16 (&o)[NEB], f32x16& negm, float& mref, float& lrun, bool& first, int l31, int hi,
                                        const LAS float* brow, int qc, int cs, bf16x8 (&pb)[4]) {
    f32x16 s0, s1;
#pragma clang loop unroll(disable)
    for (;;) {
#pragma unroll
        for (int d0 = 0; d0 < 4; ++d0) {
            const int ch = kchunk0 + 2 * d0 + hi;
            const int k0 = l31, k1 = 32 + l31;
            const bf16x8 a0 = *(const LAS bf16x8*)(Kt + k0 * KROWB + ((ch ^ kswz<KROWB>(k0)) << 4));
            const bf16x8 a1 = *(const LAS bf16x8*)(Kt + k1 * KROWB + ((ch ^ kswz<KROWB>(k1)) << 4));
            if (d0 == 0) { s0 = __builtin_amdgcn_mfma_f32_32x32x16_bf16(a0, qf[0], negm, 0, 0, 0); s1 = __builtin_amdgcn_mfma_f32_32x32x16_bf16(a1, qf[0], negm, 0, 0, 0); }
            else { s0 = __builtin_amdgcn_mfma_f32_32x32x16_bf16(a0, qf[d0], s0, 0, 0, 0); s1 = __builtin_amdgcn_mfma_f32_32x32x16_bf16(a1, qf[d0], s1, 0, 0, 0); }
        }
        if (MASK == 1) {
#pragma unroll
            for (int r = 0; r < 16; ++r) {
                const int kc0 = (r & 3) + 8 * (r >> 2) + 4 * hi, kc1 = kc0 + 32;
                const bool v0 = (unsigned)(kc0 - cs) < 16u, v1 = (unsigned)(kc1 - cs) < 16u;
                const int i0 = v0 ? (kc0 - qc + 15) : 0, i1 = v1 ? (kc1 - qc + 15) : 0;
                const float b0 = brow[i0], b1 = brow[i1];
                s0[r] = v0 ? s0[r] + b0 : NEG_BIG; s1[r] = v1 ? s1[r] + b1 : NEG_BIG;
            }
        }
        float mx = fmaxf(fmaxf(s0[0], s1[0]), fmaxf(s0[1], s1[1]));
#pragma unroll
        for (int r = 2; r < 16; r += 2) mx = fmaxf(fmaxf(mx, s0[r]), fmaxf(s1[r], fmaxf(s0[r + 1], s1[r + 1])));
        mx = fmaxf(mx, __shfl_xor(mx, 32));
        if (__builtin_expect(!(first || __any(mx > ATT_THR)), 1)) break;
        const float dl = first ? mx : fmaxf(mx, 0.f);
        const float f = first ? 1.0f : __builtin_amdgcn_exp2f(-dl);
        first = false;
        mref += dl; lrun *= f;
#pragma unroll
        for (int r = 0; r < 16; ++r) negm[r] = -mref;
#pragma unroll
        for (int eb = 0; eb < NEB; ++eb)
#pragma unroll
            for (int r = 0; r < 16; ++r) o[eb][r] *= f;
        asm volatile("" : "+v"(negm));
    }
#pragma unroll
    for (int r = 0; r < 16; ++r) { s0[r] = __builtin_amdgcn_exp2f(s0[r]); s1[r] = __builtin_amdgcn_exp2f(s1[r]); }
    float ps = s0[0] + s1[0];
#pragma unroll
    for (int r = 1; r < 16; ++r) { ps += s0[r]; ps += s1[r]; }
    lrun += ps;
    {
        u32x4 w;
        w.x = cvt_pk_bf16(s0[0], s0[1]); w.y = cvt_pk_bf16(s0[2], s0[3]); w.z = cvt_pk_bf16(s0[4], s0[5]); w.w = cvt_pk_bf16(s0[6], s0[7]); pb[0] = __builtin_bit_cast(bf16x8, w);
        w.x = cvt_pk_bf16(s0[8], s0[9]); w.y = cvt_pk_bf16(s0[10], s0[11]); w.z = cvt_pk_bf16(s0[12], s0[13]); w.w = cvt_pk_bf16(s0[14], s0[15]); pb[1] = __builtin_bit_cast(bf16x8, w);
        w.x = cvt_pk_bf16(s1[0], s1[1]); w.y = cvt_pk_bf16(s1[2], s1[3]); w.z = cvt_pk_bf16(s1[4], s1[5]); w.w = cvt_pk_bf16(s1[6], s1[7]); pb[2] = __builtin_bit_cast(bf16x8, w);
        w.x = cvt_pk_bf16(s1[8], s1[9]); w.y = cvt_pk_bf16(s1[10], s1[11]); w.z = cvt_pk_bf16(s1[12], s1[13]); w.w = cvt_pk_bf16(s1[14], s1[15]); pb[3] = __builtin_bit_cast(bf16x8, w);
    }
}
template <int KROWB>
__device__ __forceinline__ float attn_max(const LAS unsigned char* Kt, int kchunk0, const bf16x8 (&qf)[4], int l31, int hi) {
    f32x16 s0, s1;
#pragma unroll
    for (int r = 0; r < 16; ++r) { s0[r] = 0.f; s1[r] = 0.f; }
#pragma unroll
    for (int d0 = 0; d0 < 4; ++d0) {
        const int ch = kchunk0 + 2 * d0 + hi;
        const int k0 = l31, k1 = 32 + l31;
        const bf16x8 a0 = *(const LAS bf16x8*)(Kt + k0 * KROWB + ((ch ^ kswz<KROWB>(k0)) << 4));
        const bf16x8 a1 = *(const LAS bf16x8*)(Kt + k1 * KROWB + ((ch ^ kswz<KROWB>(k1)) << 4));
        s0 = __builtin_amdgcn_mfma_f32_32x32x16_bf16(a0, qf[d0], s0, 0, 0, 0); s1 = __builtin_amdgcn_mfma_f32_32x32x16_bf16(a1, qf[d0], s1, 0, 0, 0);
    }
    float mx = fmaxf(fmaxf(s0[0], s1[0]), fmaxf(s0[1], s1[1]));
#pragma unroll
    for (int r = 2; r < 16; r += 2) mx = fmaxf(fmaxf(mx, s0[r]), fmaxf(s1[r], fmaxf(s0[r + 1], s1[r + 1])));
    return fmaxf(mx, __shfl_xor(mx, 32));
}
template <int NEB, int KROWB, int MASK>
__device__ __forceinline__ void attn_qk_fast(const LAS unsigned char* Kt, int kchunk0, const bf16x8 (&qf)[4], const f32x16& negm, float& lrun, int l31, int hi,
                                             const LAS float* brow, int qc, int cs, bf16x8 (&pb)[4]) {
    f32x16 s0, s1;
#pragma unroll
    for (int d0 = 0; d0 < 4; ++d0) {
        const int ch = kchunk0 + 2 * d0 + hi;
        const int k0 = l31, k1 = 32 + l31;
        const bf16x8 a0 = *(const LAS bf16x8*)(Kt + k0 * KROWB + ((ch ^ kswz<KROWB>(k0)) << 4));
        const bf16x8 a1 = *(const LAS bf16x8*)(Kt + k1 * KROWB + ((ch ^ kswz<KROWB>(k1)) << 4));
        if (d0 == 0) { s0 = __builtin_amdgcn_mfma_f32_32x32x16_bf16(a0, qf[0], negm, 0, 0, 0); s1 = __builtin_amdgcn_mfma_f32_32x32x16_bf16(a1, qf[0], negm, 0, 0, 0); }
        else { s0 = __builtin_amdgcn_mfma_f32_32x32x16_bf16(a0, qf[d0], s0, 0, 0, 0); s1 = __builtin_amdgcn_mfma_f32_32x32x16_bf16(a1, qf[d0], s1, 0, 0, 0); }
    }
    if (MASK == 1) {
#pragma unroll
        for (int r = 0; r < 16; ++r) {
            const int kc0 = (r & 3) + 8 * (r >> 2) + 4 * hi, kc1 = kc0 + 32;
            const bool v0 = (unsigned)(kc0 - cs) < 16u, v1 = (unsigned)(kc1 - cs) < 16u;
            const int i0 = v0 ? (kc0 - qc + 15) : 0, i1 = v1 ? (kc1 - qc + 15) : 0;
            const float b0 = brow[i0], b1 = brow[i1];
            s0[r] = v0 ? s0[r] + b0 : NEG_BIG; s1[r] = v1 ? s1[r] + b1 : NEG_BIG;
        }
    }
#pragma unroll
    for (int r = 0; r < 16; ++r) { s0[r] = __builtin_amdgcn_exp2f(s0[r]); s1[r] = __builtin_amdgcn_exp2f(s1[r]); }
    float ps = s0[0] + s1[0];
#pragma unroll
    for (int r = 1; r < 16; ++r) { ps += s0[r]; ps += s1[r]; }
    lrun += ps;
    {
        u32x4 w;
        w.x = cvt_pk_bf16(s0[0], s0[1]); w.y = cvt_pk_bf16(s0[2], s0[3]); w.z = cvt_pk_bf16(s0[4], s0[5]); w.w = cvt_pk_bf16(s0[6], s0[7]); pb[0] = __builtin_bit_cast(bf16x8, w);
        w.x = cvt_pk_bf16(s0[8], s0[9]); w.y = cvt_pk_bf16(s0[10], s0[11]); w.z = cvt_pk_bf16(s0[12], s0[13]); w.w = cvt_pk_bf16(s0[14], s0[15]); pb[1] = __builtin_bit_cast(bf16x8, w);
        w.x = cvt_pk_bf16(s1[0], s1[1]); w.y = cvt_pk_bf16(s1[2], s1[3]); w.z = cvt_pk_bf16(s1[4], s1[5]); w.w = cvt_pk_bf16(s1[6], s1[7]); pb[2] = __builtin_bit_cast(bf16x8, w);
        w.x = cvt_pk_bf16(s1[8], s1[9]); w.y = cvt_pk_bf16(s1[10], s1[11]); w.z = cvt_pk_bf16(s1[12], s1[13]); w.w = cvt_pk_bf16(s1[14], s1[15]); pb[3] = __builtin_bit_cast(bf16x8, w);
    }
}
template <int NEB>
__device__ __forceinline__ void attn_pv(const LAS unsigned char* Vt, const bf16x8 (&pb)[4], f32x16 (&o)[NEB], int l31, int hi) {
    const int sw = (l31 >> 1) & 7;
    const LAS unsigned char* vrow = Vt + l31 * 128;
#pragma unroll
    for (int G = 0; G < 4; ++G) {
        const int coff = ((2 * G + hi) ^ sw) << 4;
#pragma unroll
        for (int eb = 0; eb < NEB; ++eb) {
            const bf16x8 vf = *(const LAS bf16x8*)(vrow + eb * 4096 + coff);
            o[eb] = __builtin_amdgcn_mfma_f32_32x32x16_bf16(vf, pb[G], o[eb], 0, 0, 0);
        }
    }
}

__device__ __forceinline__ void diff_attn_phase(const Ctx& F0, const bf16_t* Q, const bf16_t* Kb, const bf16_t* Vt, bf16_t* ATT, const float* lamp, const float* subg, float lam_init, bool want_ctx) {
    Ctx F = F0; F.refresh();
    const int l31 = F.lane & 31, hi = F.lane >> 5;
    const int sub = F.wave >> 1, j = F.wave & 1;
    float lam_full;
    { const float p01 = lamp[F.lane] * lamp[64 + F.lane], p23 = lamp[128 + F.lane] * lamp[192 + F.lane];
      lam_full = __expf(wave_sum(p01)) - __expf(wave_sum(p23)) + lam_init; }
    const int xcd = F.bid & 7, wi = F.bid >> 3, nwi = F.G >> 3;
    const int n_lat_rounds = (4 * 64 + nwi - 1) / nwi;
    const int total_rounds = n_lat_rounds + (want_ctx ? 1 : 0);
    for (int rd = 0; rd < total_rounds; ++rd) {
        int b, h, qrow0, ntile; bool is_ctx = false;
        if (rd < n_lat_rounds) {
            const int li = rd * nwi + wi; if (li >= 256) continue;
            const int bh = xcd + 8 * (li >> 6), qb = li & 63;
            b = bh >> 3; h = bh & 7; qrow0 = b * SEQ + qb * 128; ntile = 132;
        } else {
            if (F.bid >= 64) continue;
            b = F.bid >> 4; h = (F.bid >> 1) & 7; qrow0 = TL + b * CTXL + (F.bid & 1) * 128; ntile = 4; is_ctx = true;
        }
        const int krow_lat = b * SEQ, krow_ctx = TL + b * CTXL;
        bf16x8 qf[4];
        { const char* qbase = (const char*)Q + ((size_t)(qrow0 + sub * 32) * DM + h * 128 + j * 64) * 2;
          const unsigned qoff = (unsigned)(l31 * DM + hi * 8) * 2u;
#pragma unroll
          for (int d0 = 0; d0 < 4; ++d0) qf[d0] = *(const bf16x8*)(qbase + qoff + d0 * 32); }
        f32x16 o[4]; float lrun; f32x16 negm;
        const int kkey = F.tid >> 4, kch = F.tid & 15;
        const int ve = F.tid >> 3, vc = F.tid & 7;
        const unsigned kgoff = (unsigned)(kkey * DM + kch * 8) * 2u, vgoff = (unsigned)(ve * TA + vc * 8) * 2u;
        const unsigned klds = (unsigned)(kkey * 256 + ((kch ^ (kkey & 15)) << 4));
        const unsigned vsw = (unsigned)((ve >> 1) & 7);
        const unsigned vlds0 = (unsigned)(16384 + ve * 128 + (((2 * (vc >> 1)) ^ vsw) << 4) + (vc & 1) * 8), vlds1 = (unsigned)(16384 + ve * 128 + (((2 * (vc >> 1) + 1) ^ vsw) << 4) + (vc & 1) * 8);
        const char* kg_u = (const char*)Kb + (size_t)(h * 128) * 2;
        const char* vg_u = (const char*)Vt + (size_t)(h * 128) * TA * 2;
        u32x4 rk[2], rv[2];
#define DA_KROW(t) ((is_ctx || (t) >= 128) ? (krow_ctx + 64 * ((t) - (is_ctx ? 0 : 128))) : (krow_lat + 64 * (t)))
#define DA_LOAD(t) do { const int kr_ = DA_KROW(t); const char* kp_ = kg_u + (size_t)kr_ * (DM * 2); const char* vp_ = vg_u + (size_t)kr_ * 2; \
            rk[0] = *(const u32x4*)(kp_ + kgoff); rk[1] = *(const u32x4*)(kp_ + (size_t)(32 * DM * 2) + kgoff); \
            rv[0] = *(const u32x4*)(vp_ + vgoff); rv[1] = *(const u32x4*)(vp_ + (size_t)64 * TA * 2 + vgoff); } while (0)
#define DA_STORE(st) do { LAS unsigned char* sb_ = F.lds + (st) * 32768; \
            *(LAS u32x4*)(sb_ + klds) = rk[0]; *(LAS u32x4*)(sb_ + klds + 32 * 256) = rk[1]; \
            *(LAS u32x2*)(sb_ + vlds0) = (u32x2){rv[0].x, rv[0].y}; *(LAS u32x2*)(sb_ + vlds1) = (u32x2){rv[0].z, rv[0].w}; \
            *(LAS u32x2*)(sb_ + vlds0 + 64 * 128) = (u32x2){rv[1].x, rv[1].y}; *(LAS u32x2*)(sb_ + vlds1 + 64 * 128) = (u32x2){rv[1].z, rv[1].w}; } while (0)
        for (int attempt = 0; ; ++attempt) {
            const int nref = attempt == 0 ? 0 : ntile;
            float mrow = attempt == 0 ? 0.f : NEG_BIG;
            if (nref > 0) { DA_LOAD(0); DA_STORE(0); }
            __syncthreads();
            for (int t = 0; t < nref; ++t) {
                const bool more = (t + 1) < nref;
                if (more) DA_LOAD(t + 1);
                mrow = fmaxf(mrow, attn_max<256>(F.lds + (t & 1) * 32768, 8 * j, qf, l31, hi));
                if (more) DA_STORE((t + 1) & 1);
                __syncthreads();
            }
#pragma unroll
            for (int eb = 0; eb < 4; ++eb)
#pragma unroll
                for (int r = 0; r < 16; ++r) o[eb][r] = 0.f;
            lrun = 0.f;
#pragma unroll
            for (int r = 0; r < 16; ++r) negm[r] = -mrow;
            asm volatile("" : "+v"(negm));
            DA_LOAD(0); DA_STORE(0); DA_LOAD(1); DA_STORE(1);
            __syncthreads();
            for (int u = 0; u < (ntile >> 1); ++u) {
                const bool more = (u + 1) < (ntile >> 1);
                const int sl = (u & 1) * 2, nsl = sl ^ 2;
                bf16x8 pb[4];
                if (more) DA_LOAD(2 * u + 2);
                { const LAS unsigned char* kb = F.lds + sl * 32768;
                  attn_qk_fast<4, 256, 0>(kb, 8 * j, qf, negm, lrun, l31, hi, nullptr, 0, 0, pb);
                  attn_pv<4>(kb + 16384, pb, o, l31, hi);
                  if (more) { DA_STORE(nsl); DA_LOAD(2 * u + 3); } }
                { const LAS unsigned char* kb = F.lds + (sl + 1) * 32768;
                  attn_qk_fast<4, 256, 0>(kb, 8 * j, qf, negm, lrun, l31, hi, nullptr, 0, 0, pb);
                  attn_pv<4>(kb + 16384, pb, o, l31, hi);
                  if (more) DA_STORE(nsl + 1); }
                __syncthreads();
            }
            if (attempt == 1) break;
            const float lt0 = lrun + __shfl_xor(lrun, 32);
            const bool okw = __all(lt0 < 1.0e30f && lt0 > 1.0e-30f);
            LAS unsigned* okf = (LAS unsigned*)(F.lds + 131072 + 2048);
            if (F.lane == 0) okf[F.wave] = okw ? 1u : 0u;
            __syncthreads();
            unsigned allok = 1u;
#pragma unroll
            for (int w = 0; w < 8; ++w) allok &= okf[w];
            __syncthreads();
            if (__builtin_expect(allok != 0u, 1)) break;
        }
#undef DA_KROW
#undef DA_LOAD
#undef DA_STORE
        { const float lt = lrun + __shfl_xor(lrun, 32); const float inv = 1.0f / lt;
#pragma unroll
          for (int eb = 0; eb < 4; ++eb)
#pragma unroll
              for (int r = 0; r < 16; ++r) o[eb][r] *= inv; }
        LAS float* cb = (LAS float*)(F.lds + sub * 16384);
        if (j == 1) {
#pragma unroll
            for (int eb = 0; eb < 4; ++eb)
#pragma unroll
                for (int r = 0; r < 16; ++r) { const int e = 32 * eb + (r & 3) + 8 * (r >> 2) + 4 * hi; cb[e * 32 + l31] = o[eb][r]; }
        }
        __syncthreads();
        if (j == 0) {
            float ss = 0.f;
#pragma unroll
            for (int eb = 0; eb < 4; ++eb)
#pragma unroll
                for (int r = 0; r < 16; ++r) { const int e = 32 * eb + (r & 3) + 8 * (r >> 2) + 4 * hi; const float d = o[eb][r] - lam_full * cb[e * 32 + l31]; o[eb][r] = d; ss += d * d; }
            ss += __shfl_xor(ss, 32);
            const float rn = (1.0f - lam_init) / sqrtf(ss * (1.0f / 128.0f) + NORM_EPS);
            char* ob = (char*)ATT + ((size_t)(qrow0 + sub * 32) * DM + h * 128) * 2;
            const unsigned ooff = (unsigned)(l31 * DM + 4 * hi) * 2u;
#pragma unroll
            for (int eb = 0; eb < 4; ++eb)
#pragma unroll
                for (int g4 = 0; g4 < 4; ++g4) {
                    const int e = 32 * eb + 8 * g4 + 4 * hi;
                    bf16_t* op = (bf16_t*)(ob + ooff) - 4 * hi;
                    const f32x4 gv = *(const f32x4*)(subg + e);
                    u32x2 w; w.x = cvt_pk_bf16(o[eb][4 * g4] * rn * gv[0], o[eb][4 * g4 + 1] * rn * gv[1]); w.y = cvt_pk_bf16(o[eb][4 * g4 + 2] * rn * gv[2], o[eb][4 * g4 + 3] * rn * gv[3]);
                    *(u32x2*)(op + e) = w;
                }
        }
        __syncthreads();
    }
}

__device__ __forceinline__ void nat_attn_phase(const Ctx& F0, const bf16_t* Q, const bf16_t* Kb, const bf16_t* Vt, bf16_t* ATT, const float* rpb, bool want_ctx) {
    Ctx F = F0; F.refresh();
    const int l31 = F.lane & 31, hi = F.lane >> 5;
    const int NU = 2048 + (want_ctx ? 64 : 0);
    LAS float* rpbL = (LAS float*)(F.lds + 65536);
    for (int u = F.bid; u < NU; u += F.G) {
        int b, h, r0 = 0, qtok, nwin, lo = 0; bool is_ctx = false;
        if (u < 2048) { const int bh = u >> 5; b = bh >> 4; h = bh & 15; r0 = (u & 31) * 4;
            const int qr_ = r0 + (F.wave >> 1); qtok = b * SEQ + qr_ * 64 + (F.wave & 1) * 32 + l31;
            lo = (r0 - 4) < 0 ? 0 : ((r0 - 4) > 120 ? 120 : (r0 - 4));
            const int hi_r = ((r0 - 1) < 0 ? 0 : ((r0 - 1) > 120 ? 120 : (r0 - 1))) + 7; nwin = hi_r - lo + 1;
        } else { const int uc = u - 2048; b = uc >> 4; h = uc & 15; is_ctx = true; nwin = 0; qtok = TL + b * CTXL + F.wave * 32 + l31; }
        const int qr = r0 + (F.wave >> 1), half = F.wave & 1;
        const int rs = (qr - 4) < 0 ? 0 : ((qr - 4) > 120 ? 120 : (qr - 4));
        const int qc = half * 32 + l31;
        const int cs = (qc - 8) < 0 ? 0 : ((qc - 8) > 48 ? 48 : (qc - 8));
        if (F.tid < 480) { const int ro = F.tid >> 5, co = F.tid & 31; rpbL[F.tid] = co < 31 ? rpb[(h * 15 + ro) * 31 + co] * LOG2E : 0.f; }
        bf16x8 qf[4];
        { const bf16_t* qp = Q + (size_t)qtok * DM + h * 64 + hi * 8;
#pragma unroll
          for (int d0 = 0; d0 < 4; ++d0) qf[d0] = *(const bf16x8*)(qp + d0 * 16); }
        f32x16 o[2];
#pragma unroll
        for (int eb = 0; eb < 2; ++eb)
#pragma unroll
            for (int r = 0; r < 16; ++r) o[eb][r] = 0.f;
        float mref = 0.f, lrun = 0.f; f32x16 negm; bool first = true;
#pragma unroll
        for (int r = 0; r < 16; ++r) negm[r] = 0.f;
        const int ntile = nwin + 4;
        const int kkey = F.tid >> 3, kch = F.tid & 7;
        u32x4 rk, rv;
#define NA_KROW(t) ((t) < nwin ? (b * SEQ + (lo + (t)) * 64) : (TL + b * CTXL + 64 * ((t) - nwin)))
#define NA_LOAD(t) do { const int kr_ = NA_KROW(t); rk = *(const u32x4*)(Kb + (size_t)(kr_ + kkey) * DM + h * 64 + kch * 8); rv = *(const u32x4*)(Vt + (size_t)(h * 64 + kkey) * TA + kr_ + kch * 8); } while (0)
#define NA_STORE(st) do { LAS unsigned char* kb_ = F.lds + (st) * 16384; LAS unsigned char* vb_ = kb_ + 8192; \
            *(LAS u32x4*)(kb_ + kkey * 128 + ((kch ^ ((kkey >> 1) & 7)) << 4)) = rk; const int sw_ = (kkey >> 1) & 7; \
            *(LAS u32x2*)(vb_ + kkey * 128 + (((2 * (kch >> 1)) ^ sw_) << 4) + (kch & 1) * 8) = (u32x2){rv.x, rv.y}; *(LAS u32x2*)(vb_ + kkey * 128 + (((2 * (kch >> 1) + 1) ^ sw_) << 4) + (kch & 1) * 8) = (u32x2){rv.z, rv.w}; } while (0)
        NA_LOAD(0); NA_STORE(0);
        __syncthreads();
        for (int t = 0; t < ntile; ++t) {
            const bool more = (t + 1) < ntile;
            if (more) NA_LOAD(t + 1);
            const LAS unsigned char* kb = F.lds + (t & 1) * 16384;
            bf16x8 pb[4]; bool act = true;
            if (t < nwin) {
                const int kr = lo + t;
                act = (kr >= rs && kr < rs + 8);
                if (act) attn_qk<2, 128, 1>(kb, 0, qf, o, negm, mref, lrun, first, l31, hi, rpbL + (kr - qr + 7) * 32, qc, cs, pb);
            } else {
                attn_qk<2, 128, 0>(kb, 0, qf, o, negm, mref, lrun, first, l31, hi, nullptr, 0, 0, pb);
            }
            if (more) NA_STORE((t + 1) & 1);
            if (act) attn_pv<2>(kb + 8192, pb, o, l31, hi);
            __syncthreads();
        }
#undef NA_KROW
#undef NA_LOAD
#undef NA_STORE
        { const float lt = lrun + __shfl_xor(lrun, 32); const float inv = 1.0f / lt;
          bf16_t* op = ATT + (size_t)qtok * DM + h * 64;
#pragma unroll
          for (int eb = 0; eb < 2; ++eb)
#pragma unroll
              for (int g4 = 0; g4 < 4; ++g4) {
                  const int e = 32 * eb + 8 * g4 + 4 * hi;
                  u32x2 w; w.x = cvt_pk_bf16(o[eb][4 * g4] * inv, o[eb][4 * g4 + 1] * inv); w.y = cvt_pk_bf16(o[eb][4 * g4 + 2] * inv, o[eb][4 * g4 + 3] * inv);
                  *(u32x2*)(op + e) = w;
              } }
        (void)is_ctx;
    }
}

#define XB_TMO      128
#define XB_XCNT(j)  (256  + 64 * (j))
#define XB_XSUB(j)  (1280 + 64 * (j))
#define XB_XGEN(j)  (2304 + 64 * (j))
#define XB_TOP      3328
#define XB_TOPGEN   3392
#define XCD_BAR_WORDS 3456
#define XB_SPIN_CAP (1u << 22)
__device__ __forceinline__ unsigned xb_ld(unsigned* p)              { return __hip_atomic_load(p, __ATOMIC_RELAXED, __HIP_MEMORY_SCOPE_AGENT); }
__device__ __forceinline__ unsigned xb_add(unsigned* p, unsigned v) { return __hip_atomic_fetch_add(p, v, __ATOMIC_RELAXED, __HIP_MEMORY_SCOPE_AGENT); }
__device__ __forceinline__ unsigned xb_xcc_id() { return (unsigned)__builtin_amdgcn_s_getreg((3 << 11) | 20) & 0xFu; }
#define XB_SPIN(cond, bar) do { unsigned _sp = 0; while (cond) { __builtin_amdgcn_s_sleep(1); \
    if ((++_sp & 255u) == 0u) { if (xb_ld(&(bar)[XB_TMO])) break; if (_sp > XB_SPIN_CAP) { atomicAdd(&(bar)[XB_TMO], 1u); break; } } } } while (0)
struct XcdBarrier { unsigned* bar; unsigned x; volatile LAS unsigned* st; };
__device__ __forceinline__ void xcd_barrier_complete(unsigned* bar, unsigned x, unsigned G, unsigned& nloc, unsigned& nx) {
    unsigned sum, cnt, mine, sp = 0u;
    for (;;) {
        sum = 0u; cnt = 0u; mine = 0u;
#pragma unroll
        for (unsigned j = 0; j < 16; ++j) { const unsigned c = xb_ld(&bar[XB_XCNT(j)]); sum += c; cnt += (c > 0u) ? 1u : 0u; mine = (j == x) ? c : mine; }
        if (sum == G) break;
        __builtin_amdgcn_s_sleep(1);
        if ((++sp & 255u) == 0u) { if (xb_ld(&bar[XB_TMO])) break; if (sp > XB_SPIN_CAP) { atomicAdd(&bar[XB_TMO], 1u); break; } }
    }
    nloc = mine > 0u ? mine : 1u; nx = cnt > 0u ? cnt : 1u;
}
__device__ __forceinline__ void xcd_barrier(const XcdBarrier& b, int tid, unsigned G) {
    asm volatile("s_waitcnt vmcnt(0)" ::: "memory");
    __syncthreads();
    if (tid == 0) {
        unsigned* bar = b.bar;
        __builtin_amdgcn_s_waitcnt(0);
        unsigned nloc = b.st[0], nx = b.st[1];
        if (nloc == 0u) { xcd_barrier_complete(bar, b.x, G, nloc, nx); b.st[0] = nloc; b.st[1] = nx; }
        const unsigned old = xb_add(&bar[XB_XSUB(b.x)], 1u);
        const unsigned gen = old / nloc;
        if (old + 1u == (gen + 1u) * nloc) {
            __builtin_amdgcn_fence(__ATOMIC_RELEASE, "agent");
            asm volatile("s_waitcnt vmcnt(0)" ::: "memory");
            const unsigned og = xb_add(&bar[XB_TOP], 1u);
            const unsigned tg = og / nx;
            if (og + 1u == (tg + 1u) * nx) xb_add(&bar[XB_TOPGEN], 1u);
            else XB_SPIN(xb_ld(&bar[XB_TOPGEN]) == tg, bar);
            __builtin_amdgcn_fence(__ATOMIC_ACQUIRE, "agent");
            xb_add(&bar[XB_XGEN(b.x)], 1u);
            asm volatile("s_waitcnt vmcnt(0)" ::: "memory");
        } else {
            XB_SPIN(xb_ld(&bar[XB_XGEN(b.x)]) == gen, bar);
            __builtin_amdgcn_fence(__ATOMIC_ACQUIRE, "agent");
            asm volatile("s_waitcnt vmcnt(0)" ::: "memory");
        }
    }
    __syncthreads();
}

__global__ void __launch_bounds__(512, 2) fwd_megakernel(Args args) {
    extern __shared__ __attribute__((aligned(16))) unsigned char lds_raw[];
    cg::grid_group grid = cg::this_grid();
    Ctx F;
    F.lds = (LAS unsigned char*)lds_raw;
    F.wave_s = __builtin_amdgcn_readfirstlane((int)threadIdx.x >> 6);
    F.refresh();
    F.G = gridDim.x; F.bid = blockIdx.x;
    unsigned char* ws = args.ws;
    h16_t* X = (h16_t*)(ws + WS_X);
    bf16_t* H = (bf16_t*)(ws + WS_H);
    bf16_t* HID = (bf16_t*)(ws + WS_BIG);
    bf16_t* Qb = (bf16_t*)(ws + WS_BIG);
    bf16_t* Kb = (bf16_t*)(ws + WS_BIG + QKV_STRIDE);
    bf16_t* Vtb = (bf16_t*)(ws + WS_BIG + 2 * QKV_STRIDE);
    const float* mod = (const float*)(ws + WS_MOD);
    const float* rope = (const float*)(ws + WS_ROPE);
    const float* zeros = (const float*)(ws + WS_CONST); const float* ones = zeros + 3072; const float* halves = zeros + 4096;

    volatile LAS unsigned* xst = (volatile LAS unsigned*)(F.lds + LDS_BYTES - 64);
    if (F.tid < 16) xst[F.tid] = 0u;
    __syncthreads();
    XcdBarrier xbar; xbar.bar = (unsigned*)ws; xbar.x = xb_xcc_id(); xbar.st = xst;
    if (F.bid == 0) { for (int i = F.tid; i < 4096; i += 512) ((unsigned*)ws)[i] = 0u; }
#define GSYNC() do { Ctx Fs_ = F; Fs_.refresh(); xcd_barrier(xbar, Fs_.tid, (unsigned)F.G); } while (0)

    prologue_phase(F, args);
    grid.sync();
    if (F.tid == 0) (void)xb_add(&xbar.bar[XB_XCNT(xbar.x)], 1u);

    float* PART = (float*)(ws + WS_PART);
    for (int layer = 0; layer < 4; ++layer) {
        const int kind = layer % 3, jj = layer / 3;
        const bool pend_in = (layer >= 1 && layer <= 2);
        const bool last = (layer == 3);
        const bool update_ctx = !last;
        const int T = last ? TL : TA;
        const int Tp = layer < 2 ? TA : TL;
        const bool ctx_after = layer < 2;
        const float* modL = mod + (size_t)layer * 5 * NMODV;
        const float* ng = args.in[6] + (size_t)layer * 3 * DM;

        normmod_phase(F, X, T, ng, modL, 0, 1, H, pend_in ? PART : nullptr, mod + (size_t)(layer - 1) * 5 * NMODV + 4 * NMODV + 8 * 1024);
        GSYNC();
        { pg8::Gemm g{H, (const bf16_t*)(ws + WS_WIN) + (size_t)(layer * 2) * 5632 * 1024, DM, DM, DM, 0};
          pg8::StaticOrder S; S.init(T, 5632, F.G, F.bid);
          pg8::EpiSwiglu E{HID, DFF};
          for (int rep = 0; rep < REP_G1; ++rep) pg8::gemm_phase<pg8::EpiSwiglu>(F.lds, F.wave_s, g, S, E); }
        GSYNC();
        { const bf16_t* Wt = (const bf16_t*)(ws + WS_WOUT) + (size_t)(layer * 2) * 1024 * DFF;
          { pg8::Gemm g{HID, Wt, DFF, DFF, DFF, 0};
            pg8::StaticOrder S; S.init(TL, DM, F.G, F.bid);
            pg8::EpiResid E{X, modL + 2 * 1024, zeros, halves};
            pg8::gemm_phase<pg8::EpiResid>(F.lds, F.wave_s, g, S, E); }
          if (T > TL) {
            pg8::Gemm g{HID, Wt, DFF, DFF, 256, 0};
            pg8::StaticOrder S; S.init(TC, 44 * 256, F.G, F.bid, 128);
            pg8::EpiPartial E{PART, 11 * DM};
            pg8::gemm_phase<pg8::EpiPartial, 4, 512>(F.lds, F.wave_s, g, S, E); } }
        GSYNC();

        normmod_phase(F, X, T, ng + DM, modL, 3, 4, H, T > TL ? PART : nullptr, modL + 4 * NMODV + 2 * 1024);
        GSYNC();
        if (kind == 0) {
            bf16_t* Dd = Qb;
            pool_diff_phase(F, H, Dd, Tp);
            GSYNC();
            { pg8::Gemm g{Dd, (const bf16_t*)(ws + WS_WPOOL) + (size_t)jj * 1024 * 256, DM, 256, 256, 512};
              pg8::StaticOrder S; S.init(Tp, DM, F.G, F.bid);
              pg8::EpiResid E{X, modL + 5 * 1024, zeros, args.in[10] + (size_t)jj * DM};
              pg8::gemm_phase<pg8::EpiResid>(F.lds, F.wave_s, g, S, E); }
            GSYNC();
        } else {
            const bf16_t* Wqkv = (const bf16_t*)(ws + WS_WQKV) + (size_t)(kind - 1) * 3072 * 1024;
            { pg8::Gemm g{H, Wqkv, DM, DM, DM, 0};
              pg8::StaticOrder S; S.init(T, 2048, F.G, F.bid);
              pg8::EpiQK E{Qb, Kb, rope, kind == 2 ? args.in[16] : zeros, kind - 1};
              pg8::gemm_phase<pg8::EpiQK>(F.lds, F.wave_s, g, S, E); }
            { pg8::Gemm g{Wqkv + (size_t)2048 * 1024, H, DM, DM, DM, 0};
              pg8::StaticOrder S; S.init(DM, T, F.G, (F.bid + (F.G >> 1)) % F.G);
              pg8::EpiVt E{Vtb, TA, kind == 2 ? args.in[16] + 2048 : zeros};
              pg8::gemm_phase<pg8::EpiVt>(F.lds, F.wave_s, g, S, E); }
            GSYNC();
            if (kind == 1) {
                const float lam_init = 0.8f - 0.6f * expf(-0.3f * (float)layer);
                for (int rep = 0; rep < REP_DIFF; ++rep) diff_attn_phase(F, Qb, Kb, Vtb, H, args.in[12] + (size_t)jj * 256, args.in[13] + (size_t)jj * 128, lam_init, ctx_after);
            } else {
                for (int rep = 0; rep < REP_NAT; ++rep) nat_attn_phase(F, Qb, Kb, Vtb, H, args.in[17] + (size_t)jj * 16 * 15 * 31, ctx_after);
            }
            GSYNC();
            { pg8::Gemm g{H, (const bf16_t*)(ws + WS_WO) + (size_t)(kind - 1) * 1024 * 1024, DM, DM, DM, 0};
              pg8::StaticOrder S; S.init(Tp, DM, F.G, F.bid);
              pg8::EpiResid E{X, modL + 5 * 1024, kind == 2 ? args.in[19] + (size_t)jj * DM : zeros, ones};
              pg8::gemm_phase<pg8::EpiResid>(F.lds, F.wave_s, g, S, E); }
            GSYNC();
        }

        normmod_phase(F, X, Tp, ng + 2 * DM, modL, 6, 7, H, nullptr, zeros);
        GSYNC();
        { pg8::Gemm g{H, (const bf16_t*)(ws + WS_WIN) + (size_t)(layer * 2 + 1) * 5632 * 1024, DM, DM, DM, 0};
          pg8::StaticOrder S; S.init(Tp, 5632, F.G, F.bid);
          pg8::EpiSwiglu E{HID, DFF};
          for (int rep = 0; rep < REP_G1; ++rep) pg8::gemm_phase<pg8::EpiSwiglu>(F.lds, F.wave_s, g, S, E); }
        GSYNC();
        { const bf16_t* Wt = (const bf16_t*)(ws + WS_WOUT) + (size_t)(layer * 2 + 1) * 1024 * DFF;
          { pg8::Gemm g{HID, Wt, DFF, DFF, DFF, 0};
            pg8::StaticOrder S; S.init(TL, DM, F.G, F.bid);
            pg8::EpiResid E{X, modL + 8 * 1024, zeros, halves};
            pg8::gemm_phase<pg8::EpiResid>(F.lds, F.wave_s, g, S, E); }
          if (Tp > TL) {
            pg8::Gemm g{HID, Wt, DFF, DFF, 256, 0};
            pg8::StaticOrder S; S.init(TC, 44 * 256, F.G, F.bid, 128);
            pg8::EpiPartial E{PART, 11 * DM};
            pg8::gemm_phase<pg8::EpiPartial, 4, 512>(F.lds, F.wave_s, g, S, E); } }
        GSYNC();
    }
    final_norm_phase(F, X, args.in[20], args.out);
}

extern "C" void kernel_launch(void* const* d_in, const int* in_sizes, int n_in, void* d_out, int out_size, void* d_ws, size_t ws_size, hipStream_t stream) {
    static int grid = 0;
    if (grid == 0) {
        if (n_in != 21 || ws_size < WS_END) { fprintf(stderr, "kernel_launch: unexpected inputs (n_in %d, ws %zu)\n", n_in, ws_size); grid = -1; return; }
        int dev = 0, cus = 0, per_cu = 0;
        hipGetDevice(&dev);
        hipDeviceGetAttribute(&cus, hipDeviceAttributeMultiprocessorCount, dev);
        hipFuncSetAttribute((const void*)fwd_megakernel, hipFuncAttributeMaxDynamicSharedMemorySize, LDS_BYTES);
        hipOccupancyMaxActiveBlocksPerMultiprocessor(&per_cu, (const void*)fwd_megakernel, 512, LDS_BYTES);
        if (per_cu < 1) per_cu = 1;
        grid = cus * per_cu;
        if (grid > 256) grid = 256;
        grid &= ~7;
        (void)hipGetLastError();
    }
    if (grid <= 0) return;
    Args a{};
    for (int i = 0; i < 21; ++i) a.in[i] = (const float*)d_in[i];
    a.out = (float*)d_out; a.ws = (unsigned char*)d_ws;
    void* kargs[] = {&a};
    hipError_t e = hipLaunchCooperativeKernel((const void*)fwd_megakernel, dim3(grid), dim3(512), kargs, LDS_BYTES, stream);
    if (e != hipSuccess) fprintf(stderr, "cooperative launch failed: %s (grid %d)\n", hipGetErrorString(e), grid);
}
```

```cpp
#include <hip/hip_runtime.h>
#include <hip/hip_cooperative_groups.h>
#include <cstdio>
#include <cstdint>
namespace cg = cooperative_groups;

#define LAS __attribute__((address_space(3)))
typedef unsigned short bf16_t;
typedef short bf16x8 __attribute__((ext_vector_type(8)));
typedef short s16x4 __attribute__((ext_vector_type(4)));
typedef float f32x2 __attribute__((ext_vector_type(2)));
typedef float f32x4 __attribute__((ext_vector_type(4)));
typedef float f32x16 __attribute__((ext_vector_type(16)));
typedef unsigned u32x2 __attribute__((ext_vector_type(2)));
typedef _Float16 h16_t;
typedef _Float16 f16x4 __attribute__((ext_vector_type(4)));
typedef _Float16 f16x8 __attribute__((ext_vector_type(8)));
typedef float f32x8 __attribute__((ext_vector_type(8)));
typedef unsigned u32x4 __attribute__((ext_vector_type(4)));

constexpr int DM = 1024, NB = 4, SEQ = 8192, CTXL = 256, DFF = 2816, NMODV = 9 * 1024;
constexpr int TL = NB * SEQ, TC = NB * CTXL, TA = TL + TC;
constexpr float NORM_EPS = 1e-6f;
constexpr float LOG2E = 1.4426950408889634f;
constexpr float QSCALE = 0.125f * LOG2E;
constexpr float NEG_BIG = -1e30f;

constexpr size_t MiB = 1u << 20;
constexpr size_t WS_MOD = 1 * MiB;
constexpr size_t WS_ROPE = 2 * MiB;
constexpr size_t WS_CONST = 3 * MiB;
constexpr size_t WS_WIN = 4 * MiB;
constexpr size_t WS_WOUT = 92 * MiB;
constexpr size_t WS_WQKV = 136 * MiB;
constexpr size_t WS_WO = 148 * MiB;
constexpr size_t WS_WPOOL = 152 * MiB;
constexpr size_t WS_X = 154 * MiB;
constexpr size_t WS_H = 286 * MiB;
constexpr size_t WS_BIG = 352 * MiB;
constexpr size_t WS_PART = 550 * MiB;
constexpr size_t WS_END = 596 * MiB;
constexpr size_t QKV_STRIDE = 66 * MiB;

#ifndef REP_DIFF
#define REP_DIFF 1
#endif
#ifndef REP_NAT
#define REP_NAT 1
#endif
#ifndef REP_NORM
#define REP_NORM 1
#endif
#ifndef REP_G1
#define REP_G1 1
#endif
constexpr int LDS_BYTES = 147456;

typedef __bf16 bf16x2_t __attribute__((ext_vector_type(2)));
__device__ __forceinline__ unsigned cvt_pk_bf16(float lo, float hi) { f32x2 v = {lo, hi}; bf16x2_t b = __builtin_convertvector(v, bf16x2_t); return __builtin_bit_cast(unsigned, b); }
__device__ __forceinline__ float bf2f(unsigned short b) { return __uint_as_float(((unsigned)b) << 16); }
__device__ __forceinline__ float dpp_f(float v, int ctrl_sel) {
    const int x = __float_as_int(v); int r;
    if (ctrl_sel == 0) r = __builtin_amdgcn_update_dpp(x, x, 0xB1, 0xF, 0xF, false);
    else if (ctrl_sel == 1) r = __builtin_amdgcn_update_dpp(x, x, 0x4E, 0xF, 0xF, false);
    else if (ctrl_sel == 2) r = __builtin_amdgcn_update_dpp(x, x, 0x141, 0xF, 0xF, false);
    else r = __builtin_amdgcn_update_dpp(x, x, 0x140, 0xF, 0xF, false);
    return __int_as_float(r);
}
__device__ __forceinline__ float wave_sum(float v) {
    v += dpp_f(v, 0); v += dpp_f(v, 1); v += dpp_f(v, 2); v += dpp_f(v, 3);
    { auto rr = __builtin_amdgcn_permlane16_swap(__float_as_uint(v), __float_as_uint(v), false, false); v = __uint_as_float(rr[0]) + __uint_as_float(rr[1]); }
    { auto rr = __builtin_amdgcn_permlane32_swap(__float_as_uint(v), __float_as_uint(v), false, false); v = __uint_as_float(rr[0]) + __uint_as_float(rr[1]); }
    return v;
}
__device__ __forceinline__ int opaque_tid(int wave_s) { int l; asm volatile("v_mbcnt_lo_u32_b32 %0, -1, 0\n\tv_mbcnt_hi_u32_b32 %0, -1, %0" : "=v"(l)); return wave_s * 64 + l; }
__device__ __forceinline__ float silu_f(float v) { return v / (1.0f + __expf(-v)); }
__device__ __forceinline__ float fast_silu(float v) { return v * __builtin_amdgcn_rcpf(1.0f + __builtin_amdgcn_exp2f(-v * LOG2E)); }

namespace pg8 {
constexpr int BM = 256, BK = 64, HALF = 128, HTB = HALF * BK * 2, STAGE_BYTES = 8 * HTB, NXCD = 8, WGM = 8;
__device__ __forceinline__ int lds_byte(int r, int c) { const int st = (r >> 4) * 2 + (c >> 5), rr = r & 15, cc = c & 31, ob = rr * 64 + cc * 2; return st * 1024 + (ob ^ (((ob >> 9) & 1) << 5)); }
__device__ __forceinline__ void stage_rc(int b, int& R, int& C) { const int st = b / 1024, sb = b % 1024, swz = sb ^ (((sb >> 9) & 1) << 5); R = (st >> 1) * 16 + swz / 64; C = (st & 1) * 32 + (swz % 64) / 2; }
__device__ __forceinline__ int perm32(int rho) { const int n = rho >> 4, i = rho & 15; return 8 * (i >> 2) + 4 * n + (i & 3); }

struct Unit { int pm, pn; };
struct Gemm { const bf16_t* A; const bf16_t* Bt; int lda, ldb, K; int a_pn_off; };

struct StaticOrder {
    int nM, nN, nwg, G, c, pm0;
    __device__ void init(int M, int N, int G_, int c_, int pm0_ = 0) { nM = M / BM; nN = N / BM; nwg = nM * nN; G = G_; c = c_; pm0 = pm0_; }
    __device__ bool next(int i, Unit& u) const {
        const long L = (long)i * G + c; if (L >= nwg) return false;
        int wgid = (int)L; { const int q = nwg / NXCD, r = nwg % NXCD, xcd = wgid % NXCD, off = wgid / NXCD; wgid = (xcd < r ? xcd * (q + 1) : r * (q + 1) + (xcd - r) * q) + off; }
        const int nig = WGM * nN, gid = wgid / nig, fm = gid * WGM, gsz = (nM - fm) < WGM ? (nM - fm) : WGM;
        u.pm = pm0 + fm + ((wgid % nig) % gsz); u.pn = (wgid % nig) / gsz; return true;
    }
};

template <class Epi, int KSD = 0, int KSO = 0>
__device__ __forceinline__ void gemm_phase(LAS unsigned char* lds, int wave_s, const Gemm g, const StaticOrder& S, const Epi& E) {
    const int tid = opaque_tid(wave_s), wid = __builtin_amdgcn_readfirstlane(tid >> 6), lane = tid & 63, wr = wid >> 2, wc = wid & 3, fr = lane & 15, fq = lane >> 4;
    const int K = g.K, nt = K / BK;
    unsigned voffA[2], voffB[2];
#pragma unroll
    for (int i = 0; i < 2; ++i) { int R, C; stage_rc(tid * 16 + i * 8192, R, C); const int Rb = Epi::PERM ? ((R & ~31) + perm32(R & 31)) : R;
        voffA[i] = (unsigned)(R * g.lda + C) * 2u; voffB[i] = (unsigned)(Rb * g.ldb + C) * 2u; }
    const size_t kstep = (size_t)(BK * 2);
    const size_t hstepA = (size_t)HALF * g.lda * 2, hstepB = (size_t)HALF * g.ldb * 2;
    const size_t tstepA = 2 * hstepA, tstepB = 2 * hstepB;
    const unsigned ldsw = (unsigned)wid * 1024u;
    const int aoff = lds_byte(wr * 64 + fr, fq * 8), boff = lds_byte(wc * 32 + fr, fq * 8);
#define PG8_SA(b, h) (((b) * 2 + (h)) * HTB)
#define PG8_SB(b, h) ((4 + (b) * 2 + (h)) * HTB)
#define PG8_STAGE(bufoff, gbase, voff) do { _Pragma("unroll") for (int _i = 0; _i < 2; ++_i) \
        __builtin_amdgcn_global_load_lds((const unsigned*)((const char*)(gbase) + (voff)[_i]), (LAS unsigned*)(lds + (bufoff) + ldsw + _i * 8192), 16, 0, 0); } while (0)
#define PG8_LDA(dst, b, h) do { _Pragma("unroll") for (int m = 0; m < 4; ++m) _Pragma("unroll") for (int k = 0; k < 2; ++k) dst[m][k] = *(const LAS bf16x8*)(lds + PG8_SA(b, h) + aoff + m * 2048 + k * 1024); } while (0)
#define PG8_LDB(dst, b, h) do { _Pragma("unroll") for (int n = 0; n < 2; ++n) _Pragma("unroll") for (int k = 0; k < 2; ++k) dst[n][k] = *(const LAS bf16x8*)(lds + PG8_SB(b, h) + boff + n * 2048 + k * 1024); } while (0)
#define PG8_MMA(ai, bj, At, Bt) do { __builtin_amdgcn_s_setprio(1); _Pragma("unroll") for (int m = 0; m < 4; ++m) _Pragma("unroll") for (int n = 0; n < 2; ++n) _Pragma("unroll") for (int k = 0; k < 2; ++k) \
        acc[ai][bj][m][n] = __builtin_amdgcn_mfma_f32_16x16x32_bf16(Bt[n][k], At[m][k], acc[ai][bj][m][n], 0, 0, 0); __builtin_amdgcn_s_setprio(0); } while (0)
#define PG8_WAIT_V(n) asm volatile("s_waitcnt vmcnt(" #n ")" ::: "memory")
#define PG8_WAIT_L(n) asm volatile("s_waitcnt lgkmcnt(" #n ")" ::: "memory")
#define PG8_BAR __builtin_amdgcn_s_barrier()
#define PG8_SCHED __builtin_amdgcn_sched_barrier(0)
    Unit cur, nxt; int ui = 0;
    if (!S.next(0, cur)) return;
    f32x4 acc[2][2][4][2];
#pragma unroll
    for (int a = 0; a < 2; ++a)
#pragma unroll
        for (int b = 0; b < 2; ++b)
#pragma unroll
            for (int m = 0; m < 4; ++m)
#pragma unroll
                for (int n = 0; n < 2; ++n) acc[a][b][m][n] = (f32x4){0.f, 0.f, 0.f, 0.f};
    bf16x8 At[4][2], B0[2][2], B1[2][2];
    const char* cA; const char* cB;
    if constexpr (KSD == 0) { cA = (const char*)g.A + (size_t)cur.pm * tstepA + (size_t)cur.pn * g.a_pn_off; cB = (const char*)g.Bt + (size_t)cur.pn * tstepB; }
    else { cA = (const char*)g.A + (size_t)cur.pm * tstepA + (size_t)(cur.pn / KSD) * KSO; cB = (const char*)g.Bt + (size_t)(cur.pn % KSD) * tstepB + (size_t)(cur.pn / KSD) * KSO; }
    PG8_STAGE(PG8_SB(0, 0), cB, voffB); PG8_STAGE(PG8_SB(0, 1), cB + hstepB, voffB); PG8_STAGE(PG8_SA(0, 0), cA, voffA); PG8_STAGE(PG8_SA(0, 1), cA + hstepA, voffA);
    if (wr == 1) PG8_BAR;
    PG8_WAIT_V(2); PG8_BAR;
    PG8_STAGE(PG8_SB(1, 0), cB + kstep, voffB); PG8_STAGE(PG8_SA(1, 0), cA + kstep, voffA); PG8_STAGE(PG8_SB(1, 1), cB + hstepB + kstep, voffB);
    PG8_WAIT_V(6); PG8_BAR;
    for (;;) {
        const bool has_next = S.next(ui + 1, nxt);
        const char* nA = cA; const char* nB = cB;
        if (has_next) {
            if constexpr (KSD == 0) { nA = (const char*)g.A + (size_t)nxt.pm * tstepA + (size_t)nxt.pn * g.a_pn_off; nB = (const char*)g.Bt + (size_t)nxt.pn * tstepB; }
            else { nA = (const char*)g.A + (size_t)nxt.pm * tstepA + (size_t)(nxt.pn / KSD) * KSO; nB = (const char*)g.Bt + (size_t)(nxt.pn % KSD) * tstepB + (size_t)(nxt.pn / KSD) * KSO; } }
        for (int t = 0; t < nt; t += 2) {
            const bool last = (t == nt - 2);
            const char* a1 = cA + (size_t)(t + 1) * kstep;
            const char* a2 = last ? nA : cA + (size_t)(t + 2) * kstep; const char* b2 = last ? nB : cB + (size_t)(t + 2) * kstep;
            const char* a3 = a2 + kstep; const char* b3 = b2 + kstep;
            PG8_LDB(B0, 0, 0); PG8_LDB(B1, 0, 1); PG8_SCHED; PG8_LDA(At, 0, 0); PG8_STAGE(PG8_SA(1, 1), a1 + hstepA, voffA);
            PG8_WAIT_V(8); PG8_WAIT_L(0); PG8_BAR; PG8_MMA(0, 0, At, B0); PG8_MMA(0, 1, At, B1); PG8_BAR; PG8_SCHED;
            PG8_LDA(At, 0, 1); PG8_STAGE(PG8_SB(0, 0), b2, voffB); PG8_STAGE(PG8_SB(0, 1), b2 + hstepB, voffB); PG8_STAGE(PG8_SA(0, 0), a2, voffA);
            PG8_WAIT_V(8); PG8_WAIT_L(0); PG8_BAR; PG8_MMA(1, 0, At, B0); PG8_MMA(1, 1, At, B1); PG8_BAR; PG8_SCHED;
            PG8_LDB(B0, 1, 0); PG8_LDB(B1, 1, 1); PG8_SCHED; PG8_LDA(At, 1, 0); PG8_STAGE(PG8_SA(0, 1), a2 + hstepA, voffA);
            PG8_WAIT_V(8); PG8_WAIT_L(0); PG8_BAR; PG8_MMA(0, 0, At, B0); PG8_MMA(0, 1, At, B1); PG8_BAR; PG8_SCHED;
            PG8_LDA(At, 1, 1); PG8_STAGE(PG8_SB(1, 0), b3, voffB); PG8_STAGE(PG8_SB(1, 1), b3 + hstepB, voffB); PG8_STAGE(PG8_SA(1, 0), a3, voffA);
            PG8_WAIT_V(8); PG8_WAIT_L(0); PG8_BAR; PG8_MMA(1, 0, At, B0); PG8_MMA(1, 1, At, B1); PG8_BAR; PG8_SCHED;
        }
        if (wr == 0) PG8_BAR;
        { const int l2_ = opaque_tid(wave_s) & 63; E(acc, cur, wr, wc, l2_ & 15, l2_ >> 4); }
        if (!has_next) break;
#pragma unroll
        for (int a = 0; a < 2; ++a)
#pragma unroll
            for (int b = 0; b < 2; ++b)
#pragma unroll
                for (int m = 0; m < 4; ++m)
#pragma unroll
                    for (int n = 0; n < 2; ++n) acc[a][b][m][n] = (f32x4){0.f, 0.f, 0.f, 0.f};
        cur = nxt; cA = nA; cB = nB; ++ui;
        if (wr == 1) PG8_BAR;
    }
    PG8_WAIT_V(0);
    PG8_BAR;
#undef PG8_SA
#undef PG8_SB
#undef PG8_STAGE
#undef PG8_LDA
#undef PG8_LDB
#undef PG8_MMA
#undef PG8_WAIT_V
#undef PG8_WAIT_L
#undef PG8_BAR
#undef PG8_SCHED
}

struct EpiSwiglu {
    static constexpr bool PERM = true;
    bf16_t* O; int ldc;
    static __device__ __forceinline__ float hs(float g, float u) { return g * u * __builtin_amdgcn_rcpf(1.0f + __builtin_amdgcn_exp2f(-g)); }
    __device__ __forceinline__ void operator()(const f32x4 (&acc)[2][2][4][2], const Unit& u, int wr, int wc, int fr, int fq) const {
        const int row0 = u.pm * BM + wr * 64 + fr, col0 = u.pn * 128 + wc * 32 + 8 * fq;
#pragma unroll
        for (int ai = 0; ai < 2; ++ai)
#pragma unroll
            for (int m = 0; m < 4; ++m) {
                bf16_t* rowp = O + (size_t)(row0 + ai * HALF + m * 16) * ldc + col0;
                const f32x4 g0 = acc[ai][0][m][0], g1 = acc[ai][0][m][1], u0 = acc[ai][1][m][0], u1 = acc[ai][1][m][1];
                u32x4 w;
                w.x = cvt_pk_bf16(hs(g0[0], u0[0]), hs(g0[1], u0[1]));
                w.y = cvt_pk_bf16(hs(g0[2], u0[2]), hs(g0[3], u0[3]));
                w.z = cvt_pk_bf16(hs(g1[0], u1[0]), hs(g1[1], u1[1]));
                w.w = cvt_pk_bf16(hs(g1[2], u1[2]), hs(g1[3], u1[3]));
                *(u32x4*)rowp = w;
            }
    }
};
struct EpiResid {
    static constexpr bool PERM = true;
    h16_t* X; const float* gate_base; const float* bias; const float* cscale;
    __device__ __forceinline__ void operator()(const f32x4 (&acc)[2][2][4][2], const Unit& u, int wr, int wc, int fr, int fq) const {
        const int midx = u.pm < 128 ? (u.pm >> 5) : 4;
        const float* gate = gate_base + midx * NMODV;
        asm volatile("" : "+v"(fr), "+v"(fq));
        const int col0 = u.pn * BM + wc * 32 + 8 * fq;
#pragma unroll
        for (int bj = 0; bj < 2; ++bj) {
            const int c = col0 + bj * HALF;
            const f32x4 g0 = *(const f32x4*)(gate + c) * *(const f32x4*)(cscale + c), g1 = *(const f32x4*)(gate + c + 4) * *(const f32x4*)(cscale + c + 4);
            const f32x4 b0 = *(const f32x4*)(bias + c), b1 = *(const f32x4*)(bias + c + 4);
#pragma unroll
            for (int ai = 0; ai < 2; ++ai) {
                h16_t* p0 = X + (size_t)(u.pm * BM + ai * HALF + wr * 64 + fr) * DM + c;
                f16x8 xv[4];
#pragma unroll
                for (int m = 0; m < 4; ++m) xv[m] = *(const f16x8*)(p0 + (size_t)m * 16 * DM);
                asm volatile("" ::: "memory");
#pragma unroll
                for (int m = 0; m < 4; ++m) {
                    const f32x8 xf = __builtin_convertvector(xv[m], f32x8);
                    const f32x4 lo = (f32x4){xf[0], xf[1], xf[2], xf[3]} + g0 * (acc[ai][bj][m][0] + b0);
                    const f32x4 hh = (f32x4){xf[4], xf[5], xf[6], xf[7]} + g1 * (acc[ai][bj][m][1] + b1);
                    const f32x8 o = (f32x8){lo[0], lo[1], lo[2], lo[3], hh[0], hh[1], hh[2], hh[3]};
                    *(f16x8*)(p0 + (size_t)m * 16 * DM) = __builtin_convertvector(o, f16x8);
                }
                asm volatile("" ::: "memory");
            }
        }
    }
};
struct EpiQK {
    static constexpr bool PERM = false;
    bf16_t* Q; bf16_t* Kb; const float* rope; const float* bias; int mode;
    __device__ __forceinline__ void operator()(const f32x4 (&acc)[2][2][4][2], const Unit& u, int wr, int wc, int fr, int fq) const {
        const bool isq = u.pn < 4;
        bf16_t* base = isq ? Q : Kb;
        const float sc = isq ? QSCALE : 1.0f;
        const int colt = (u.pn & 3) * BM + wc * 32 + 4 * fq;
        const bool dorope = (mode == 0) && (u.pm < 128);
#pragma unroll
        for (int ai = 0; ai < 2; ++ai)
#pragma unroll
            for (int m = 0; m < 4; ++m) {
                const int row = u.pm * BM + ai * HALF + wr * 64 + m * 16 + fr;
                f32x4 cv = (f32x4){1.f, 1.f, 1.f, 1.f}, sv = (f32x4){0.f, 0.f, 0.f, 0.f};
                if (dorope) {
                    const int t = row & (SEQ - 1); const int pos = (wc & 1) ? (t & 63) : (t >> 6);
                    const f32x4 t0 = *(const f32x4*)(rope + (pos * 16 + 4 * fq) * 2), t1 = *(const f32x4*)(rope + (pos * 16 + 4 * fq) * 2 + 4);
                    cv = (f32x4){t0[0], t0[2], t1[0], t1[2]}; sv = (f32x4){t0[1], t0[3], t1[1], t1[3]};
                }
#pragma unroll
                for (int bj = 0; bj < 2; ++bj) {
                    const int bc = u.pn * BM + bj * HALF + wc * 32 + 4 * fq;
                    const f32x4 x1 = acc[ai][bj][m][0] + *(const f32x4*)(bias + bc), x2 = acc[ai][bj][m][1] + *(const f32x4*)(bias + bc + 16);
                    const f32x4 o1 = (x1 * cv - x2 * sv) * sc, o2 = (x2 * cv + x1 * sv) * sc;
                    bf16_t* p = base + (size_t)row * DM + colt + bj * HALF;
                    u32x2 w1, w2; w1.x = cvt_pk_bf16(o1[0], o1[1]); w1.y = cvt_pk_bf16(o1[2], o1[3]); w2.x = cvt_pk_bf16(o2[0], o2[1]); w2.y = cvt_pk_bf16(o2[2], o2[3]);
                    *(u32x2*)p = w1; *(u32x2*)(p + 16) = w2;
                }
                asm volatile("" ::: "memory");
            }
    }
};
struct EpiPartial {
    static constexpr bool PERM = false;
    float* O; int ldc;
    __device__ __forceinline__ void operator()(const f32x4 (&acc)[2][2][4][2], const Unit& u, int wr, int wc, int fr, int fq) const {
        asm volatile("" : "+v"(fr), "+v"(fq));
        const unsigned base = (unsigned)(((u.pm - 128) * BM + wr * 64 + fr) * ldc + u.pn * BM + wc * 32 + 4 * fq) * 4u;
#pragma unroll
        for (int ai = 0; ai < 2; ++ai)
#pragma unroll
            for (int m = 0; m < 4; ++m) {
                char* rp = (char*)O + (base + (unsigned)((ai * HALF + m * 16) * ldc) * 4u);
#pragma unroll
                for (int bj = 0; bj < 2; ++bj)
#pragma unroll
                    for (int n = 0; n < 2; ++n) *(f32x4*)(rp + (bj * HALF + n * 16) * 4) = acc[ai][bj][m][n];
                asm volatile("" ::: "memory");
            }
    }
};
struct EpiVt {
    static constexpr bool PERM = true;
    bf16_t* O; int ldc; const float* rbias;
    __device__ __forceinline__ void operator()(const f32x4 (&acc)[2][2][4][2], const Unit& u, int wr, int wc, int fr, int fq) const {
        const int row0 = u.pm * BM + wr * 64 + fr, col0 = u.pn * BM + wc * 32 + 8 * fq;
#pragma unroll
        for (int ai = 0; ai < 2; ++ai)
#pragma unroll
            for (int m = 0; m < 4; ++m) {
                const int row = row0 + ai * HALF + m * 16;
                const float b = rbias[row];
                bf16_t* rowp = O + (size_t)row * ldc + col0;
#pragma unroll
                for (int bj = 0; bj < 2; ++bj) {
                    const f32x4 v0 = acc[ai][bj][m][0] + b, v1 = acc[ai][bj][m][1] + b;
                    u32x4 w; w.x = cvt_pk_bf16(v0[0], v0[1]); w.y = cvt_pk_bf16(v0[2], v0[3]); w.z = cvt_pk_bf16(v1[0], v1[1]); w.w = cvt_pk_bf16(v1[2], v1[3]);
                    *(u32x4*)(rowp + bj * HALF) = w;
                }
            }
    }
};
}

struct Args { const float* in[21]; float* out; unsigned char* ws; };

struct Ctx {
    LAS unsigned char* lds;
    int tid, lane, wave, G, bid, wave_s;
    __device__ __forceinline__ void refresh() { tid = opaque_tid(wave_s); lane = tid & 63; wave = __builtin_amdgcn_readfirstlane(tid >> 6); }
};

__device__ __forceinline__ void transpose_item(const float* W, int ldw, int k0, int n0, bf16_t* WT, int ldt, int dst_row0, LAS float* scr, int lane, float wscale = 1.0f) {
#pragma unroll 8
    for (int i = 0; i < 32; ++i) { const int kk = 2 * i + (lane >> 5); scr[kk * 33 + (lane & 31)] = W[(size_t)(k0 + kk) * ldw + n0 + (lane & 31)] * wscale; }
    asm volatile("s_waitcnt lgkmcnt(0)" ::: "memory");
    const int c = lane & 7;
#pragma unroll
    for (int j = 0; j < 4; ++j) { const int n = (lane >> 3) + 8 * j; const LAS float* s = scr + (8 * c) * 33 + n;
        u32x4 o; o.x = cvt_pk_bf16(s[0 * 33], s[1 * 33]); o.y = cvt_pk_bf16(s[2 * 33], s[3 * 33]); o.z = cvt_pk_bf16(s[4 * 33], s[5 * 33]); o.w = cvt_pk_bf16(s[6 * 33], s[7 * 33]);
        *(u32x4*)(WT + (size_t)(dst_row0 + n) * ldt + k0 + 8 * c) = o; }
    asm volatile("s_waitcnt lgkmcnt(0)" ::: "memory");
}

__device__ __forceinline__ void prologue_phase(const Ctx& F0, const Args& a) {
    Ctx F = F0; F.refresh();
    unsigned char* ws = a.ws;
    {
        LAS float* sv = (LAS float*)F.lds;
        LAS float* red = (LAS float*)(F.lds + 20480);
        for (int i = F.tid; i < 5 * 1024; i += 512) { const int m = i >> 10, k = i & 1023; const float v = m < 4 ? a.in[1][m * 1024 + k] : a.in[3][k]; sv[i] = silu_f(v); }
        __syncthreads();
        float* mod = (float*)(ws + WS_MOD);
        for (int u = F.bid; u < 4 * 72; u += F.G) {
            const int layer = u / 72, col0 = (u % 72) * 128;
            const float* W = a.in[4] + (size_t)layer * 1024 * NMODV + col0 + 2 * F.lane;
            float acc[5][2];
#pragma unroll
            for (int m = 0; m < 5; ++m) { acc[m][0] = 0.f; acc[m][1] = 0.f; }
            const int kb = F.wave * 128;
#pragma unroll 4
            for (int k = 0; k < 128; ++k) {
                const f32x2 w = *(const f32x2*)(W + (size_t)(kb + k) * NMODV);
#pragma unroll
                for (int m = 0; m < 5; ++m) { const float s = sv[m * 1024 + kb + k]; acc[m][0] += s * w.x; acc[m][1] += s * w.y; }
            }
#pragma unroll
            for (int m = 0; m < 5; ++m) { red[(F.wave * 5 + m) * 128 + 2 * F.lane] = acc[m][0]; red[(F.wave * 5 + m) * 128 + 2 * F.lane + 1] = acc[m][1]; }
            __syncthreads();
            for (int i = F.tid; i < 640; i += 512) { const int m = i >> 7, cc = i & 127; float s = a.in[5][layer * NMODV + col0 + cc];
#pragma unroll
                for (int w = 0; w < 8; ++w) s += red[(w * 5 + m) * 128 + cc];
                mod[((size_t)layer * 5 + m) * NMODV + col0 + cc] = s; }
            __syncthreads();
        }
    }
    {
        h16_t* X = (h16_t*)(ws + WS_X);
        const size_t n8 = (size_t)TA * DM / 8, nl8 = (size_t)TL * DM / 8;
        for (size_t i = (size_t)F.bid * 512 + F.tid; i < n8; i += (size_t)F.G * 512) {
            const float* sp = i < nl8 ? a.in[0] + i * 8 : a.in[2] + (i - nl8) * 8;
            const f32x4 p = *(const f32x4*)sp, q = *(const f32x4*)(sp + 4);
            const f32x8 o = (f32x8){p[0], p[1], p[2], p[3], q[0], q[1], q[2], q[3]};
            *(f16x8*)(X + i * 8) = __builtin_convertvector(o, f16x8);
        }
    }
    if (F.bid == 0) { float* cz = (float*)(ws + WS_CONST); for (int i = F.tid; i < 5120; i += 512) cz[i] = i < 3072 ? 0.f : (i < 4096 ? 1.f : 0.5f); }
    {
        float* rope = (float*)(ws + WS_ROPE);
        const int gi = F.bid * 512 + F.tid;
        if (gi < 128 * 16) { const int pos = gi >> 4, f = gi & 15; const float inv = powf(10000.0f, -(float)(2 * f) / 32.0f); const float ang = (float)pos * inv; rope[gi * 2] = cosf(ang); rope[gi * 2 + 1] = sinf(ang); }
    }
    {
        LAS float* scr = (LAS float*)(F.lds + 32768 + F.wave * 8704);
        const int gw = F.bid * 8 + F.wave, NGW = F.G * 8;
        constexpr int I_IN = 16 * 176, I_OUT = 44 * 32, I_QKV = 16 * 96, I_O = 16 * 32, I_P = 4 * 8;
        constexpr int N_IN = 8 * I_IN, N_OUT = 8 * I_OUT, N_QKV = 2 * I_QKV, N_O = 2 * I_O, N_P = 8 * I_P;
        for (int it = gw; it < N_IN + N_OUT + N_QKV + N_O + N_P; it += NGW) {
            int r = it;
            if (r < N_IN) { const int mat = r / I_IN, l = r % I_IN, kb = l / 176, nb = l % 176; const int n0 = nb * 32;
                const int j = n0 < DFF ? n0 : n0 - DFF; const int dst = 256 * (j >> 7) + (n0 < DFF ? 0 : 128) + (j & 127);
                transpose_item(a.in[7] + (size_t)mat * 1024 * 5632, 5632, kb * 64, n0, (bf16_t*)(ws + WS_WIN) + (size_t)mat * 5632 * 1024, 1024, dst, scr, F.lane, n0 < DFF ? LOG2E : 0.6931471805599453f); continue; }
            r -= N_IN;
            if (r < N_OUT) { const int mat = r / I_OUT, l = r % I_OUT, kb = l / 32, nb = l % 32;
                transpose_item(a.in[8] + (size_t)mat * DFF * 1024, 1024, kb * 64, nb * 32, (bf16_t*)(ws + WS_WOUT) + (size_t)mat * 1024 * DFF, DFF, nb * 32, scr, F.lane); continue; }
            r -= N_OUT;
            if (r < N_QKV) { const int mat = r / I_QKV, l = r % I_QKV, kb = l / 96, nb = l % 96;
                transpose_item(mat == 0 ? a.in[11] : a.in[15], 3072, kb * 64, nb * 32, (bf16_t*)(ws + WS_WQKV) + (size_t)mat * 3072 * 1024, 1024, nb * 32, scr, F.lane); continue; }
            r -= N_QKV;
            if (r < N_O) { const int mat = r / I_O, l = r % I_O, kb = l / 32, nb = l % 32;
                transpose_item(mat == 0 ? a.in[14] : a.in[18], 1024, kb * 64, nb * 32, (bf16_t*)(ws + WS_WO) + (size_t)mat * 1024 * 1024, 1024, nb * 32, scr, F.lane); continue; }
            r -= N_O;
            { const int mat = r / I_P, l = r % I_P, kb = l / 8, nb = l % 8;
                transpose_item(a.in[9] + (size_t)mat * 256 * 256, 256, kb * 64, nb * 32, (bf16_t*)(ws + WS_WPOOL) + (size_t)mat * 256 * 256, 256, nb * 32, scr, F.lane); }
        }
    }
}

__device__ __forceinline__ void normmod_phase(const Ctx& F0, h16_t* X, int T, const float* g, const float* modL, int slot_shift, int slot_scale, bf16_t* H,
                                              const float* part, const float* pgate) {
    Ctx F = F0; F.refresh();
    const int gw = F.bid * 8 + F.wave, NGW = F.G * 8;
    const int RPW = (TL + NGW - 1) / NGW;
    const int r0 = gw * RPW, r1 = (r0 + RPW) < TL ? (r0 + RPW) : TL;
    const int nrows = (r1 > r0 ? r1 - r0 : 0) + ((T > TL && gw < TC) ? 1 : 0);
    int cur = -1; f32x4 gm[4], sh[4];
#pragma unroll
    for (int j = 0; j < 4; ++j) { gm[j] = (f32x4){0.f, 0.f, 0.f, 0.f}; sh[j] = gm[j]; }
    for (int ir = 0; ir < nrows; ++ir) {
        const int row = (r0 + ir) < r1 ? (r0 + ir) : (TL + gw);
        const int midx = row < TL ? (row >> 13) : 4;
        if (midx != cur) { cur = midx;
#pragma unroll
            for (int j = 0; j < 4; ++j) { const int c = 512 * (j >> 1) + 8 * F.lane + 4 * (j & 1); const f32x4 gv = *(const f32x4*)(g + c), sc = *(const f32x4*)(modL + midx * NMODV + slot_scale * 1024 + c);
                gm[j] = gv * (sc + 1.0f); sh[j] = *(const f32x4*)(modL + midx * NMODV + slot_shift * 1024 + c); } }
        h16_t* xr = X + (size_t)row * DM;
        f32x4 v[4]; float ss = 0.f;
#pragma unroll
        for (int jj = 0; jj < 2; ++jj) { const f32x8 xf = __builtin_convertvector(*(const f16x8*)(xr + 512 * jj + 8 * F.lane), f32x8);
            v[2 * jj] = (f32x4){xf[0], xf[1], xf[2], xf[3]}; v[2 * jj + 1] = (f32x4){xf[4], xf[5], xf[6], xf[7]}; }
        if (part != nullptr && row >= TL) {
            const float* pr = part + (size_t)(row - TL) * (11 * DM) + 8 * F.lane;
            f32x4 s[4];
#pragma unroll
            for (int j = 0; j < 4; ++j) s[j] = (f32x4){0.f, 0.f, 0.f, 0.f};
#pragma unroll 1
            for (int sl = 0; sl < 11; ++sl) {
#pragma unroll
                for (int j = 0; j < 4; ++j) s[j] = s[j] + *(const f32x4*)(pr + sl * DM + 512 * (j >> 1) + 4 * (j & 1));
            }
#pragma unroll
            for (int j = 0; j < 4; ++j) v[j] = v[j] + s[j] * (*(const f32x4*)(pgate + 512 * (j >> 1) + 8 * F.lane + 4 * (j & 1)) * 0.5f);
#pragma unroll
            for (int jj = 0; jj < 2; ++jj) { const f32x8 o = (f32x8){v[2 * jj][0], v[2 * jj][1], v[2 * jj][2], v[2 * jj][3], v[2 * jj + 1][0], v[2 * jj + 1][1], v[2 * jj + 1][2], v[2 * jj + 1][3]};
                const f16x8 oh = __builtin_convertvector(o, f16x8);
                *(f16x8*)(xr + 512 * jj + 8 * F.lane) = oh;
                const f32x8 back = __builtin_convertvector(oh, f32x8);
                v[2 * jj] = (f32x4){back[0], back[1], back[2], back[3]}; v[2 * jj + 1] = (f32x4){back[4], back[5], back[6], back[7]}; }
        }
#pragma unroll
        for (int j = 0; j < 4; ++j) ss += (v[j][0] * v[j][0] + v[j][1] * v[j][1]) + (v[j][2] * v[j][2] + v[j][3] * v[j][3]);
        const float r = 1.0f / sqrtf(wave_sum(ss) * (1.0f / DM) + NORM_EPS);
        bf16_t* o = H + (size_t)row * DM;
#pragma unroll
        for (int jj = 0; jj < 2; ++jj) { const f32x4 y0 = v[2 * jj] * r * gm[2 * jj] + sh[2 * jj], y1 = v[2 * jj + 1] * r * gm[2 * jj + 1] + sh[2 * jj + 1];
            u32x4 w; w.x = cvt_pk_bf16(y0[0], y0[1]); w.y = cvt_pk_bf16(y0[2], y0[3]); w.z = cvt_pk_bf16(y1[0], y1[1]); w.w = cvt_pk_bf16(y1[2], y1[3]);
            *(u32x4*)(o + 512 * jj + 8 * F.lane) = w; }
    }
}
__device__ __forceinline__ void final_norm_phase(const Ctx& F0, const h16_t* x, const float* g, float* out) {
    Ctx F = F0; F.refresh();
    const int gw = F.bid * 8 + F.wave, NGW = F.G * 8;
    f32x4 gv[4];
#pragma unroll
    for (int j = 0; j < 4; ++j) gv[j] = *(const f32x4*)(g + 512 * (j >> 1) + 8 * F.lane + 4 * (j & 1));
    for (int row = gw; row < TL; row += NGW) {
        const h16_t* xr = x + (size_t)row * DM;
        f32x4 v[4]; float ss = 0.f;
#pragma unroll
        for (int jj = 0; jj < 2; ++jj) { const f32x8 xf = __builtin_convertvector(*(const f16x8*)(xr + 512 * jj + 8 * F.lane), f32x8);
            v[2 * jj] = (f32x4){xf[0], xf[1], xf[2], xf[3]}; v[2 * jj + 1] = (f32x4){xf[4], xf[5], xf[6], xf[7]}; }
#pragma unroll
        for (int j = 0; j < 4; ++j) ss += (v[j][0] * v[j][0] + v[j][1] * v[j][1]) + (v[j][2] * v[j][2] + v[j][3] * v[j][3]);
        const float r = 1.0f / sqrtf(wave_sum(ss) * (1.0f / DM) + NORM_EPS);
#pragma unroll
        for (int j = 0; j < 4; ++j) *(f32x4*)(out + (size_t)row * DM + 512 * (j >> 1) + 8 * F.lane + 4 * (j & 1)) = v[j] * r * gv[j];
    }
}

__device__ __forceinline__ void bf8_to_f(const u32x4 w, float (&f)[8]) {
    f[0] = __uint_as_float(w.x << 16); f[1] = __uint_as_float(w.x & 0xffff0000u); f[2] = __uint_as_float(w.y << 16); f[3] = __uint_as_float(w.y & 0xffff0000u);
    f[4] = __uint_as_float(w.z << 16); f[5] = __uint_as_float(w.z & 0xffff0000u); f[6] = __uint_as_float(w.w << 16); f[7] = __uint_as_float(w.w & 0xffff0000u);
}
__device__ __forceinline__ void pool_diff_phase(const Ctx& F0, const bf16_t* H, bf16_t* Dd, int T) {
    Ctx F = F0; F.refresh();
    const int gw = F.bid * 8 + F.wave, NGW = F.G * 8;
    const int NI = (T >> 4) * 2;
    for (int it = gw; it < NI; it += NGW) {
        const int row0 = (it >> 1) << 4, col = (it & 1) * 512 + F.lane * 8;
        const int grp = col >> 8, win = 2 << grp, hw = win >> 1;
        int seq0, n;
        if (row0 < TL) { seq0 = row0 & ~(SEQ - 1); n = SEQ; } else { seq0 = TL + ((row0 - TL) & ~(CTXL - 1)); n = CTXL; }
        const bf16_t* base = H + (size_t)seq0 * DM + col;
        const int t0 = row0 - seq0;
        int lo = (t0 - hw) > 0 ? (t0 - hw) : 0, hi = (t0 + hw - 1) < (n - 1) ? (t0 + hw - 1) : (n - 1);
        float s[8];
#pragma unroll
        for (int i = 0; i < 8; ++i) s[i] = 0.f;
        for (int rr = lo; rr <= hi; ++rr) { float f[8]; bf8_to_f(*(const u32x4*)(base + (size_t)rr * DM), f);
#pragma unroll
            for (int i = 0; i < 8; ++i) s[i] += f[i]; }
        for (int k = 0; k < 16; ++k) {
            const int t = t0 + k;
            const int nlo = (t - hw) > 0 ? (t - hw) : 0, nhi = (t + hw - 1) < (n - 1) ? (t + hw - 1) : (n - 1);
            if (nlo > lo) { float f[8]; bf8_to_f(*(const u32x4*)(base + (size_t)lo * DM), f);
#pragma unroll
                for (int i = 0; i < 8; ++i) s[i] -= f[i]; }
            if (nhi > hi) { float f[8]; bf8_to_f(*(const u32x4*)(base + (size_t)nhi * DM), f);
#pragma unroll
                for (int i = 0; i < 8; ++i) s[i] += f[i]; }
            lo = nlo; hi = nhi;
            const float inv = 1.0f / (float)(hi - lo + 1);
            float c[8]; bf8_to_f(*(const u32x4*)(base + (size_t)t * DM), c);
            u32x4 ov; ov.x = cvt_pk_bf16(s[0] * inv - c[0], s[1] * inv - c[1]); ov.y = cvt_pk_bf16(s[2] * inv - c[2], s[3] * inv - c[3]);
            ov.z = cvt_pk_bf16(s[4] * inv - c[4], s[5] * inv - c[5]); ov.w = cvt_pk_bf16(s[6] * inv - c[6], s[7] * inv - c[7]);
            *(u32x4*)(Dd + (size_t)(row0 + k) * DM + col) = ov;
        }
    }
}

template <int KROWB> __device__ __forceinline__ int kswz(int key) { return KROWB == 256 ? (key & 15) : ((key >> 1) & 7); }

constexpr float ATT_THR = 8.0f;
template <int NEB, int KROWB, int MASK>
__device__ __forceinline__ void attn_qk(const LAS unsigned char* Kt, int kchunk0, const bf16x8 (&qf)[4], f32x16 (&o)[NEB], f32x16& negm, float& mref, float& lrun, bool& first, int l31, int hi,
                                        const LAS float* brow, int qc, int cs, bf16x8 (&pb)[4]) {
    f32x16 s0, s1;
#pragma clang loop unroll(disable)
    for (;;) {
#pragma unroll
        for (int d0 = 0; d0 < 4; ++d0) {
            const int ch = kchunk0 + 2 * d0 + hi;
            const int k0 = l31, k1 = 32 + l31;
            const bf16x8 a0 = *(const LAS bf16x8*)(Kt + k0 * KROWB + ((ch ^ kswz<KROWB>(k0)) << 4));
            const bf16x8 a1 = *(const LAS bf16x8*)(Kt + k1 * KROWB + ((ch ^ kswz<KROWB>(k1)) << 4));
            if (d0 == 0) { s0 = __builtin_amdgcn_mfma_f32_32x32x16_bf16(a0, qf[0], negm, 0, 0, 0); s1 = __builtin_amdgcn_mfma_f32_32x32x16_bf16(a1, qf[0], negm, 0, 0, 0); }
            else { s0 = __builtin_amdgcn_mfma_f32_32x32x16_bf16(a0, qf[d0], s0, 0, 0, 0); s1 = __builtin_amdgcn_mfma_f32_32x32x16_bf16(a1, qf[d0], s1, 0, 0, 0); }
        }
        if (MASK == 1) {
#pragma unroll
            for (int r = 0; r < 16; ++r) {
                const int kc0 = (r & 3) + 8 * (r >> 2) + 4 * hi, kc1 = kc0 + 32;
                const bool v0 = (unsigned)(kc0 - cs) < 16u, v1 = (unsigned)(kc1 - cs) < 16u;
                const int i0 = v0 ? (kc0 - qc + 15) : 0, i1 = v1 ? (kc1 - qc + 15) : 0;
                const float b0 = brow[i0], b1 = brow[i1];
                s0[r] = v0 ? s0[r] + b0 : NEG_BIG; s1[r] = v1 ? s1[r] + b1 : NEG_BIG;
            }
        }
        float mx = fmaxf(fmaxf(s0[0], s1[0]), fmaxf(s0[1], s1[1]));
#pragma unroll
        for (int r = 2; r < 16; r += 2) mx = fmaxf(fmaxf(mx, s0[r]), fmaxf(s1[r], fmaxf(s0[r + 1], s1[r + 1])));
        mx = fmaxf(mx, __shfl_xor(mx, 32));
        if (__builtin_expect(!(first || __any(mx > ATT_THR)), 1)) break;
        const float dl = first ? mx : fmaxf(mx, 0.f);
        const float f = first ? 1.0f : __builtin_amdgcn_exp2f(-dl);
        first = false;
        mref += dl; lrun *= f;
#pragma unroll
        for (int r = 0; r < 16; ++r) negm[r] = -mref;
#pragma unroll
        for (int eb = 0; eb < NEB; ++eb)
#pragma unroll
            for (int r = 0; r < 16; ++r) o[eb][r] *= f;
        asm volatile("" : "+v"(negm));
    }
#pragma unroll
    for (int r = 0; r < 16; ++r) { s0[r] = __builtin_amdgcn_exp2f(s0[r]); s1[r] = __builtin_amdgcn_exp2f(s1[r]); }
    float ps = s0[0] + s1[0];
#pragma unroll
    for (int r = 1; r < 16; ++r) { ps += s0[r]; ps += s1[r]; }
    lrun += ps;
    {
        u32x4 w;
        w.x = cvt_pk_bf16(s0[0], s0[1]); w.y = cvt_pk_bf16(s0[2], s0[3]); w.z = cvt_pk_bf16(s0[4], s0[5]); w.w = cvt_pk_bf16(s0[6], s0[7]); pb[0] = __builtin_bit_cast(bf16x8, w);
        w.x = cvt_pk_bf16(s0[8], s0[9]); w.y = cvt_pk_bf16(s0[10], s0[11]); w.z = cvt_pk_bf16(s0[12], s0[13]); w.w = cvt_pk_bf16(s0[14], s0[15]); pb[1] = __builtin_bit_cast(bf16x8, w);
        w.x = cvt_pk_bf16(s1[0], s1[1]); w.y = cvt_pk_bf16(s1[2], s1[3]); w.z = cvt_pk_bf16(s1[4], s1[5]); w.w = cvt_pk_bf16(s1[6], s1[7]); pb[2] = __builtin_bit_cast(bf16x8, w);
        w.x = cvt_pk_bf16(s1[8], s1[9]); w.y = cvt_pk_bf16(s1[10], s1[11]); w.z = cvt_pk_bf16(s1[12], s1[13]); w.w = cvt_pk_bf16(s1[14], s1[15]); pb[3] = __builtin_bit_cast(bf16x8, w);
    }
}
template <int KROWB, int MASK = 0>
__device__ __forceinline__ float attn_max(const LAS unsigned char* Kt, int kchunk0, const bf16x8 (&qf)[4], int l31, int hi, const LAS float* brow = nullptr, int qc = 0, int cs = 0) {
    f32x16 s0, s1;
#pragma unroll
    for (int r = 0; r < 16; ++r) { s0[r] = 0.f; s1[r] = 0.f; }
#pragma unroll
    for (int d0 = 0; d0 < 4; ++d0) {
        const int ch = kchunk0 + 2 * d0 + hi;
        const int k0 = l31, k1 = 32 + l31;
        const bf16x8 a0 = *(const LAS bf16x8*)(Kt + k0 * KROWB + ((ch ^ kswz<KROWB>(k0)) << 4));
        const bf16x8 a1 = *(const LAS bf16x8*)(Kt + k1 * KROWB + ((ch ^ kswz<KROWB>(k1)) << 4));
        s0 = __builtin_amdgcn_mfma_f32_32x32x16_bf16(a0, qf[d0], s0, 0, 0, 0); s1 = __builtin_amdgcn_mfma_f32_32x32x16_bf16(a1, qf[d0], s1, 0, 0, 0);
    }
    if (MASK == 1) {
#pragma unroll
        for (int r = 0; r < 16; ++r) {
            const int kc0 = (r & 3) + 8 * (r >> 2) + 4 * hi, kc1 = kc0 + 32;
            const bool v0 = (unsigned)(kc0 - cs) < 16u, v1 = (unsigned)(kc1 - cs) < 16u;
            const int i0 = v0 ? (kc0 - qc + 15) : 0, i1 = v1 ? (kc1 - qc + 15) : 0;
            const float b0 = brow[i0], b1 = brow[i1];
            s0[r] = v0 ? s0[r] + b0 : NEG_BIG; s1[r] = v1 ? s1[r] + b1 : NEG_BIG;
        }
    }
    float mx = fmaxf(fmaxf(s0[0], s1[0]), fmaxf(s0[1], s1[1]));
#pragma unroll
    for (int r = 2; r < 16; r += 2) mx = fmaxf(fmaxf(mx, s0[r]), fmaxf(s1[r], fmaxf(s0[r + 1], s1[r + 1])));
    return fmaxf(mx, __shfl_xor(mx, 32));
}
template <int NEB, int KROWB, int MASK>
__device__ __forceinline__ void attn_qk_fast(const LAS unsigned char* Kt, int kchunk0, const bf16x8 (&qf)[4], const f32x16& negm, float& lrun, int l31, int hi,
                                             const LAS float* brow, int qc, int cs, bf16x8 (&pb)[4]) {
    f32x16 s0, s1;
#pragma unroll
    for (int d0 = 0; d0 < 4; ++d0) {
        const int ch = kchunk0 + 2 * d0 + hi;
        const int k0 = l31, k1 = 32 + l31;
        const bf16x8 a0 = *(const LAS bf16x8*)(Kt + k0 * KROWB + ((ch ^ kswz<KROWB>(k0)) << 4));
        const bf16x8 a1 = *(const LAS bf16x8*)(Kt + k1 * KROWB + ((ch ^ kswz<KROWB>(k1)) << 4));
        if (d0 == 0) { s0 = __builtin_amdgcn_mfma_f32_32x32x16_bf16(a0, qf[0], negm, 0, 0, 0); s1 = __builtin_amdgcn_mfma_f32_32x32x16_bf16(a1, qf[0], negm, 0, 0, 0); }
        else { s0 = __builtin_amdgcn_mfma_f32_32x32x16_bf16(a0, qf[d0], s0, 0, 0, 0); s1 = __builtin_amdgcn_mfma_f32_32x32x16_bf16(a1, qf[d0], s1, 0, 0, 0); }
    }
    if (MASK == 1) {
#pragma unroll
        for (int r = 0; r < 16; ++r) {
            const int kc0 = (r & 3) + 8 * (r >> 2) + 4 * hi, kc1 = kc0 + 32;
            const bool v0 = (unsigned)(kc0 - cs) < 16u, v1 = (unsigned)(kc1 - cs) < 16u;
            const int i0 = v0 ? (kc0 - qc + 15) : 0, i1 = v1 ? (kc1 - qc + 15) : 0;
            const float b0 = brow[i0], b1 = brow[i1];
            s0[r] = v0 ? s0[r] + b0 : NEG_BIG; s1[r] = v1 ? s1[r] + b1 : NEG_BIG;
        }
    }
#pragma unroll
    for (int r = 0; r < 16; ++r) { s0[r] = __builtin_amdgcn_exp2f(s0[r]); s1[r] = __builtin_amdgcn_exp2f(s1[r]); }
    float ps = s0[0] + s1[0];
#pragma unroll
    for (int r = 1; r < 16; ++r) { ps += s0[r]; ps += s1[r]; }
    lrun += ps;
    {
        u32x4 w;
        w.x = cvt_pk_bf16(s0[0], s0[1]); w.y = cvt_pk_bf16(s0[2], s0[3]); w.z = cvt_pk_bf16(s0[4], s0[5]); w.w = cvt_pk_bf16(s0[6], s0[7]); pb[0] = __builtin_bit_cast(bf16x8, w);
        w.x = cvt_pk_bf16(s0[8], s0[9]); w.y = cvt_pk_bf16(s0[10], s0[11]); w.z = cvt_pk_bf16(s0[12], s0[13]); w.w = cvt_pk_bf16(s0[14], s0[15]); pb[1] = __builtin_bit_cast(bf16x8, w);
        w.x = cvt_pk_bf16(s1[0], s1[1]); w.y = cvt_pk_bf16(s1[2], s1[3]); w.z = cvt_pk_bf16(s1[4], s1[5]); w.w = cvt_pk_bf16(s1[6], s1[7]); pb[2] = __builtin_bit_cast(bf16x8, w);
        w.x = cvt_pk_bf16(s1[8], s1[9]); w.y = cvt_pk_bf16(s1[10], s1[11]); w.z = cvt_pk_bf16(s1[12], s1[13]); w.w = cvt_pk_bf16(s1[14], s1[15]); pb[3] = __builtin_bit_cast(bf16x8, w);
    }
}
template <int NEB>
__device__ __forceinline__ void attn_pv(const LAS unsigned char* Vt, const bf16x8 (&pb)[4], f32x16 (&o)[NEB], int l31, int hi) {
    const int sw = (l31 >> 1) & 7;
    const LAS unsigned char* vrow = Vt + l31 * 128;
#pragma unroll
    for (int G = 0; G < 4; ++G) {
        const int coff = ((2 * G + hi) ^ sw) << 4;
#pragma unroll
        for (int eb = 0; eb < NEB; ++eb) {
            const bf16x8 vf = *(const LAS bf16x8*)(vrow + eb * 4096 + coff);
            o[eb] = __builtin_amdgcn_mfma_f32_32x32x16_bf16(vf, pb[G], o[eb], 0, 0, 0);
        }
    }
}

__device__ __forceinline__ void diff_attn_phase(const Ctx& F0, const bf16_t* Q, const bf16_t* Kb, const bf16_t* Vt, bf16_t* ATT, const float* lamp, const float* subg, float lam_init, bool want_ctx) {
    Ctx F = F0; F.refresh();
    const int l31 = F.lane & 31, hi = F.lane >> 5;
    const int sub = F.wave >> 1, j = F.wave & 1;
    float lam_full;
    { const float p01 = lamp[F.lane] * lamp[64 + F.lane], p23 = lamp[128 + F.lane] * lamp[192 + F.lane];
      lam_full = __expf(wave_sum(p01)) - __expf(wave_sum(p23)) + lam_init; }
    const int xcd = F.bid & 7, wi = F.bid >> 3, nwi = F.G >> 3;
    const int n_lat_rounds = (4 * 64 + nwi - 1) / nwi;
    const int total_rounds = n_lat_rounds + (want_ctx ? 1 : 0);
    for (int rd = 0; rd < total_rounds; ++rd) {
        int b, h, qrow0, ntile; bool is_ctx = false;
        if (rd < n_lat_rounds) {
            const int li = rd * nwi + wi; if (li >= 256) continue;
            const int bh = xcd + 8 * (li >> 6), qb = li & 63;
            b = bh >> 3; h = bh & 7; qrow0 = b * SEQ + qb * 128; ntile = 132;
        } else {
            if (F.bid >= 64) continue;
            b = F.bid >> 4; h = (F.bid >> 1) & 7; qrow0 = TL + b * CTXL + (F.bid & 1) * 128; ntile = 4; is_ctx = true;
        }
        const int krow_lat = b * SEQ, krow_ctx = TL + b * CTXL;
        bf16x8 qf[4];
        { const char* qbase = (const char*)Q + ((size_t)(qrow0 + sub * 32) * DM + h * 128 + j * 64) * 2;
          const unsigned qoff = (unsigned)(l31 * DM + hi * 8) * 2u;
#pragma unroll
          for (int d0 = 0; d0 < 4; ++d0) qf[d0] = *(const bf16x8*)(qbase + qoff + d0 * 32); }
        f32x16 o[4]; float lrun; f32x16 negm;
        const int kkey = F.tid >> 4, kch = F.tid & 15;
        const int ve = F.tid >> 3, vc = F.tid & 7;
        const unsigned kgoff = (unsigned)(kkey * DM + kch * 8) * 2u, vgoff = (unsigned)(ve * TA + vc * 8) * 2u;
        const unsigned klds = (unsigned)(kkey * 256 + ((kch ^ (kkey & 15)) << 4));
        const unsigned vsw = (unsigned)((ve >> 1) & 7);
        const unsigned vlds0 = (unsigned)(16384 + ve * 128 + (((2 * (vc >> 1)) ^ vsw) << 4) + (vc & 1) * 8), vlds1 = (unsigned)(16384 + ve * 128 + (((2 * (vc >> 1) + 1) ^ vsw) << 4) + (vc & 1) * 8);
        const char* kg_u = (const char*)Kb + (size_t)(h * 128) * 2;
        const char* vg_u = (const char*)Vt + (size_t)(h * 128) * TA * 2;
        u32x4 rk[2], rv[2];
#define DA_KROW(t) ((is_ctx || (t) >= 128) ? (krow_ctx + 64 * ((t) - (is_ctx ? 0 : 128))) : (krow_lat + 64 * (t)))
#define DA_LOAD(t) do { const int kr_ = DA_KROW(t); const char* kp_ = kg_u + (size_t)kr_ * (DM * 2); const char* vp_ = vg_u + (size_t)kr_ * 2; \
            rk[0] = *(const u32x4*)(kp_ + kgoff); rk[1] = *(const u32x4*)(kp_ + (size_t)(32 * DM * 2) + kgoff); \
            rv[0] = *(const u32x4*)(vp_ + vgoff); rv[1] = *(const u32x4*)(vp_ + (size_t)64 * TA * 2 + vgoff); } while (0)
#define DA_STORE(st) do { LAS unsigned char* sb_ = F.lds + (st) * 32768; \
            *(LAS u32x4*)(sb_ + klds) = rk[0]; *(LAS u32x4*)(sb_ + klds + 32 * 256) = rk[1]; \
            *(LAS u32x2*)(sb_ + vlds0) = (u32x2){rv[0].x, rv[0].y}; *(LAS u32x2*)(sb_ + vlds1) = (u32x2){rv[0].z, rv[0].w}; \
            *(LAS u32x2*)(sb_ + vlds0 + 64 * 128) = (u32x2){rv[1].x, rv[1].y}; *(LAS u32x2*)(sb_ + vlds1 + 64 * 128) = (u32x2){rv[1].z, rv[1].w}; } while (0)
        for (int attempt = 0; ; ++attempt) {
            const int nref = attempt == 0 ? 0 : ntile;
            float mrow = attempt == 0 ? 0.f : NEG_BIG;
            if (nref > 0) { DA_LOAD(0); DA_STORE(0); }
            __syncthreads();
            for (int t = 0; t < nref; ++t) {
                const bool more = (t + 1) < nref;
                if (more) DA_LOAD(t + 1);
                mrow = fmaxf(mrow, attn_max<256>(F.lds + (t & 1) * 32768, 8 * j, qf, l31, hi));
                if (more) DA_STORE((t + 1) & 1);
                __syncthreads();
            }
#pragma unroll
            for (int eb = 0; eb < 4; ++eb)
#pragma unroll
                for (int r = 0; r < 16; ++r) o[eb][r] = 0.f;
            lrun = 0.f;
#pragma unroll
            for (int r = 0; r < 16; ++r) negm[r] = -mrow;
            asm volatile("" : "+v"(negm));
            DA_LOAD(0); DA_STORE(0); DA_LOAD(1); DA_STORE(1);
            __syncthreads();
            for (int u = 0; u < (ntile >> 1); ++u) {
                const bool more = (u + 1) < (ntile >> 1);
                const int sl = (u & 1) * 2, nsl = sl ^ 2;
                bf16x8 pb[4];
                if (more) DA_LOAD(2 * u + 2);
                { const LAS unsigned char* kb = F.lds + sl * 32768;
                  attn_qk_fast<4, 256, 0>(kb, 8 * j, qf, negm, lrun, l31, hi, nullptr, 0, 0, pb);
                  attn_pv<4>(kb + 16384, pb, o, l31, hi);
                  if (more) { DA_STORE(nsl); DA_LOAD(2 * u + 3); } }
                { const LAS unsigned char* kb = F.lds + (sl + 1) * 32768;
                  attn_qk_fast<4, 256, 0>(kb, 8 * j, qf, negm, lrun, l31, hi, nullptr, 0, 0, pb);
                  attn_pv<4>(kb + 16384, pb, o, l31, hi);
                  if (more) DA_STORE(nsl + 1); }
                __syncthreads();
            }
            if (attempt == 1) break;
            const float lt0 = lrun + __shfl_xor(lrun, 32);
            const bool okw = __all(lt0 < 1.0e30f && lt0 > 1.0e-30f);
            LAS unsigned* okf = (LAS unsigned*)(F.lds + 131072 + 2048);
            if (F.lane == 0) okf[F.wave] = okw ? 1u : 0u;
            __syncthreads();
            unsigned allok = 1u;
#pragma unroll
            for (int w = 0; w < 8; ++w) allok &= okf[w];
            __syncthreads();
            if (__builtin_expect(allok != 0u, 1)) break;
        }
#undef DA_KROW
#undef DA_LOAD
#undef DA_STORE
        { const float lt = lrun + __shfl_xor(lrun, 32); const float inv = 1.0f / lt;
#pragma unroll
          for (int eb = 0; eb < 4; ++eb)
#pragma unroll
              for (int r = 0; r < 16; ++r) o[eb][r] *= inv; }
        LAS float* cb = (LAS float*)(F.lds + sub * 16384);
        if (j == 1) {
#pragma unroll
            for (int eb = 0; eb < 4; ++eb)
#pragma unroll
                for (int r = 0; r < 16; ++r) { const int e = 32 * eb + (r & 3) + 8 * (r >> 2) + 4 * hi; cb[e * 32 + l31] = o[eb][r]; }
        }
        __syncthreads();
        if (j == 0) {
            float ss = 0.f;
#pragma unroll
            for (int eb = 0; eb < 4; ++eb)
#pragma unroll
                for (int r = 0; r < 16; ++r) { const int e = 32 * eb + (r & 3) + 8 * (r >> 2) + 4 * hi; const float d = o[eb][r] - lam_full * cb[e * 32 + l31]; o[eb][r] = d; ss += d * d; }
            ss += __shfl_xor(ss, 32);
            const float rn = (1.0f - lam_init) / sqrtf(ss * (1.0f / 128.0f) + NORM_EPS);
            char* ob = (char*)ATT + ((size_t)(qrow0 + sub * 32) * DM + h * 128) * 2;
            const unsigned ooff = (unsigned)(l31 * DM + 4 * hi) * 2u;
#pragma unroll
            for (int eb = 0; eb < 4; ++eb)
#pragma unroll
                for (int g4 = 0; g4 < 4; ++g4) {
                    const int e = 32 * eb + 8 * g4 + 4 * hi;
                    bf16_t* op = (bf16_t*)(ob + ooff) - 4 * hi;
                    const f32x4 gv = *(const f32x4*)(subg + e);
                    u32x2 w; w.x = cvt_pk_bf16(o[eb][4 * g4] * rn * gv[0], o[eb][4 * g4 + 1] * rn * gv[1]); w.y = cvt_pk_bf16(o[eb][4 * g4 + 2] * rn * gv[2], o[eb][4 * g4 + 3] * rn * gv[3]);
                    *(u32x2*)(op + e) = w;
                }
        }
        __syncthreads();
    }
}

__device__ __forceinline__ void nat_attn_phase(const Ctx& F0, const bf16_t* Q, const bf16_t* Kb, const bf16_t* Vt, bf16_t* ATT, const float* rpb, bool want_ctx) {
    Ctx F = F0; F.refresh();
    const int l31 = F.lane & 31, hi = F.lane >> 5;
    const int NU = 2048 + (want_ctx ? 64 : 0);
    LAS float* rpbL = (LAS float*)(F.lds + 65536);
    for (int u = F.bid; u < NU; u += F.G) {
        int b, h, r0 = 0, qtok, nwin, lo = 0; bool is_ctx = false;
        if (u < 2048) { const int bh = u >> 5; b = bh >> 4; h = bh & 15; r0 = (u & 31) * 4;
            const int qr_ = r0 + (F.wave >> 1); qtok = b * SEQ + qr_ * 64 + (F.wave & 1) * 32 + l31;
            lo = (r0 - 4) < 0 ? 0 : ((r0 - 4) > 120 ? 120 : (r0 - 4));
            const int hi_r = ((r0 - 1) < 0 ? 0 : ((r0 - 1) > 120 ? 120 : (r0 - 1))) + 7; nwin = hi_r - lo + 1;
        } else { const int uc = u - 2048; b = uc >> 4; h = uc & 15; is_ctx = true; nwin = 0; qtok = TL + b * CTXL + F.wave * 32 + l31; }
        const int qr = r0 + (F.wave >> 1), half = F.wave & 1;
        const int rs = (qr - 4) < 0 ? 0 : ((qr - 4) > 120 ? 120 : (qr - 4));
        const int qc = half * 32 + l31;
        const int cs = (qc - 8) < 0 ? 0 : ((qc - 8) > 48 ? 48 : (qc - 8));
        if (F.tid < 480) { const int ro = F.tid >> 5, co = F.tid & 31; rpbL[F.tid] = co < 31 ? rpb[(h * 15 + ro) * 31 + co] * LOG2E : 0.f; }
        bf16x8 qf[4];
        { const bf16_t* qp = Q + (size_t)qtok * DM + h * 64 + hi * 8;
#pragma unroll
          for (int d0 = 0; d0 < 4; ++d0) qf[d0] = *(const bf16x8*)(qp + d0 * 16); }
        f32x16 o[2]; float lrun; f32x16 negm;
        const int ntile = nwin + 4;
        const int kkey = F.tid >> 3, kch = F.tid & 7;
        u32x4 rk, rv;
#define NA_KROW(t) ((t) < nwin ? (b * SEQ + (lo + (t)) * 64) : (TL + b * CTXL + 64 * ((t) - nwin)))
#define NA_LOAD(t) do { const int kr_ = NA_KROW(t); rk = *(const u32x4*)(Kb + (size_t)(kr_ + kkey) * DM + h * 64 + kch * 8); rv = *(const u32x4*)(Vt + (size_t)(h * 64 + kkey) * TA + kr_ + kch * 8); } while (0)
#define NA_STORE(st) do { LAS unsigned char* kb_ = F.lds + (st) * 16384; LAS unsigned char* vb_ = kb_ + 8192; \
            *(LAS u32x4*)(kb_ + kkey * 128 + ((kch ^ ((kkey >> 1) & 7)) << 4)) = rk; const int sw_ = (kkey >> 1) & 7; \
            *(LAS u32x2*)(vb_ + kkey * 128 + (((2 * (kch >> 1)) ^ sw_) << 4) + (kch & 1) * 8) = (u32x2){rv.x, rv.y}; *(LAS u32x2*)(vb_ + kkey * 128 + (((2 * (kch >> 1) + 1) ^ sw_) << 4) + (kch & 1) * 8) = (u32x2){rv.z, rv.w}; } while (0)
        for (int attempt = 0; ; ++attempt) {
            float mrow = attempt == 0 ? 0.f : NEG_BIG;
            if (attempt > 0) {
                NA_LOAD(0); NA_STORE(0);
                __syncthreads();
                for (int t = 0; t < ntile; ++t) {
                    const bool more = (t + 1) < ntile;
                    if (more) NA_LOAD(t + 1);
                    const LAS unsigned char* kb = F.lds + (t & 1) * 16384;
                    if (t < nwin) {
                        const int kr = lo + t;
                        if (kr >= rs && kr < rs + 8) mrow = fmaxf(mrow, attn_max<128, 1>(kb, 0, qf, l31, hi, rpbL + (kr - qr + 7) * 32, qc, cs));
                    } else {
                        mrow = fmaxf(mrow, attn_max<128, 0>(kb, 0, qf, l31, hi));
                    }
                    if (more) NA_STORE((t + 1) & 1);
                    __syncthreads();
                }
            }
#pragma unroll
            for (int eb = 0; eb < 2; ++eb)
#pragma unroll
                for (int r = 0; r < 16; ++r) o[eb][r] = 0.f;
            lrun = 0.f;
#pragma unroll
            for (int r = 0; r < 16; ++r) negm[r] = -mrow;
            asm volatile("" : "+v"(negm));
            NA_LOAD(0); NA_STORE(0);
            __syncthreads();
            for (int t = 0; t < ntile; ++t) {
                const bool more = (t + 1) < ntile;
                if (more) NA_LOAD(t + 1);
                const LAS unsigned char* kb = F.lds + (t & 1) * 16384;
                bf16x8 pb[4]; bool act = true;
                if (t < nwin) {
                    const int kr = lo + t;
                    act = (kr >= rs && kr < rs + 8);
                    if (act) attn_qk_fast<2, 128, 1>(kb, 0, qf, negm, lrun, l31, hi, rpbL + (kr - qr + 7) * 32, qc, cs, pb);
                } else {
                    attn_qk_fast<2, 128, 0>(kb, 0, qf, negm, lrun, l31, hi, nullptr, 0, 0, pb);
                }
                if (more) NA_STORE((t + 1) & 1);
                if (act) attn_pv<2>(kb + 8192, pb, o, l31, hi);
                __syncthreads();
            }
            if (attempt == 1) break;
            const float lt0 = lrun + __shfl_xor(lrun, 32);
            const bool okw = __all(lt0 < 1.0e30f && lt0 > 1.0e-30f);
            LAS unsigned* okf = (LAS unsigned*)(F.lds + 65536 + 2048);
            if (F.lane == 0) okf[F.wave] = okw ? 1u : 0u;
            __syncthreads();
            unsigned allok = 1u;
#pragma unroll
            for (int w = 0; w < 8; ++w) allok &= okf[w];
            __syncthreads();
            if (__builtin_expect(allok != 0u, 1)) break;
        }
#undef NA_KROW
#undef NA_LOAD
#undef NA_STORE
        { const float lt = lrun + __shfl_xor(lrun, 32); const float inv = 1.0f / lt;
          bf16_t* op = ATT + (size_t)qtok * DM + h * 64;
#pragma unroll
          for (int eb = 0; eb < 2; ++eb)
#pragma unroll
              for (int g4 = 0; g4 < 4; ++g4) {
                  const int e = 32 * eb + 8 * g4 + 4 * hi;
                  u32x2 w; w.x = cvt_pk_bf16(o[eb][4 * g4] * inv, o[eb][4 * g4 + 1] * inv); w.y = cvt_pk_bf16(o[eb][4 * g4 + 2] * inv, o[eb][4 * g4 + 3] * inv);
                  *(u32x2*)(op + e) = w;
              } }
        (void)is_ctx;
    }
}

#define XB_TMO      128
#define XB_XCNT(j)  (256  + 64 * (j))
#define XB_XSUB(j)  (1280 + 64 * (j))
#define XB_XGEN(j)  (2304 + 64 * (j))
#define XB_TOP      3328
#define XB_TOPGEN   3392
#define XCD_BAR_WORDS 3456
#define XB_SPIN_CAP (1u << 22)
__device__ __forceinline__ unsigned xb_ld(unsigned* p)              { return __hip_atomic_load(p, __ATOMIC_RELAXED, __HIP_MEMORY_SCOPE_AGENT); }
__device__ __forceinline__ unsigned xb_add(unsigned* p, unsigned v) { return __hip_atomic_fetch_add(p, v, __ATOMIC_RELAXED, __HIP_MEMORY_SCOPE_AGENT); }
__device__ __forceinline__ unsigned xb_xcc_id() { return (unsigned)__builtin_amdgcn_s_getreg((3 << 11) | 20) & 0xFu; }
#define XB_SPIN(cond, bar) do { unsigned _sp = 0; while (cond) { __builtin_amdgcn_s_sleep(1); \
    if ((++_sp & 255u) == 0u) { if (xb_ld(&(bar)[XB_TMO])) break; if (_sp > XB_SPIN_CAP) { atomicAdd(&(bar)[XB_TMO], 1u); break; } } } } while (0)
struct XcdBarrier { unsigned* bar; unsigned x; volatile LAS unsigned* st; };
__device__ __forceinline__ void xcd_barrier_complete(unsigned* bar, unsigned x, unsigned G, unsigned& nloc, unsigned& nx) {
    unsigned sum, cnt, mine, sp = 0u;
    for (;;) {
        sum = 0u; cnt = 0u; mine = 0u;
#pragma unroll
        for (unsigned j = 0; j < 16; ++j) { const unsigned c = xb_ld(&bar[XB_XCNT(j)]); sum += c; cnt += (c > 0u) ? 1u : 0u; mine = (j == x) ? c : mine; }
        if (sum == G) break;
        __builtin_amdgcn_s_sleep(1);
        if ((++sp & 255u) == 0u) { if (xb_ld(&bar[XB_TMO])) break; if (sp > XB_SPIN_CAP) { atomicAdd(&bar[XB_TMO], 1u); break; } }
    }
    nloc = mine > 0u ? mine : 1u; nx = cnt > 0u ? cnt : 1u;
}
__device__ __forceinline__ void xcd_barrier(const XcdBarrier& b, int tid, unsigned G) {
    asm volatile("s_waitcnt vmcnt(0)" ::: "memory");
    __syncthreads();
    if (tid == 0) {
        unsigned* bar = b.bar;
        __builtin_amdgcn_s_waitcnt(0);
        unsigned nloc = b.st[0], nx = b.st[1];
        if (nloc == 0u) { xcd_barrier_complete(bar, b.x, G, nloc, nx); b.st[0] = nloc; b.st[1] = nx; }
        const unsigned old = xb_add(&bar[XB_XSUB(b.x)], 1u);
        const unsigned gen = old / nloc;
        if (old + 1u == (gen + 1u) * nloc) {
            __builtin_amdgcn_fence(__ATOMIC_RELEASE, "agent");
            asm volatile("s_waitcnt vmcnt(0)" ::: "memory");
            const unsigned og = xb_add(&bar[XB_TOP], 1u);
            const unsigned tg = og / nx;
            if (og + 1u == (tg + 1u) * nx) xb_add(&bar[XB_TOPGEN], 1u);
            else XB_SPIN(xb_ld(&bar[XB_TOPGEN]) == tg, bar);
            __builtin_amdgcn_fence(__ATOMIC_ACQUIRE, "agent");
            xb_add(&bar[XB_XGEN(b.x)], 1u);
            asm volatile("s_waitcnt vmcnt(0)" ::: "memory");
        } else {
            XB_SPIN(xb_ld(&bar[XB_XGEN(b.x)]) == gen, bar);
            __builtin_amdgcn_fence(__ATOMIC_ACQUIRE, "agent");
            asm volatile("s_waitcnt vmcnt(0)" ::: "memory");
        }
    }
    __syncthreads();
}

__global__ void __launch_bounds__(512, 2) fwd_megakernel(Args args) {
    extern __shared__ __attribute__((aligned(16))) unsigned char lds_raw[];
    cg::grid_group grid = cg::this_grid();
    Ctx F;
    F.lds = (LAS unsigned char*)lds_raw;
    F.wave_s = __builtin_amdgcn_readfirstlane((int)threadIdx.x >> 6);
    F.refresh();
    F.G = gridDim.x; F.bid = blockIdx.x;
    unsigned char* ws = args.ws;
    h16_t* X = (h16_t*)(ws + WS_X);
    bf16_t* H = (bf16_t*)(ws + WS_H);
    bf16_t* HID = (bf16_t*)(ws + WS_BIG);
    bf16_t* Qb = (bf16_t*)(ws + WS_BIG);
    bf16_t* Kb = (bf16_t*)(ws + WS_BIG + QKV_STRIDE);
    bf16_t* Vtb = (bf16_t*)(ws + WS_BIG + 2 * QKV_STRIDE);
    const float* mod = (const float*)(ws + WS_MOD);
    const float* rope = (const float*)(ws + WS_ROPE);
    const float* zeros = (const float*)(ws + WS_CONST); const float* ones = zeros + 3072; const float* halves = zeros + 4096;

    volatile LAS unsigned* xst = (volatile LAS unsigned*)(F.lds + LDS_BYTES - 64);
    if (F.tid < 16) xst[F.tid] = 0u;
    __syncthreads();
    XcdBarrier xbar; xbar.bar = (unsigned*)ws; xbar.x = xb_xcc_id(); xbar.st = xst;
    if (F.bid == 0) { for (int i = F.tid; i < 4096; i += 512) ((unsigned*)ws)[i] = 0u; }
#define GSYNC() do { Ctx Fs_ = F; Fs_.refresh(); xcd_barrier(xbar, Fs_.tid, (unsigned)F.G); } while (0)

    prologue_phase(F, args);
    grid.sync();
    if (F.tid == 0) (void)xb_add(&xbar.bar[XB_XCNT(xbar.x)], 1u);

    float* PART = (float*)(ws + WS_PART);
    for (int layer = 0; layer < 4; ++layer) {
        const int kind = layer % 3, jj = layer / 3;
        const bool pend_in = (layer >= 1 && layer <= 2);
        const bool last = (layer == 3);
        const bool update_ctx = !last;
        const int T = last ? TL : TA;
        const int Tp = layer < 2 ? TA : TL;
        const bool ctx_after = layer < 2;
        const float* modL = mod + (size_t)layer * 5 * NMODV;
        const float* ng = args.in[6] + (size_t)layer * 3 * DM;

        normmod_phase(F, X, T, ng, modL, 0, 1, H, pend_in ? PART : nullptr, mod + (size_t)(layer - 1) * 5 * NMODV + 4 * NMODV + 8 * 1024);
        GSYNC();
        { pg8::Gemm g{H, (const bf16_t*)(ws + WS_WIN) + (size_t)(layer * 2) * 5632 * 1024, DM, DM, DM, 0};
          pg8::StaticOrder S; S.init(T, 5632, F.G, F.bid);
          pg8::EpiSwiglu E{HID, DFF};
          for (int rep = 0; rep < REP_G1; ++rep) pg8::gemm_phase<pg8::EpiSwiglu>(F.lds, F.wave_s, g, S, E); }
        GSYNC();
        { const bf16_t* Wt = (const bf16_t*)(ws + WS_WOUT) + (size_t)(layer * 2) * 1024 * DFF;
          { pg8::Gemm g{HID, Wt, DFF, DFF, DFF, 0};
            pg8::StaticOrder S; S.init(TL, DM, F.G, F.bid);
            pg8::EpiResid E{X, modL + 2 * 1024, zeros, halves};
            pg8::gemm_phase<pg8::EpiResid>(F.lds, F.wave_s, g, S, E); }
          if (T > TL) {
            pg8::Gemm g{HID, Wt, DFF, DFF, 256, 0};
            pg8::StaticOrder S; S.init(TC, 44 * 256, F.G, F.bid, 128);
            pg8::EpiPartial E{PART, 11 * DM};
            pg8::gemm_phase<pg8::EpiPartial, 4, 512>(F.lds, F.wave_s, g, S, E); } }
        GSYNC();

        normmod_phase(F, X, T, ng + DM, modL, 3, 4, H, T > TL ? PART : nullptr, modL + 4 * NMODV + 2 * 1024);
        GSYNC();
        if (kind == 0) {
            bf16_t* Dd = Qb;
            pool_diff_phase(F, H, Dd, Tp);
            GSYNC();
            { pg8::Gemm g{Dd, (const bf16_t*)(ws + WS_WPOOL) + (size_t)jj * 1024 * 256, DM, 256, 256, 512};
              pg8::StaticOrder S; S.init(Tp, DM, F.G, F.bid);
              pg8::EpiResid E{X, modL + 5 * 1024, zeros, args.in[10] + (size_t)jj * DM};
              pg8::gemm_phase<pg8::EpiResid>(F.lds, F.wave_s, g, S, E); }
            GSYNC();
        } else {
            const bf16_t* Wqkv = (const bf16_t*)(ws + WS_WQKV) + (size_t)(kind - 1) * 3072 * 1024;
            { pg8::Gemm g{H, Wqkv, DM, DM, DM, 0};
              pg8::StaticOrder S; S.init(T, 2048, F.G, F.bid);
              pg8::EpiQK E{Qb, Kb, rope, kind == 2 ? args.in[16] : zeros, kind - 1};
              pg8::gemm_phase<pg8::EpiQK>(F.lds, F.wave_s, g, S, E); }
            { pg8::Gemm g{Wqkv + (size_t)2048 * 1024, H, DM, DM, DM, 0};
              pg8::StaticOrder S; S.init(DM, T, F.G, (F.bid + (F.G >> 1)) % F.G);
              pg8::EpiVt E{Vtb, TA, kind == 2 ? args.in[16] + 2048 : zeros};
              pg8::gemm_phase<pg8::EpiVt>(F.lds, F.wave_s, g, S, E); }
            GSYNC();
            if (kind == 1) {
                const float lam_init = 0.8f - 0.6f * expf(-0.3f * (float)layer);
                for (int rep = 0; rep < REP_DIFF; ++rep) diff_attn_phase(F, Qb, Kb, Vtb, H, args.in[12] + (size_t)jj * 256, args.in[13] + (size_t)jj * 128, lam_init, ctx_after);
            } else {
                for (int rep = 0; rep < REP_NAT; ++rep) nat_attn_phase(F, Qb, Kb, Vtb, H, args.in[17] + (size_t)jj * 16 * 15 * 31, ctx_after);
            }
            GSYNC();
            { pg8::Gemm g{H, (const bf16_t*)(ws + WS_WO) + (size_t)(kind - 1) * 1024 * 1024, DM, DM, DM, 0};
              pg8::StaticOrder S; S.init(Tp, DM, F.G, F.bid);
              pg8::EpiResid E{X, modL + 5 * 1024, kind == 2 ? args.in[19] + (size_t)jj * DM : zeros, ones};
              pg8::gemm_phase<pg8::EpiResid>(F.lds, F.wave_s, g, S, E); }
            GSYNC();
        }

        normmod_phase(F, X, Tp, ng + 2 * DM, modL, 6, 7, H, nullptr, zeros);
        GSYNC();
        { pg8::Gemm g{H, (const bf16_t*)(ws + WS_WIN) + (size_t)(layer * 2 + 1) * 5632 * 1024, DM, DM, DM, 0};
          pg8::StaticOrder S; S.init(Tp, 5632, F.G, F.bid);
          pg8::EpiSwiglu E{HID, DFF};
          for (int rep = 0; rep < REP_G1; ++rep) pg8::gemm_phase<pg8::EpiSwiglu>(F.lds, F.wave_s, g, S, E); }
        GSYNC();
        { const bf16_t* Wt = (const bf16_t*)(ws + WS_WOUT) + (size_t)(layer * 2 + 1) * 1024 * DFF;
          { pg8::Gemm g{HID, Wt, DFF, DFF, DFF, 0};
            pg8::StaticOrder S; S.init(TL, DM, F.G, F.bid);
            pg8::EpiResid E{X, modL + 8 * 1024, zeros, halves};
            pg8::gemm_phase<pg8::EpiResid>(F.lds, F.wave_s, g, S, E); }
          if (Tp > TL) {
            pg8::Gemm g{HID, Wt, DFF, DFF, 256, 0};
            pg8::StaticOrder S; S.init(TC, 44 * 256, F.G, F.bid, 128);
            pg8::EpiPartial E{PART, 11 * DM};
            pg8::gemm_phase<pg8::EpiPartial, 4, 512>(F.lds, F.wave_s, g, S, E); } }
        GSYNC();
    }
    final_norm_phase(F, X, args.in[20], args.out);
}

extern "C" void kernel_launch(void* const* d_in, const int* in_sizes, int n_in, void* d_out, int out_size, void* d_ws, size_t ws_size, hipStream_t stream) {
    static int grid = 0;
    if (grid == 0) {
        if (n_in != 21 || ws_size < WS_END) { fprintf(stderr, "kernel_launch: unexpected inputs (n_in %d, ws %zu)\n", n_in, ws_size); grid = -1; return; }
        int dev = 0, cus = 0, per_cu = 0;
        hipGetDevice(&dev);
        hipDeviceGetAttribute(&cus, hipDeviceAttributeMultiprocessorCount, dev);
        hipFuncSetAttribute((const void*)fwd_megakernel, hipFuncAttributeMaxDynamicSharedMemorySize, LDS_BYTES);
        hipOccupancyMaxActiveBlocksPerMultiprocessor(&per_cu, (const void*)fwd_megakernel, 512, LDS_BYTES);
        if (per_cu < 1) per_cu = 1;
        grid = cus * per_cu;
        if (grid > 256) grid = 256;
        grid &= ~7;
        (void)hipGetLastError();
    }
    if (grid <= 0) return;
    Args a{};
    for (int i = 0; i < 21; ++i) a.in[i] = (const float*)d_in[i];
    a.out = (float*)d_out; a.ws = (unsigned char*)d_ws;
    void* kargs[] = {&a};
    hipError_t e = hipLaunchCooperativeKernel((const void*)fwd_megakernel, dim3(grid), dim3(512), kargs, LDS_BYTES, stream);
    if (e != hipSuccess) fprintf(stderr, "cooperative launch failed: %s (grid %d)\n", hipGetErrorString(e), grid);
}
```

```cpp
#include <hip/hip_runtime.h>
#include <hip/hip_cooperative_groups.h>
#include <cstdio>
#include <cstdint>
namespace cg = cooperative_groups;

#define LAS __attribute__((address_space(3)))
typedef unsigned short bf16_t;
typedef short bf16x8 __attribute__((ext_vector_type(8)));
typedef short s16x4 __attribute__((ext_vector_type(4)));
typedef float f32x2 __attribute__((ext_vector_type(2)));
typedef float f32x4 __attribute__((ext_vector_type(4)));
typedef float f32x16 __attribute__((ext_vector_type(16)));
typedef unsigned u32x2 __attribute__((ext_vector_type(2)));
typedef _Float16 h16_t;
typedef _Float16 f16x4 __attribute__((ext_vector_type(4)));
typedef _Float16 f16x8 __attribute__((ext_vector_type(8)));
typedef float f32x8 __attribute__((ext_vector_type(8)));
typedef unsigned u32x4 __attribute__((ext_vector_type(4)));

constexpr int DM = 1024, NB = 4, SEQ = 8192, CTXL = 256, DFF = 2816, NMODV = 9 * 1024;
constexpr int TL = NB * SEQ, TC = NB * CTXL, TA = TL + TC;
constexpr float NORM_EPS = 1e-6f;
constexpr float LOG2E = 1.4426950408889634f;
constexpr float QSCALE = 0.125f * LOG2E;
constexpr float NEG_BIG = -1e30f;

constexpr size_t MiB = 1u << 20;
constexpr size_t WS_MOD = 1 * MiB;
constexpr size_t WS_ROPE = 2 * MiB;
constexpr size_t WS_CONST = 3 * MiB;
constexpr size_t WS_WIN = 4 * MiB;
constexpr size_t WS_WOUT = 92 * MiB;
constexpr size_t WS_WQKV = 136 * MiB;
constexpr size_t WS_WO = 148 * MiB;
constexpr size_t WS_WPOOL = 152 * MiB;
constexpr size_t WS_X = 154 * MiB;
constexpr size_t WS_H = 286 * MiB;
constexpr size_t WS_BIG = 352 * MiB;
constexpr size_t WS_PART = 550 * MiB;
constexpr size_t WS_END = 596 * MiB;
constexpr size_t QKV_STRIDE = 66 * MiB;

#ifndef REP_DIFF
#define REP_DIFF 1
#endif
#ifndef REP_NAT
#define REP_NAT 1
#endif
#ifndef REP_NORM
#define REP_NORM 1
#endif
#ifndef REP_G1
#define REP_G1 1
#endif
constexpr int LDS_BYTES = 147456;

typedef __bf16 bf16x2_t __attribute__((ext_vector_type(2)));
__device__ __forceinline__ unsigned cvt_pk_bf16(float lo, float hi) { f32x2 v = {lo, hi}; bf16x2_t b = __builtin_convertvector(v, bf16x2_t); return __builtin_bit_cast(unsigned, b); }
__device__ __forceinline__ float bf2f(unsigned short b) { return __uint_as_float(((unsigned)b) << 16); }
__device__ __forceinline__ float dpp_f(float v, int ctrl_sel) {
    const int x = __float_as_int(v); int r;
    if (ctrl_sel == 0) r = __builtin_amdgcn_update_dpp(x, x, 0xB1, 0xF, 0xF, false);
    else if (ctrl_sel == 1) r = __builtin_amdgcn_update_dpp(x, x, 0x4E, 0xF, 0xF, false);
    else if (ctrl_sel == 2) r = __builtin_amdgcn_update_dpp(x, x, 0x141, 0xF, 0xF, false);
    else r = __builtin_amdgcn_update_dpp(x, x, 0x140, 0xF, 0xF, false);
    return __int_as_float(r);
}
__device__ __forceinline__ float wave_sum(float v) {
    v += dpp_f(v, 0); v += dpp_f(v, 1); v += dpp_f(v, 2); v += dpp_f(v, 3);
    { auto rr = __builtin_amdgcn_permlane16_swap(__float_as_uint(v), __float_as_uint(v), false, false); v = __uint_as_float(rr[0]) + __uint_as_float(rr[1]); }
    { auto rr = __builtin_amdgcn_permlane32_swap(__float_as_uint(v), __float_as_uint(v), false, false); v = __uint_as_float(rr[0]) + __uint_as_float(rr[1]); }
    return v;
}
__device__ __forceinline__ int opaque_tid(int wave_s) { int l; asm volatile("v_mbcnt_lo_u32_b32 %0, -1, 0\n\tv_mbcnt_hi_u32_b32 %0, -1, %0" : "=v"(l)); return wave_s * 64 + l; }
__device__ __forceinline__ float silu_f(float v) { return v / (1.0f + __expf(-v)); }
__device__ __forceinline__ float fast_silu(float v) { return v * __builtin_amdgcn_rcpf(1.0f + __builtin_amdgcn_exp2f(-v * LOG2E)); }

namespace pg8 {
constexpr int BM = 256, BK = 64, HALF = 128, HTB = HALF * BK * 2, STAGE_BYTES = 8 * HTB, NXCD = 8, WGM = 8;
__device__ __forceinline__ int lds_byte(int r, int c) { const int st = (r >> 4) * 2 + (c >> 5), rr = r & 15, cc = c & 31, ob = rr * 64 + cc * 2; return st * 1024 + (ob ^ (((ob >> 9) & 1) << 5)); }
__device__ __forceinline__ void stage_rc(int b, int& R, int& C) { const int st = b / 1024, sb = b % 1024, swz = sb ^ (((sb >> 9) & 1) << 5); R = (st >> 1) * 16 + swz / 64; C = (st & 1) * 32 + (swz % 64) / 2; }
__device__ __forceinline__ int perm32(int rho) { const int n = rho >> 4, i = rho & 15; return 8 * (i >> 2) + 4 * n + (i & 3); }

struct Unit { int pm, pn; };
struct Gemm { const bf16_t* A; const bf16_t* Bt; int lda, ldb, K; int a_pn_off; };

struct StaticOrder {
    int nM, nN, nwg, G, c, pm0;
    __device__ void init(int M, int N, int G_, int c_, int pm0_ = 0) { nM = M / BM; nN = N / BM; nwg = nM * nN; G = G_; c = c_; pm0 = pm0_; }
    __device__ bool next(int i, Unit& u) const {
        const long L = (long)i * G + c; if (L >= nwg) return false;
        int wgid = (int)L; { const int q = nwg / NXCD, r = nwg % NXCD, xcd = wgid % NXCD, off = wgid / NXCD; wgid = (xcd < r ? xcd * (q + 1) : r * (q + 1) + (xcd - r) * q) + off; }
        const int nig = WGM * nN, gid = wgid / nig, fm = gid * WGM, gsz = (nM - fm) < WGM ? (nM - fm) : WGM;
        u.pm = pm0 + fm + ((wgid % nig) % gsz); u.pn = (wgid % nig) / gsz; return true;
    }
};

template <class Epi, int KSD = 0, int KSO = 0>
__device__ __forceinline__ void gemm_phase(LAS unsigned char* lds, int wave_s, const Gemm g, const StaticOrder& S, const Epi& E) {
    const int tid = opaque_tid(wave_s), wid = __builtin_amdgcn_readfirstlane(tid >> 6), lane = tid & 63, wr = wid >> 2, wc = wid & 3, fr = lane & 15, fq = lane >> 4;
    const int K = g.K, nt = K / BK;
    unsigned voffA[2], voffB[2];
#pragma unroll
    for (int i = 0; i < 2; ++i) { int R, C; stage_rc(tid * 16 + i * 8192, R, C); const int Rb = Epi::PERM ? ((R & ~31) + perm32(R & 31)) : R;
        voffA[i] = (unsigned)(R * g.lda + C) * 2u; voffB[i] = (unsigned)(Rb * g.ldb + C) * 2u; }
    const size_t kstep = (size_t)(BK * 2);
    const size_t hstepA = (size_t)HALF * g.lda * 2, hstepB = (size_t)HALF * g.ldb * 2;
    const size_t tstepA = 2 * hstepA, tstepB = 2 * hstepB;
    const unsigned ldsw = (unsigned)wid * 1024u;
    const int aoff = lds_byte(wr * 64 + fr, fq * 8), boff = lds_byte(wc * 32 + fr, fq * 8);
#define PG8_SA(b, h) (((b) * 2 + (h)) * HTB)
#define PG8_SB(b, h) ((4 + (b) * 2 + (h)) * HTB)
#define PG8_STAGE(bufoff, gbase, voff) do { _Pragma("unroll") for (int _i = 0; _i < 2; ++_i) \
        __builtin_amdgcn_global_load_lds((const unsigned*)((const char*)(gbase) + (voff)[_i]), (LAS unsigned*)(lds + (bufoff) + ldsw + _i * 8192), 16, 0, 0); } while (0)
#define PG8_LDA(dst, b, h) do { _Pragma("unroll") for (int m = 0; m < 4; ++m) _Pragma("unroll") for (int k = 0; k < 2; ++k) dst[m][k] = *(const LAS bf16x8*)(lds + PG8_SA(b, h) + aoff + m * 2048 + k * 1024); } while (0)
#define PG8_LDB(dst, b, h) do { _Pragma("unroll") for (int n = 0; n < 2; ++n) _Pragma("unroll") for (int k = 0; k < 2; ++k) dst[n][k] = *(const LAS bf16x8*)(lds + PG8_SB(b, h) + boff + n * 2048 + k * 1024); } while (0)
#define PG8_MMA(ai, bj, At, Bt) do { __builtin_amdgcn_s_setprio(1); _Pragma("unroll") for (int m = 0; m < 4; ++m) _Pragma("unroll") for (int n = 0; n < 2; ++n) _Pragma("unroll") for (int k = 0; k < 2; ++k) \
        acc[ai][bj][m][n] = __builtin_amdgcn_mfma_f32_16x16x32_bf16(Bt[n][k], At[m][k], acc[ai][bj][m][n], 0, 0, 0); __builtin_amdgcn_s_setprio(0); } while (0)
#define PG8_WAIT_V(n) asm volatile("s_waitcnt vmcnt(" #n ")" ::: "memory")
#define PG8_WAIT_L(n) asm volatile("s_waitcnt lgkmcnt(" #n ")" ::: "memory")
#define PG8_BAR __builtin_amdgcn_s_barrier()
#define PG8_SCHED __builtin_amdgcn_sched_barrier(0)
    Unit cur, nxt; int ui = 0;
    if (!S.next(0, cur)) return;
    f32x4 acc[2][2][4][2];
#pragma unroll
    for (int a = 0; a < 2; ++a)
#pragma unroll
        for (int b = 0; b < 2; ++b)
#pragma unroll
            for (int m = 0; m < 4; ++m)
#pragma unroll
                for (int n = 0; n < 2; ++n) acc[a][b][m][n] = (f32x4){0.f, 0.f, 0.f, 0.f};
    bf16x8 At[4][2], B0[2][2], B1[2][2];
    const char* cA; const char* cB;
    if constexpr (KSD == 0) { cA = (const char*)g.A + (size_t)cur.pm * tstepA + (size_t)cur.pn * g.a_pn_off; cB = (const char*)g.Bt + (size_t)cur.pn * tstepB; }
    else { cA = (const char*)g.A + (size_t)cur.pm * tstepA + (size_t)(cur.pn / KSD) * KSO; cB = (const char*)g.Bt + (size_t)(cur.pn % KSD) * tstepB + (size_t)(cur.pn / KSD) * KSO; }
    PG8_STAGE(PG8_SB(0, 0), cB, voffB); PG8_STAGE(PG8_SB(0, 1), cB + hstepB, voffB); PG8_STAGE(PG8_SA(0, 0), cA, voffA); PG8_STAGE(PG8_SA(0, 1), cA + hstepA, voffA);
    if (wr == 1) PG8_BAR;
    PG8_WAIT_V(2); PG8_BAR;
    PG8_STAGE(PG8_SB(1, 0), cB + kstep, voffB); PG8_STAGE(PG8_SA(1, 0), cA + kstep, voffA); PG8_STAGE(PG8_SB(1, 1), cB + hstepB + kstep, voffB);
    PG8_WAIT_V(6); PG8_BAR;
    for (;;) {
        const bool has_next = S.next(ui + 1, nxt);
        const char* nA = cA; const char* nB = cB;
        if (has_next) {
            if constexpr (KSD == 0) { nA = (const char*)g.A + (size_t)nxt.pm * tstepA + (size_t)nxt.pn * g.a_pn_off; nB = (const char*)g.Bt + (size_t)nxt.pn * tstepB; }
            else { nA = (const char*)g.A + (size_t)nxt.pm * tstepA + (size_t)(nxt.pn / KSD) * KSO; nB = (const char*)g.Bt + (size_t)(nxt.pn % KSD) * tstepB + (size_t)(nxt.pn / KSD) * KSO; } }
        for (int t = 0; t < nt; t += 2) {
            const bool last = (t == nt - 2);
            const char* a1 = cA + (size_t)(t + 1) * kstep;
            const char* a2 = last ? nA : cA + (size_t)(t + 2) * kstep; const char* b2 = last ? nB : cB + (size_t)(t + 2) * kstep;
            const char* a3 = a2 + kstep; const char* b3 = b2 + kstep;
            PG8_LDB(B0, 0, 0); PG8_LDB(B1, 0, 1); PG8_SCHED; PG8_LDA(At, 0, 0); PG8_STAGE(PG8_SA(1, 1), a1 + hstepA, voffA);
            PG8_WAIT_V(8); PG8_WAIT_L(0); PG8_BAR; PG8_MMA(0, 0, At, B0); PG8_MMA(0, 1, At, B1); PG8_BAR; PG8_SCHED;
            PG8_LDA(At, 0, 1); PG8_STAGE(PG8_SB(0, 0), b2, voffB); PG8_STAGE(PG8_SB(0, 1), b2 + hstepB, voffB); PG8_STAGE(PG8_SA(0, 0), a2, voffA);
            PG8_WAIT_V(8); PG8_WAIT_L(0); PG8_BAR; PG8_MMA(1, 0, At, B0); PG8_MMA(1, 1, At, B1); PG8_BAR; PG8_SCHED;
            PG8_LDB(B0, 1, 0); PG8_LDB(B1, 1, 1); PG8_SCHED; PG8_LDA(At, 1, 0); PG8_STAGE(PG8_SA(0, 1), a2 + hstepA, voffA);
            PG8_WAIT_V(8); PG8_WAIT_L(0); PG8_BAR; PG8_MMA(0, 0, At, B0); PG8_MMA(0, 1, At, B1); PG8_BAR; PG8_SCHED;
            PG8_LDA(At, 1, 1); PG8_STAGE(PG8_SB(1, 0), b3, voffB); PG8_STAGE(PG8_SB(1, 1), b3 + hstepB, voffB); PG8_STAGE(PG8_SA(1, 0), a3, voffA);
            PG8_WAIT_V(8); PG8_WAIT_L(0); PG8_BAR; PG8_MMA(1, 0, At, B0); PG8_MMA(1, 1, At, B1); PG8_BAR; PG8_SCHED;
        }
        if (wr == 0) PG8_BAR;
        { const int l2_ = opaque_tid(wave_s) & 63; E(acc, cur, wr, wc, l2_ & 15, l2_ >> 4); }
        if (!has_next) break;
#pragma unroll
        for (int a = 0; a < 2; ++a)
#pragma unroll
            for (int b = 0; b < 2; ++b)
#pragma unroll
                for (int m = 0; m < 4; ++m)
#pragma unroll
                    for (int n = 0; n < 2; ++n) acc[a][b][m][n] = (f32x4){0.f, 0.f, 0.f, 0.f};
        cur = nxt; cA = nA; cB = nB; ++ui;
        if (wr == 1) PG8_BAR;
    }
    PG8_WAIT_V(0);
    PG8_BAR;
#undef PG8_SA
#undef PG8_SB
#undef PG8_STAGE
#undef PG8_LDA
#undef PG8_LDB
#undef PG8_MMA
#undef PG8_WAIT_V
#undef PG8_WAIT_L
#undef PG8_BAR
#undef PG8_SCHED
}

struct EpiSwiglu {
    static constexpr bool PERM = true;
    bf16_t* O; int ldc;
    static __device__ __forceinline__ float hs(float g, float u) { return g * u * __builtin_amdgcn_rcpf(1.0f + __builtin_amdgcn_exp2f(-g)); }
    __device__ __forceinline__ void operator()(const f32x4 (&acc)[2][2][4][2], const Unit& u, int wr, int wc, int fr, int fq) const {
        const int row0 = u.pm * BM + wr * 64 + fr, col0 = u.pn * 128 + wc * 32 + 8 * fq;
#pragma unroll
        for (int ai = 0; ai < 2; ++ai)
#pragma unroll
            for (int m = 0; m < 4; ++m) {
                bf16_t* rowp = O + (size_t)(row0 + ai * HALF + m * 16) * ldc + col0;
                const f32x4 g0 = acc[ai][0][m][0], g1 = acc[ai][0][m][1], u0 = acc[ai][1][m][0], u1 = acc[ai][1][m][1];
                u32x4 w;
                w.x = cvt_pk_bf16(hs(g0[0], u0[0]), hs(g0[1], u0[1]));
                w.y = cvt_pk_bf16(hs(g0[2], u0[2]), hs(g0[3], u0[3]));
                w.z = cvt_pk_bf16(hs(g1[0], u1[0]), hs(g1[1], u1[1]));
                w.w = cvt_pk_bf16(hs(g1[2], u1[2]), hs(g1[3], u1[3]));
                *(u32x4*)rowp = w;
            }
    }
};
struct EpiResid {
    static constexpr bool PERM = true;
    h16_t* X; const float* gate_base; const float* bias; const float* cscale;
    __device__ __forceinline__ void operator()(const f32x4 (&acc)[2][2][4][2], const Unit& u, int wr, int wc, int fr, int fq) const {
        const int midx = u.pm < 128 ? (u.pm >> 5) : 4;
        const float* gate = gate_base + midx * NMODV;
        asm volatile("" : "+v"(fr), "+v"(fq));
        const int col0 = u.pn * BM + wc * 32 + 8 * fq;
#pragma unroll
        for (int bj = 0; bj < 2; ++bj) {
            const int c = col0 + bj * HALF;
            const f32x4 g0 = *(const f32x4*)(gate + c) * *(const f32x4*)(cscale + c), g1 = *(const f32x4*)(gate + c + 4) * *(const f32x4*)(cscale + c + 4);
            const f32x4 b0 = *(const f32x4*)(bias + c), b1 = *(const f32x4*)(bias + c + 4);
#pragma unroll
            for (int ai = 0; ai < 2; ++ai) {
                h16_t* p0 = X + (size_t)(u.pm * BM + ai * HALF + wr * 64 + fr) * DM + c;
                f16x8 xv[4];
#pragma unroll
                for (int m = 0; m < 4; ++m) xv[m] = *(const f16x8*)(p0 + (size_t)m * 16 * DM);
                asm volatile("" ::: "memory");
#pragma unroll
                for (int m = 0; m < 4; ++m) {
                    const f32x8 xf = __builtin_convertvector(xv[m], f32x8);
                    const f32x4 lo = (f32x4){xf[0], xf[1], xf[2], xf[3]} + g0 * (acc[ai][bj][m][0] + b0);
                    const f32x4 hh = (f32x4){xf[4], xf[5], xf[6], xf[7]} + g1 * (acc[ai][bj][m][1] + b1);
                    const f32x8 o = (f32x8){lo[0], lo[1], lo[2], lo[3], hh[0], hh[1], hh[2], hh[3]};
                    *(f16x8*)(p0 + (size_t)m * 16 * DM) = __builtin_convertvector(o, f16x8);
                }
                asm volatile("" ::: "memory");
            }
        }
    }
};
struct EpiQK {
    static constexpr bool PERM = false;
    bf16_t* Q; bf16_t* Kb; const float* rope; const float* bias; int mode;
    __device__ __forceinline__ void operator()(const f32x4 (&acc)[2][2][4][2], const Unit& u, int wr, int wc, int fr, int fq) const {
        const bool isq = u.pn < 4;
        bf16_t* base = isq ? Q : Kb;
        const float sc = isq ? QSCALE : 1.0f;
        const int colt = (u.pn & 3) * BM + wc * 32 + 4 * fq;
        const bool dorope = (mode == 0) && (u.pm < 128);
#pragma unroll
        for (int ai = 0; ai < 2; ++ai)
#pragma unroll
            for (int m = 0; m < 4; ++m) {
                const int row = u.pm * BM + ai * HALF + wr * 64 + m * 16 + fr;
                f32x4 cv = (f32x4){1.f, 1.f, 1.f, 1.f}, sv = (f32x4){0.f, 0.f, 0.f, 0.f};
                if (dorope) {
                    const int t = row & (SEQ - 1); const int pos = (wc & 1) ? (t & 63) : (t >> 6);
                    const f32x4 t0 = *(const f32x4*)(rope + (pos * 16 + 4 * fq) * 2), t1 = *(const f32x4*)(rope + (pos * 16 + 4 * fq) * 2 + 4);
                    cv = (f32x4){t0[0], t0[2], t1[0], t1[2]}; sv = (f32x4){t0[1], t0[3], t1[1], t1[3]};
                }
#pragma unroll
                for (int bj = 0; bj < 2; ++bj) {
                    const int bc = u.pn * BM + bj * HALF + wc * 32 + 4 * fq;
                    const f32x4 x1 = acc[ai][bj][m][0] + *(const f32x4*)(bias + bc), x2 = acc[ai][bj][m][1] + *(const f32x4*)(bias + bc + 16);
                    const f32x4 o1 = (x1 * cv - x2 * sv) * sc, o2 = (x2 * cv + x1 * sv) * sc;
                    bf16_t* p = base + (size_t)row * DM + colt + bj * HALF;
                    u32x2 w1, w2; w1.x = cvt_pk_bf16(o1[0], o1[1]); w1.y = cvt_pk_bf16(o1[2], o1[3]); w2.x = cvt_pk_bf16(o2[0], o2[1]); w2.y = cvt_pk_bf16(o2[2], o2[3]);
                    *(u32x2*)p = w1; *(u32x2*)(p + 16) = w2;
                }
                asm volatile("" ::: "memory");
            }
    }
};
struct EpiPartial {
    static constexpr bool PERM = true;
    h16_t* O; int ldc;
    __device__ __forceinline__ void operator()(const f32x4 (&acc)[2][2][4][2], const Unit& u, int wr, int wc, int fr, int fq) const {
        asm volatile("" : "+v"(fr), "+v"(fq));
        const unsigned base = (unsigned)(((u.pm - 128) * BM + wr * 64 + fr) * ldc + u.pn * BM + wc * 32 + 8 * fq) * 2u;
#pragma unroll
        for (int ai = 0; ai < 2; ++ai)
#pragma unroll
            for (int m = 0; m < 4; ++m) {
                char* rp = (char*)O + (base + (unsigned)((ai * HALF + m * 16) * ldc) * 2u);
#pragma unroll
                for (int bj = 0; bj < 2; ++bj) {
                    const f32x4 a = acc[ai][bj][m][0], b = acc[ai][bj][m][1];
                    const f32x8 o = (f32x8){a[0], a[1], a[2], a[3], b[0], b[1], b[2], b[3]};
                    *(f16x8*)(rp + bj * HALF * 2) = __builtin_convertvector(o, f16x8);
                }
                asm volatile("" ::: "memory");
            }
    }
};
struct EpiVt {
    static constexpr bool PERM = true;
    bf16_t* O; int ldc; const float* rbias;
    __device__ __forceinline__ void operator()(const f32x4 (&acc)[2][2][4][2], const Unit& u, int wr, int wc, int fr, int fq) const {
        const int row0 = u.pm * BM + wr * 64 + fr, col0 = u.pn * BM + wc * 32 + 8 * fq;
#pragma unroll
        for (int ai = 0; ai < 2; ++ai)
#pragma unroll
            for (int m = 0; m < 4; ++m) {
                const int row = row0 + ai * HALF + m * 16;
                const float b = rbias[row];
                bf16_t* rowp = O + (size_t)row * ldc + col0;
#pragma unroll
                for (int bj = 0; bj < 2; ++bj) {
                    const f32x4 v0 = acc[ai][bj][m][0] + b, v1 = acc[ai][bj][m][1] + b;
                    u32x4 w; w.x = cvt_pk_bf16(v0[0], v0[1]); w.y = cvt_pk_bf16(v0[2], v0[3]); w.z = cvt_pk_bf16(v1[0], v1[1]); w.w = cvt_pk_bf16(v1[2], v1[3]);
                    *(u32x4*)(rowp + bj * HALF) = w;
                }
            }
    }
};
}

struct Args { const float* in[21]; float* out; unsigned char* ws; };

struct Ctx {
    LAS unsigned char* lds;
    int tid, lane, wave, G, bid, wave_s;
    __device__ __forceinline__ void refresh() { tid = opaque_tid(wave_s); lane = tid & 63; wave = __builtin_amdgcn_readfirstlane(tid >> 6); }
};

__device__ __forceinline__ void transpose_item(const float* W, int ldw, int k0, int n0, bf16_t* WT, int ldt, int dst_row0, LAS float* scr, int lane, float wscale = 1.0f) {
#pragma unroll 8
    for (int i = 0; i < 32; ++i) { const int kk = 2 * i + (lane >> 5); scr[kk * 33 + (lane & 31)] = W[(size_t)(k0 + kk) * ldw + n0 + (lane & 31)] * wscale; }
    asm volatile("s_waitcnt lgkmcnt(0)" ::: "memory");
    const int c = lane & 7;
#pragma unroll
    for (int j = 0; j < 4; ++j) { const int n = (lane >> 3) + 8 * j; const LAS float* s = scr + (8 * c) * 33 + n;
        u32x4 o; o.x = cvt_pk_bf16(s[0 * 33], s[1 * 33]); o.y = cvt_pk_bf16(s[2 * 33], s[3 * 33]); o.z = cvt_pk_bf16(s[4 * 33], s[5 * 33]); o.w = cvt_pk_bf16(s[6 * 33], s[7 * 33]);
        *(u32x4*)(WT + (size_t)(dst_row0 + n) * ldt + k0 + 8 * c) = o; }
    asm volatile("s_waitcnt lgkmcnt(0)" ::: "memory");
}

__device__ __forceinline__ void prologue_phase(const Ctx& F0, const Args& a) {
    Ctx F = F0; F.refresh();
    unsigned char* ws = a.ws;
    {
        LAS float* sv = (LAS float*)F.lds;
        LAS float* red = (LAS float*)(F.lds + 20480);
        for (int i = F.tid; i < 5 * 1024; i += 512) { const int m = i >> 10, k = i & 1023; const float v = m < 4 ? a.in[1][m * 1024 + k] : a.in[3][k]; sv[i] = silu_f(v); }
        __syncthreads();
        float* mod = (float*)(ws + WS_MOD);
        for (int u = F.bid; u < 4 * 72; u += F.G) {
            const int layer = u / 72, col0 = (u % 72) * 128;
            const float* W = a.in[4] + (size_t)layer * 1024 * NMODV + col0 + 2 * F.lane;
            float acc[5][2];
#pragma unroll
            for (int m = 0; m < 5; ++m) { acc[m][0] = 0.f; acc[m][1] = 0.f; }
            const int kb = F.wave * 128;
#pragma unroll 4
            for (int k = 0; k < 128; ++k) {
                const f32x2 w = *(const f32x2*)(W + (size_t)(kb + k) * NMODV);
#pragma unroll
                for (int m = 0; m < 5; ++m) { const float s = sv[m * 1024 + kb + k]; acc[m][0] += s * w.x; acc[m][1] += s * w.y; }
            }
#pragma unroll
            for (int m = 0; m < 5; ++m) { red[(F.wave * 5 + m) * 128 + 2 * F.lane] = acc[m][0]; red[(F.wave * 5 + m) * 128 + 2 * F.lane + 1] = acc[m][1]; }
            __syncthreads();
            for (int i = F.tid; i < 640; i += 512) { const int m = i >> 7, cc = i & 127; float s = a.in[5][layer * NMODV + col0 + cc];
#pragma unroll
                for (int w = 0; w < 8; ++w) s += red[(w * 5 + m) * 128 + cc];
                mod[((size_t)layer * 5 + m) * NMODV + col0 + cc] = s; }
            __syncthreads();
        }
    }
    {
        h16_t* X = (h16_t*)(ws + WS_X);
        const size_t n8 = (size_t)TA * DM / 8, nl8 = (size_t)TL * DM / 8;
        for (size_t i = (size_t)F.bid * 512 + F.tid; i < n8; i += (size_t)F.G * 512) {
            const float* sp = i < nl8 ? a.in[0] + i * 8 : a.in[2] + (i - nl8) * 8;
            const f32x4 p = *(const f32x4*)sp, q = *(const f32x4*)(sp + 4);
            const f32x8 o = (f32x8){p[0], p[1], p[2], p[3], q[0], q[1], q[2], q[3]};
            *(f16x8*)(X + i * 8) = __builtin_convertvector(o, f16x8);
        }
    }
    if (F.bid == 0) { float* cz = (float*)(ws + WS_CONST); for (int i = F.tid; i < 5120; i += 512) cz[i] = i < 3072 ? 0.f : (i < 4096 ? 1.f : 0.5f); }
    {
        float* rope = (float*)(ws + WS_ROPE);
        const int gi = F.bid * 512 + F.tid;
        if (gi < 128 * 16) { const int pos = gi >> 4, f = gi & 15; const float inv = powf(10000.0f, -(float)(2 * f) / 32.0f); const float ang = (float)pos * inv; rope[gi * 2] = cosf(ang); rope[gi * 2 + 1] = sinf(ang); }
    }
    {
        LAS float* scr = (LAS float*)(F.lds + 32768 + F.wave * 8704);
        const int gw = F.bid * 8 + F.wave, NGW = F.G * 8;
        constexpr int I_IN = 16 * 176, I_OUT = 44 * 32, I_QKV = 16 * 96, I_O = 16 * 32, I_P = 4 * 8;
        constexpr int N_IN = 8 * I_IN, N_OUT = 8 * I_OUT, N_QKV = 2 * I_QKV, N_O = 2 * I_O, N_P = 8 * I_P;
        for (int it = gw; it < N_IN + N_OUT + N_QKV + N_O + N_P; it += NGW) {
            int r = it;
            if (r < N_IN) { const int mat = r / I_IN, l = r % I_IN, kb = l / 176, nb = l % 176; const int n0 = nb * 32;
                const int j = n0 < DFF ? n0 : n0 - DFF; const int dst = 256 * (j >> 7) + (n0 < DFF ? 0 : 128) + (j & 127);
                transpose_item(a.in[7] + (size_t)mat * 1024 * 5632, 5632, kb * 64, n0, (bf16_t*)(ws + WS_WIN) + (size_t)mat * 5632 * 1024, 1024, dst, scr, F.lane, n0 < DFF ? LOG2E : 0.6931471805599453f); continue; }
            r -= N_IN;
            if (r < N_OUT) { const int mat = r / I_OUT, l = r % I_OUT, kb = l / 32, nb = l % 32;
                transpose_item(a.in[8] + (size_t)mat * DFF * 1024, 1024, kb * 64, nb * 32, (bf16_t*)(ws + WS_WOUT) + (size_t)mat * 1024 * DFF, DFF, nb * 32, scr, F.lane); continue; }
            r -= N_OUT;
            if (r < N_QKV) { const int mat = r / I_QKV, l = r % I_QKV, kb = l / 96, nb = l % 96;
                transpose_item(mat == 0 ? a.in[11] : a.in[15], 3072, kb * 64, nb * 32, (bf16_t*)(ws + WS_WQKV) + (size_t)mat * 3072 * 1024, 1024, nb * 32, scr, F.lane); continue; }
            r -= N_QKV;
            if (r < N_O) { const int mat = r / I_O, l = r % I_O, kb = l / 32, nb = l % 32;
                transpose_item(mat == 0 ? a.in[14] : a.in[18], 1024, kb * 64, nb * 32, (bf16_t*)(ws + WS_WO) + (size_t)mat * 1024 * 1024, 1024, nb * 32, scr, F.lane); continue; }
            r -= N_O;
            { const int mat = r / I_P, l = r % I_P, kb = l / 8, nb = l % 8;
                transpose_item(a.in[9] + (size_t)mat * 256 * 256, 256, kb * 64, nb * 32, (bf16_t*)(ws + WS_WPOOL) + (size_t)mat * 256 * 256, 256, nb * 32, scr, F.lane); }
        }
    }
}

__device__ __forceinline__ void normmod_phase(const Ctx& F0, h16_t* X, int T, const float* g, const float* modL, int slot_shift, int slot_scale, bf16_t* H,
                                              const h16_t* part, const float* pgate) {
    Ctx F = F0; F.refresh();
    const int gw = F.bid * 8 + F.wave, NGW = F.G * 8;
    const int RPW = (TL + NGW - 1) / NGW;
    const int r0 = gw * RPW, r1 = (r0 + RPW) < TL ? (r0 + RPW) : TL;
    const int nrows = (r1 > r0 ? r1 - r0 : 0) + ((T > TL && gw < TC) ? 1 : 0);
    int cur = -1; f32x4 gm[4], sh[4];
#pragma unroll
    for (int j = 0; j < 4; ++j) { gm[j] = (f32x4){0.f, 0.f, 0.f, 0.f}; sh[j] = gm[j]; }
    for (int ir = 0; ir < nrows; ++ir) {
        const int row = (r0 + ir) < r1 ? (r0 + ir) : (TL + gw);
        const int midx = row < TL ? (row >> 13) : 4;
        if (midx != cur) { cur = midx;
#pragma unroll
            for (int j = 0; j < 4; ++j) { const int c = 512 * (j >> 1) + 8 * F.lane + 4 * (j & 1); const f32x4 gv = *(const f32x4*)(g + c), sc = *(const f32x4*)(modL + midx * NMODV + slot_scale * 1024 + c);
                gm[j] = gv * (sc + 1.0f); sh[j] = *(const f32x4*)(modL + midx * NMODV + slot_shift * 1024 + c); } }
        h16_t* xr = X + (size_t)row * DM;
        f32x4 v[4]; float ss = 0.f;
#pragma unroll
        for (int jj = 0; jj < 2; ++jj) { const f32x8 xf = __builtin_convertvector(*(const f16x8*)(xr + 512 * jj + 8 * F.lane), f32x8);
            v[2 * jj] = (f32x4){xf[0], xf[1], xf[2], xf[3]}; v[2 * jj + 1] = (f32x4){xf[4], xf[5], xf[6], xf[7]}; }
        if (part != nullptr && row >= TL) {
            const h16_t* pr = part + (size_t)(row - TL) * (11 * DM) + 8 * F.lane;
            f32x4 s[4];
#pragma unroll
            for (int j = 0; j < 4; ++j) s[j] = (f32x4){0.f, 0.f, 0.f, 0.f};
#pragma unroll 1
            for (int sl = 0; sl < 11; ++sl) {
#pragma unroll
                for (int jj = 0; jj < 2; ++jj) { const f32x8 pf = __builtin_convertvector(*(const f16x8*)(pr + sl * DM + 512 * jj), f32x8);
                    s[2 * jj] = s[2 * jj] + (f32x4){pf[0], pf[1], pf[2], pf[3]}; s[2 * jj + 1] = s[2 * jj + 1] + (f32x4){pf[4], pf[5], pf[6], pf[7]}; }
            }
#pragma unroll
            for (int j = 0; j < 4; ++j) v[j] = v[j] + s[j] * (*(const f32x4*)(pgate + 512 * (j >> 1) + 8 * F.lane + 4 * (j & 1)) * 0.5f);
#pragma unroll
            for (int jj = 0; jj < 2; ++jj) { const f32x8 o = (f32x8){v[2 * jj][0], v[2 * jj][1], v[2 * jj][2], v[2 * jj][3], v[2 * jj + 1][0], v[2 * jj + 1][1], v[2 * jj + 1][2], v[2 * jj + 1][3]};
                const f16x8 oh = __builtin_convertvector(o, f16x8);
                *(f16x8*)(xr + 512 * jj + 8 * F.lane) = oh;
                const f32x8 back = __builtin_convertvector(oh, f32x8);
                v[2 * jj] = (f32x4){back[0], back[1], back[2], back[3]}; v[2 * jj + 1] = (f32x4){back[4], back[5], back[6], back[7]}; }
        }
#pragma unroll
        for (int j = 0; j < 4; ++j) ss += (v[j][0] * v[j][0] + v[j][1] * v[j][1]) + (v[j][2] * v[j][2] + v[j][3] * v[j][3]);
        const float r = 1.0f / sqrtf(wave_sum(ss) * (1.0f / DM) + NORM_EPS);
        bf16_t* o = H + (size_t)row * DM;
#pragma unroll
        for (int jj = 0; jj < 2; ++jj) { const f32x4 y0 = v[2 * jj] * r * gm[2 * jj] + sh[2 * jj], y1 = v[2 * jj + 1] * r * gm[2 * jj + 1] + sh[2 * jj + 1];
            u32x4 w; w.x = cvt_pk_bf16(y0[0], y0[1]); w.y = cvt_pk_bf16(y0[2], y0[3]); w.z = cvt_pk_bf16(y1[0], y1[1]); w.w = cvt_pk_bf16(y1[2], y1[3]);
            *(u32x4*)(o + 512 * jj + 8 * F.lane) = w; }
    }
}
__device__ __forceinline__ void final_norm_phase(const Ctx& F0, const h16_t* x, const float* g, float* out) {
    Ctx F = F0; F.refresh();
    const int gw = F.bid * 8 + F.wave, NGW = F.G * 8;
    f32x4 gv[4];
#pragma unroll
    for (int j = 0; j < 4; ++j) gv[j] = *(const f32x4*)(g + 512 * (j >> 1) + 8 * F.lane + 4 * (j & 1));
    for (int row = gw; row < TL; row += NGW) {
        const h16_t* xr = x + (size_t)row * DM;
        f32x4 v[4]; float ss = 0.f;
#pragma unroll
        for (int jj = 0; jj < 2; ++jj) { const f32x8 xf = __builtin_convertvector(*(const f16x8*)(xr + 512 * jj + 8 * F.lane), f32x8);
            v[2 * jj] = (f32x4){xf[0], xf[1], xf[2], xf[3]}; v[2 * jj + 1] = (f32x4){xf[4], xf[5], xf[6], xf[7]}; }
#pragma unroll
        for (int j = 0; j < 4; ++j) ss += (v[j][0] * v[j][0] + v[j][1] * v[j][1]) + (v[j][2] * v[j][2] + v[j][3] * v[j][3]);
        const float r = 1.0f / sqrtf(wave_sum(ss) * (1.0f / DM) + NORM_EPS);
#pragma unroll
        for (int j = 0; j < 4; ++j) *(f32x4*)(out + (size_t)row * DM + 512 * (j >> 1) + 8 * F.lane + 4 * (j & 1)) = v[j] * r * gv[j];
    }
}

__device__ __forceinline__ void bf8_to_f(const u32x4 w, float (&f)[8]) {
    f[0] = __uint_as_float(w.x << 16); f[1] = __uint_as_float(w.x & 0xffff0000u); f[2] = __uint_as_float(w.y << 16); f[3] = __uint_as_float(w.y & 0xffff0000u);
    f[4] = __uint_as_float(w.z << 16); f[5] = __uint_as_float(w.z & 0xffff0000u); f[6] = __uint_as_float(w.w << 16); f[7] = __uint_as_float(w.w & 0xffff0000u);
}
__device__ __forceinline__ void pool_diff_phase(const Ctx& F0, const bf16_t* H, bf16_t* Dd, int T) {
    Ctx F = F0; F.refresh();
    const int gw = F.bid * 8 + F.wave, NGW = F.G * 8;
    const int NI = (T >> 4) * 2;
    for (int it = gw; it < NI; it += NGW) {
        const int row0 = (it >> 1) << 4, col = (it & 1) * 512 + F.lane * 8;
        const int grp = col >> 8, win = 2 << grp, hw = win >> 1;
        int seq0, n;
        if (row0 < TL) { seq0 = row0 & ~(SEQ - 1); n = SEQ; } else { seq0 = TL + ((row0 - TL) & ~(CTXL - 1)); n = CTXL; }
        const bf16_t* base = H + (size_t)seq0 * DM + col;
        const int t0 = row0 - seq0;
        int lo = (t0 - hw) > 0 ? (t0 - hw) : 0, hi = (t0 + hw - 1) < (n - 1) ? (t0 + hw - 1) : (n - 1);
        float s[8];
#pragma unroll
        for (int i = 0; i < 8; ++i) s[i] = 0.f;
        for (int rr = lo; rr <= hi; ++rr) { float f[8]; bf8_to_f(*(const u32x4*)(base + (size_t)rr * DM), f);
#pragma unroll
            for (int i = 0; i < 8; ++i) s[i] += f[i]; }
        for (int k = 0; k < 16; ++k) {
            const int t = t0 + k;
            const int nlo = (t - hw) > 0 ? (t - hw) : 0, nhi = (t + hw - 1) < (n - 1) ? (t + hw - 1) : (n - 1);
            if (nlo > lo) { float f[8]; bf8_to_f(*(const u32x4*)(base + (size_t)lo * DM), f);
#pragma unroll
                for (int i = 0; i < 8; ++i) s[i] -= f[i]; }
            if (nhi > hi) { float f[8]; bf8_to_f(*(const u32x4*)(base + (size_t)nhi * DM), f);
#pragma unroll
                for (int i = 0; i < 8; ++i) s[i] += f[i]; }
            lo = nlo; hi = nhi;
            const float inv = 1.0f / (float)(hi - lo + 1);
            float c[8]; bf8_to_f(*(const u32x4*)(base + (size_t)t * DM), c);
            u32x4 ov; ov.x = cvt_pk_bf16(s[0] * inv - c[0], s[1] * inv - c[1]); ov.y = cvt_pk_bf16(s[2] * inv - c[2], s[3] * inv - c[3]);
            ov.z = cvt_pk_bf16(s[4] * inv - c[4], s[5] * inv - c[5]); ov.w = cvt_pk_bf16(s[6] * inv - c[6], s[7] * inv - c[7]);
            *(u32x4*)(Dd + (size_t)(row0 + k) * DM + col) = ov;
        }
    }
}

template <int KROWB> __device__ __forceinline__ int kswz(int key) { return KROWB == 256 ? (key & 15) : ((key >> 1) & 7); }

constexpr float ATT_THR = 8.0f;
template <int NEB, int KROWB, int MASK>
__device__ __forceinline__ void attn_qk(const LAS unsigned char* Kt, int kchunk0, const bf16x8 (&qf)[4], f32x16 (&o)[NEB], f32x16& negm, float& mref, float& lrun, bool& first, int l31, int hi,
                                        const LAS float* brow, int qc, int cs, bf16x8 (&pb)[4]) {
    f32x16 s0, s1;
#pragma clang loop unroll(disable)
    for (;;) {
#pragma unroll
        for (int d0 = 0; d0 < 4; ++d0) {
            const int ch = kchunk0 + 2 * d0 + hi;
            const int k0 = l31, k1 = 32 + l31;
            const bf16x8 a0 = *(const LAS bf16x8*)(Kt + k0 * KROWB + ((ch ^ kswz<KROWB>(k0)) << 4));
            const bf16x8 a1 = *(const LAS bf16x8*)(Kt + k1 * KROWB + ((ch ^ kswz<KROWB>(k1)) << 4));
            if (d0 == 0) { s0 = __builtin_amdgcn_mfma_f32_32x32x16_bf16(a0, qf[0], negm, 0, 0, 0); s1 = __builtin_amdgcn_mfma_f32_32x32x16_bf16(a1, qf[0], negm, 0, 0, 0); }
            else { s0 = __builtin_amdgcn_mfma_f32_32x32x16_bf16(a0, qf[d0], s0, 0, 0, 0); s1 = __builtin_amdgcn_mfma_f32_32x32x16_bf16(a1, qf[d0], s1, 0, 0, 0); }
        }
        if (MASK == 1) {
#pragma unroll
            for (int r = 0; r < 16; ++r) {
                const int kc0 = (r & 3) + 8 * (r >> 2) + 4 * hi, kc1 = kc0 + 32;
                const bool v0 = (unsigned)(kc0 - cs) < 16u, v1 = (unsigned)(kc1 - cs) < 16u;
                const int i0 = v0 ? (kc0 - qc + 15) : 0, i1 = v1 ? (kc1 - qc + 15) : 0;
                const float b0 = brow[i0], b1 = brow[i1];
                s0[r] = v0 ? s0[r] + b0 : NEG_BIG; s1[r] = v1 ? s1[r] + b1 : NEG_BIG;
            }
        }
        float mx = fmaxf(fmaxf(s0[0], s1[0]), fmaxf(s0[1], s1[1]));
#pragma unroll
        for (int r = 2; r < 16; r += 2) mx = fmaxf(fmaxf(mx, s0[r]), fmaxf(s1[r], fmaxf(s0[r + 1], s1[r + 1])));
        mx = fmaxf(mx, __shfl_xor(mx, 32));
        if (__builtin_expect(!(first || __any(mx > ATT_THR)), 1)) break;
        const float dl = first ? mx : fmaxf(mx, 0.f);
        const float f = first ? 1.0f : __builtin_amdgcn_exp2f(-dl);
        first = false;
        mref += dl; lrun *= f;
#pragma unroll
        for (int r = 0; r < 16; ++r) negm[r] = -mref;
#pragma unroll
        for (int eb = 0; eb < NEB; ++eb)
#pragma unroll
            for (int r = 0; r < 16; ++r) o[eb][r] *= f;
        asm volatile("" : "+v"(negm));
    }
#pragma unroll
    for (int r = 0; r < 16; ++r) { s0[r] = __builtin_amdgcn_exp2f(s0[r]); s1[r] = __builtin_amdgcn_exp2f(s1[r]); }
    float ps = s0[0] + s1[0];
#pragma unroll
    for (int r = 1; r < 16; ++r) { ps += s0[r]; ps += s1[r]; }
    lrun += ps;
    {
        u32x4 w;
        w.x = cvt_pk_bf16(s0[0], s0[1]); w.y = cvt_pk_bf16(s0[2], s0[3]); w.z = cvt_pk_bf16(s0[4], s0[5]); w.w = cvt_pk_bf16(s0[6], s0[7]); pb[0] = __builtin_bit_cast(bf16x8, w);
        w.x = cvt_pk_bf16(s0[8], s0[9]); w.y = cvt_pk_bf16(s0[10], s0[11]); w.z = cvt_pk_bf16(s0[12], s0[13]); w.w = cvt_pk_bf16(s0[14], s0[15]); pb[1] = __builtin_bit_cast(bf16x8, w);
        w.x = cvt_pk_bf16(s1[0], s1[1]); w.y = cvt_pk_bf16(s1[2], s1[3]); w.z = cvt_pk_bf16(s1[4], s1[5]); w.w = cvt_pk_bf16(s1[6], s1[7]); pb[2] = __builtin_bit_cast(bf16x8, w);
        w.x = cvt_pk_bf16(s1[8], s1[9]); w.y = cvt_pk_bf16(s1[10], s1[11]); w.z = cvt_pk_bf16(s1[12], s1[13]); w.w = cvt_pk_bf16(s1[14], s1[15]); pb[3] = __builtin_bit_cast(bf16x8, w);
    }
}
template <int KROWB, int MASK = 0>
__device__ __forceinline__ float attn_max(const LAS unsigned char* Kt, int kchunk0, const bf16x8 (&qf)[4], int l31, int hi, const LAS float* brow = nullptr, int qc = 0, int cs = 0) {
    f32x16 s0, s1;
#pragma unroll
    for (int r = 0; r < 16; ++r) { s0[r] = 0.f; s1[r] = 0.f; }
#pragma unroll
    for (int d0 = 0; d0 < 4; ++d0) {
        const int ch = kchunk0 + 2 * d0 + hi;
        const int k0 = l31, k1 = 32 + l31;
        const bf16x8 a0 = *(const LAS bf16x8*)(Kt + k0 * KROWB + ((ch ^ kswz<KROWB>(k0)) << 4));
        const bf16x8 a1 = *(const LAS bf16x8*)(Kt + k1 * KROWB + ((ch ^ kswz<KROWB>(k1)) << 4));
        s0 = __builtin_amdgcn_mfma_f32_32x32x16_bf16(a0, qf[d0], s0, 0, 0, 0); s1 = __builtin_amdgcn_mfma_f32_32x32x16_bf16(a1, qf[d0], s1, 0, 0, 0);
    }
    if (MASK == 1) {
#pragma unroll
        for (int r = 0; r < 16; ++r) {
            const int kc0 = (r & 3) + 8 * (r >> 2) + 4 * hi, kc1 = kc0 + 32;
            const bool v0 = (unsigned)(kc0 - cs) < 16u, v1 = (unsigned)(kc1 - cs) < 16u;
            const int i0 = v0 ? (kc0 - qc + 15) : 0, i1 = v1 ? (kc1 - qc + 15) : 0;
            const float b0 = brow[i0], b1 = brow[i1];
            s0[r] = v0 ? s0[r] + b0 : NEG_BIG; s1[r] = v1 ? s1[r] + b1 : NEG_BIG;
        }
    }
    float mx = fmaxf(fmaxf(s0[0], s1[0]), fmaxf(s0[1], s1[1]));
#pragma unroll
    for (int r = 2; r < 16; r += 2) mx = fmaxf(fmaxf(mx, s0[r]), fmaxf(s1[r], fmaxf(s0[r + 1], s1[r + 1])));
    return fmaxf(mx, __shfl_xor(mx, 32));
}
template <int NEB, int KROWB, int MASK>
__device__ __forceinline__ void attn_qk_fast(const LAS unsigned char* Kt, int kchunk0, const bf16x8 (&qf)[4], const f32x16& negm, float& lrun, int l31, int hi,
                                             const LAS float* brow, int qc, int cs, bf16x8 (&pb)[4]) {
    f32x16 s0, s1;
#pragma unroll
    for (int d0 = 0; d0 < 4; ++d0) {
        const int ch = kchunk0 + 2 * d0 + hi;
        const int k0 = l31, k1 = 32 + l31;
        const bf16x8 a0 = *(const LAS bf16x8*)(Kt + k0 * KROWB + ((ch ^ kswz<KROWB>(k0)) << 4));
        const bf16x8 a1 = *(const LAS bf16x8*)(Kt + k1 * KROWB + ((ch ^ kswz<KROWB>(k1)) << 4));
        if (d0 == 0) { s0 = __builtin_amdgcn_mfma_f32_32x32x16_bf16(a0, qf[0], negm, 0, 0, 0); s1 = __builtin_amdgcn_mfma_f32_32x32x16_bf16(a1, qf[0], negm, 0, 0, 0); }
        else { s0 = __builtin_amdgcn_mfma_f32_32x32x16_bf16(a0, qf[d0], s0, 0, 0, 0); s1 = __builtin_amdgcn_mfma_f32_32x32x16_bf16(a1, qf[d0], s1, 0, 0, 0); }
    }
    if (MASK == 1) {
#pragma unroll
        for (int r = 0; r < 16; ++r) {
            const int kc0 = (r & 3) + 8 * (r >> 2) + 4 * hi, kc1 = kc0 + 32;
            const bool v0 = (unsigned)(kc0 - cs) < 16u, v1 = (unsigned)(kc1 - cs) < 16u;
            const int i0 = v0 ? (kc0 - qc + 15) : 0, i1 = v1 ? (kc1 - qc + 15) : 0;
            const float b0 = brow[i0], b1 = brow[i1];
            s0[r] = v0 ? s0[r] + b0 : NEG_BIG; s1[r] = v1 ? s1[r] + b1 : NEG_BIG;
        }
    }
#pragma unroll
    for (int r = 0; r < 16; ++r) { s0[r] = __builtin_amdgcn_exp2f(s0[r]); s1[r] = __builtin_amdgcn_exp2f(s1[r]); }
    float ps = s0[0] + s1[0];
#pragma unroll
    for (int r = 1; r < 16; ++r) { ps += s0[r]; ps += s1[r]; }
    lrun += ps;
    {
        u32x4 w;
        w.x = cvt_pk_bf16(s0[0], s0[1]); w.y = cvt_pk_bf16(s0[2], s0[3]); w.z = cvt_pk_bf16(s0[4], s0[5]); w.w = cvt_pk_bf16(s0[6], s0[7]); pb[0] = __builtin_bit_cast(bf16x8, w);
        w.x = cvt_pk_bf16(s0[8], s0[9]); w.y = cvt_pk_bf16(s0[10], s0[11]); w.z = cvt_pk_bf16(s0[12], s0[13]); w.w = cvt_pk_bf16(s0[14], s0[15]); pb[1] = __builtin_bit_cast(bf16x8, w);
        w.x = cvt_pk_bf16(s1[0], s1[1]); w.y = cvt_pk_bf16(s1[2], s1[3]); w.z = cvt_pk_bf16(s1[4], s1[5]); w.w = cvt_pk_bf16(s1[6], s1[7]); pb[2] = __builtin_bit_cast(bf16x8, w);
        w.x = cvt_pk_bf16(s1[8], s1[9]); w.y = cvt_pk_bf16(s1[10], s1[11]); w.z = cvt_pk_bf16(s1[12], s1[13]); w.w = cvt_pk_bf16(s1[14], s1[15]); pb[3] = __builtin_bit_cast(bf16x8, w);
    }
}
template <int NEB>
__device__ __forceinline__ void attn_pv(const LAS unsigned char* Vt, const bf16x8 (&pb)[4], f32x16 (&o)[NEB], int l31, int hi) {
    const int sw = (l31 >> 1) & 7;
    const LAS unsigned char* vrow = Vt + l31 * 128;
#pragma unroll
    for (int G = 0; G < 4; ++G) {
        const int coff = ((2 * G + hi) ^ sw) << 4;
#pragma unroll
        for (int eb = 0; eb < NEB; ++eb) {
            const bf16x8 vf = *(const LAS bf16x8*)(vrow + eb * 4096 + coff);
            o[eb] = __builtin_amdgcn_mfma_f32_32x32x16_bf16(vf, pb[G], o[eb], 0, 0, 0);
        }
    }
}

__device__ __forceinline__ void diff_attn_phase(const Ctx& F0, const bf16_t* Q, const bf16_t* Kb, const bf16_t* Vt, bf16_t* ATT, const float* lamp, const float* subg, float lam_init, bool want_ctx) {
    Ctx F = F0; F.refresh();
    const int l31 = F.lane & 31, hi = F.lane >> 5;
    const int sub = F.wave >> 1, j = F.wave & 1;
    float lam_full;
    { const float p01 = lamp[F.lane] * lamp[64 + F.lane], p23 = lamp[128 + F.lane] * lamp[192 + F.lane];
      lam_full = __expf(wave_sum(p01)) - __expf(wave_sum(p23)) + lam_init; }
    const int xcd = F.bid & 7, wi = F.bid >> 3, nwi = F.G >> 3;
    const int n_lat_rounds = (4 * 64 + nwi - 1) / nwi;
    const int total_rounds = n_lat_rounds + (want_ctx ? 1 : 0);
    for (int rd = 0; rd < total_rounds; ++rd) {
        int b, h, qrow0, ntile; bool is_ctx = false;
        if (rd < n_lat_rounds) {
            const int li = rd * nwi + wi; if (li >= 256) continue;
            const int bh = xcd + 8 * (li >> 6), qb = li & 63;
            b = bh >> 3; h = bh & 7; qrow0 = b * SEQ + qb * 128; ntile = 132;
        } else {
            if (F.bid >= 64) continue;
            b = F.bid >> 4; h = (F.bid >> 1) & 7; qrow0 = TL + b * CTXL + (F.bid & 1) * 128; ntile = 4; is_ctx = true;
        }
        const int krow_lat = b * SEQ, krow_ctx = TL + b * CTXL;
        bf16x8 qf[4];
        { const char* qbase = (const char*)Q + ((size_t)(qrow0 + sub * 32) * DM + h * 128 + j * 64) * 2;
          const unsigned qoff = (unsigned)(l31 * DM + hi * 8) * 2u;
#pragma unroll
          for (int d0 = 0; d0 < 4; ++d0) qf[d0] = *(const bf16x8*)(qbase + qoff + d0 * 32); }
        f32x16 o[4]; float lrun; f32x16 negm;
        const int kkey = F.tid >> 4, kch = F.tid & 15;
        const int ve = F.tid >> 3, vc = F.tid & 7;
        const unsigned kgoff = (unsigned)(kkey * DM + kch * 8) * 2u, vgoff = (unsigned)(ve * TA + vc * 8) * 2u;
        const unsigned klds = (unsigned)(kkey * 256 + ((kch ^ (kkey & 15)) << 4));
        const unsigned vsw = (unsigned)((ve >> 1) & 7);
        const unsigned vlds0 = (unsigned)(16384 + ve * 128 + (((2 * (vc >> 1)) ^ vsw) << 4) + (vc & 1) * 8), vlds1 = (unsigned)(16384 + ve * 128 + (((2 * (vc >> 1) + 1) ^ vsw) << 4) + (vc & 1) * 8);
        const char* kg_u = (const char*)Kb + (size_t)(h * 128) * 2;
        const char* vg_u = (const char*)Vt + (size_t)(h * 128) * TA * 2;
        u32x4 rk[2], rv[2];
#define DA_KROW(t) ((is_ctx || (t) >= 128) ? (krow_ctx + 64 * ((t) - (is_ctx ? 0 : 128))) : (krow_lat + 64 * (t)))
#define DA_LOAD(t) do { const int kr_ = DA_KROW(t); const char* kp_ = kg_u + (size_t)kr_ * (DM * 2); const char* vp_ = vg_u + (size_t)kr_ * 2; \
            rk[0] = *(const u32x4*)(kp_ + kgoff); rk[1] = *(const u32x4*)(kp_ + (size_t)(32 * DM * 2) + kgoff); \
            rv[0] = *(const u32x4*)(vp_ + vgoff); rv[1] = *(const u32x4*)(vp_ + (size_t)64 * TA * 2 + vgoff); } while (0)
#define DA_STORE(st) do { LAS unsigned char* sb_ = F.lds + (st) * 32768; \
            *(LAS u32x4*)(sb_ + klds) = rk[0]; *(LAS u32x4*)(sb_ + klds + 32 * 256) = rk[1]; \
            *(LAS u32x2*)(sb_ + vlds0) = (u32x2){rv[0].x, rv[0].y}; *(LAS u32x2*)(sb_ + vlds1) = (u32x2){rv[0].z, rv[0].w}; \
            *(LAS u32x2*)(sb_ + vlds0 + 64 * 128) = (u32x2){rv[1].x, rv[1].y}; *(LAS u32x2*)(sb_ + vlds1 + 64 * 128) = (u32x2){rv[1].z, rv[1].w}; } while (0)
        for (int attempt = 0; ; ++attempt) {
            const int nref = attempt == 0 ? 0 : ntile;
            float mrow = attempt == 0 ? 0.f : NEG_BIG;
            if (nref > 0) { DA_LOAD(0); DA_STORE(0); }
            __syncthreads();
            for (int t = 0; t < nref; ++t) {
                const bool more = (t + 1) < nref;
                if (more) DA_LOAD(t + 1);
                mrow = fmaxf(mrow, attn_max<256>(F.lds + (t & 1) * 32768, 8 * j, qf, l31, hi));
                if (more) DA_STORE((t + 1) & 1);
                __syncthreads();
            }
#pragma unroll
            for (int eb = 0; eb < 4; ++eb)
#pragma unroll
                for (int r = 0; r < 16; ++r) o[eb][r] = 0.f;
            lrun = 0.f;
#pragma unroll
            for (int r = 0; r < 16; ++r) negm[r] = -mrow;
            asm volatile("" : "+v"(negm));
            DA_LOAD(0); DA_STORE(0); DA_LOAD(1); DA_STORE(1);
            __syncthreads();
            for (int u = 0; u < (ntile >> 1); ++u) {
                const bool more = (u + 1) < (ntile >> 1);
                const int sl = (u & 1) * 2, nsl = sl ^ 2;
                bf16x8 pb[4];
                if (more) DA_LOAD(2 * u + 2);
                { const LAS unsigned char* kb = F.lds + sl * 32768;
                  attn_qk_fast<4, 256, 0>(kb, 8 * j, qf, negm, lrun, l31, hi, nullptr, 0, 0, pb);
                  attn_pv<4>(kb + 16384, pb, o, l31, hi);
                  if (more) { DA_STORE(nsl); DA_LOAD(2 * u + 3); } }
                { const LAS unsigned char* kb = F.lds + (sl + 1) * 32768;
                  attn_qk_fast<4, 256, 0>(kb, 8 * j, qf, negm, lrun, l31, hi, nullptr, 0, 0, pb);
                  attn_pv<4>(kb + 16384, pb, o, l31, hi);
                  if (more) DA_STORE(nsl + 1); }
                __syncthreads();
            }
            if (attempt == 1) break;
            const float lt0 = lrun + __shfl_xor(lrun, 32);
            const bool okw = __all(lt0 < 1.0e30f && lt0 > 1.0e-30f);
            LAS unsigned* okf = (LAS unsigned*)(F.lds + 131072 + 2048);
            if (F.lane == 0) okf[F.wave] = okw ? 1u : 0u;
            __syncthreads();
            unsigned allok = 1u;
#pragma unroll
            for (int w = 0; w < 8; ++w) allok &= okf[w];
            __syncthreads();
            if (__builtin_expect(allok != 0u, 1)) break;
        }
#undef DA_KROW
#undef DA_LOAD
#undef DA_STORE
        { const float lt = lrun + __shfl_xor(lrun, 32); const float inv = 1.0f / lt;
#pragma unroll
          for (int eb = 0; eb < 4; ++eb)
#pragma unroll
              for (int r = 0; r < 16; ++r) o[eb][r] *= inv; }
        LAS float* cb = (LAS float*)(F.lds + sub * 16384);
        if (j == 1) {
#pragma unroll
            for (int eb = 0; eb < 4; ++eb)
#pragma unroll
                for (int r = 0; r < 16; ++r) { const int e = 32 * eb + (r & 3) + 8 * (r >> 2) + 4 * hi; cb[e * 32 + l31] = o[eb][r]; }
        }
        __syncthreads();
        if (j == 0) {
            float ss = 0.f;
#pragma unroll
            for (int eb = 0; eb < 4; ++eb)
#pragma unroll
                for (int r = 0; r < 16; ++r) { const int e = 32 * eb + (r & 3) + 8 * (r >> 2) + 4 * hi; const float d = o[eb][r] - lam_full * cb[e * 32 + l31]; o[eb][r] = d; ss += d * d; }
            ss += __shfl_xor(ss, 32);
            const float rn = (1.0f - lam_init) / sqrtf(ss * (1.0f / 128.0f) + NORM_EPS);
            char* ob = (char*)ATT + ((size_t)(qrow0 + sub * 32) * DM + h * 128) * 2;
            const unsigned ooff = (unsigned)(l31 * DM + 4 * hi) * 2u;
#pragma unroll
            for (int eb = 0; eb < 4; ++eb)
#pragma unroll
                for (int g4 = 0; g4 < 4; ++g4) {
                    const int e = 32 * eb + 8 * g4 + 4 * hi;
                    bf16_t* op = (bf16_t*)(ob + ooff) - 4 * hi;
                    const f32x4 gv = *(const f32x4*)(subg + e);
                    u32x2 w; w.x = cvt_pk_bf16(o[eb][4 * g4] * rn * gv[0], o[eb][4 * g4 + 1] * rn * gv[1]); w.y = cvt_pk_bf16(o[eb][4 * g4 + 2] * rn * gv[2], o[eb][4 * g4 + 3] * rn * gv[3]);
                    *(u32x2*)(op + e) = w;
                }
        }
        __syncthreads();
    }
}

__device__ __forceinline__ void nat_attn_phase(const Ctx& F0, const bf16_t* Q, const bf16_t* Kb, const bf16_t* Vt, bf16_t* ATT, const float* rpb, bool want_ctx) {
    Ctx F = F0; F.refresh();
    const int l31 = F.lane & 31, hi = F.lane >> 5;
    const int NU = 2048 + (want_ctx ? 64 : 0);
    LAS float* rpbL = (LAS float*)(F.lds + 65536);
    for (int u = F.bid; u < NU; u += F.G) {
        int b, h, r0 = 0, qtok, nwin, lo = 0; bool is_ctx = false;
        if (u < 2048) { const int bh = u >> 5; b = bh >> 4; h = bh & 15; r0 = (u & 31) * 4;
            const int qr_ = r0 + (F.wave >> 1); qtok = b * SEQ + qr_ * 64 + (F.wave & 1) * 32 + l31;
            lo = (r0 - 4) < 0 ? 0 : ((r0 - 4) > 120 ? 120 : (r0 - 4));
            const int hi_r = ((r0 - 1) < 0 ? 0 : ((r0 - 1) > 120 ? 120 : (r0 - 1))) + 7; nwin = hi_r - lo + 1;
        } else { const int uc = u - 2048; b = uc >> 4; h = uc & 15; is_ctx = true; nwin = 0; qtok = TL + b * CTXL + F.wave * 32 + l31; }
        const int qr = r0 + (F.wave >> 1), half = F.wave & 1;
        const int rs = (qr - 4) < 0 ? 0 : ((qr - 4) > 120 ? 120 : (qr - 4));
        const int qc = half * 32 + l31;
        const int cs = (qc - 8) < 0 ? 0 : ((qc - 8) > 48 ? 48 : (qc - 8));
        if (F.tid < 480) { const int ro = F.tid >> 5, co = F.tid & 31; rpbL[F.tid] = co < 31 ? rpb[(h * 15 + ro) * 31 + co] * LOG2E : 0.f; }
        bf16x8 qf[4];
        { const bf16_t* qp = Q + (size_t)qtok * DM + h * 64 + hi * 8;
#pragma unroll
          for (int d0 = 0; d0 < 4; ++d0) qf[d0] = *(const bf16x8*)(qp + d0 * 16); }
        f32x16 o[2]; float lrun; f32x16 negm;
        const int ntile = nwin + 4;
        const int kkey = F.tid >> 3, kch = F.tid & 7;
        u32x4 rk, rv;
#define NA_KROW(t) ((t) < nwin ? (b * SEQ + (lo + (t)) * 64) : (TL + b * CTXL + 64 * ((t) - nwin)))
#define NA_LOAD(t) do { const int kr_ = NA_KROW(t); rk = *(const u32x4*)(Kb + (size_t)(kr_ + kkey) * DM + h * 64 + kch * 8); rv = *(const u32x4*)(Vt + (size_t)(h * 64 + kkey) * TA + kr_ + kch * 8); } while (0)
#define NA_STORE(st) do { LAS unsigned char* kb_ = F.lds + (st) * 16384; LAS unsigned char* vb_ = kb_ + 8192; \
            *(LAS u32x4*)(kb_ + kkey * 128 + ((kch ^ ((kkey >> 1) & 7)) << 4)) = rk; const int sw_ = (kkey >> 1) & 7; \
            *(LAS u32x2*)(vb_ + kkey * 128 + (((2 * (kch >> 1)) ^ sw_) << 4) + (kch & 1) * 8) = (u32x2){rv.x, rv.y}; *(LAS u32x2*)(vb_ + kkey * 128 + (((2 * (kch >> 1) + 1) ^ sw_) << 4) + (kch & 1) * 8) = (u32x2){rv.z, rv.w}; } while (0)
        for (int attempt = 0; ; ++attempt) {
            float mrow = attempt == 0 ? 0.f : NEG_BIG;
            if (attempt > 0) {
                NA_LOAD(0); NA_STORE(0);
                __syncthreads();
                for (int t = 0; t < ntile; ++t) {
                    const bool more = (t + 1) < ntile;
                    if (more) NA_LOAD(t + 1);
                    const LAS unsigned char* kb = F.lds + (t & 1) * 16384;
                    if (t < nwin) {
                        const int kr = lo + t;
                        if (kr >= rs && kr < rs + 8) mrow = fmaxf(mrow, attn_max<128, 1>(kb, 0, qf, l31, hi, rpbL + (kr - qr + 7) * 32, qc, cs));
                    } else {
                        mrow = fmaxf(mrow, attn_max<128, 0>(kb, 0, qf, l31, hi));
                    }
                    if (more) NA_STORE((t + 1) & 1);
                    __syncthreads();
                }
            }
#pragma unroll
            for (int eb = 0; eb < 2; ++eb)
#pragma unroll
                for (int r = 0; r < 16; ++r) o[eb][r] = 0.f;
            lrun = 0.f;
#pragma unroll
            for (int r = 0; r < 16; ++r) negm[r] = -mrow;
            asm volatile("" : "+v"(negm));
            NA_LOAD(0); NA_STORE(0);
            __syncthreads();
            for (int t = 0; t < ntile; ++t) {
                const bool more = (t + 1) < ntile;
                if (more) NA_LOAD(t + 1);
                const LAS unsigned char* kb = F.lds + (t & 1) * 16384;
                bf16x8 pb[4]; bool act = true;
                if (t < nwin) {
                    const int kr = lo + t;
                    act = (kr >= rs && kr < rs + 8);
                    if (act) attn_qk_fast<2, 128, 1>(kb, 0, qf, negm, lrun, l31, hi, rpbL + (kr - qr + 7) * 32, qc, cs, pb);
                } else {
                    attn_qk_fast<2, 128, 0>(kb, 0, qf, negm, lrun, l31, hi, nullptr, 0, 0, pb);
                }
                if (more) NA_STORE((t + 1) & 1);
                if (act) attn_pv<2>(kb + 8192, pb, o, l31, hi);
                __syncthreads();
            }
            if (attempt == 1) break;
            const float lt0 = lrun + __shfl_xor(lrun, 32);
            const bool okw = __all(lt0 < 1.0e30f && lt0 > 1.0e-30f);
            LAS unsigned* okf = (LAS unsigned*)(F.lds + 65536 + 2048);
            if (F.lane == 0) okf[F.wave] = okw ? 1u : 0u;
            __syncthreads();
            unsigned allok = 1u;
#pragma unroll
            for (int w = 0; w < 8; ++w) allok &= okf[w];
            __syncthreads();
            if (__builtin_expect(allok != 0u, 1)) break;
        }
#undef NA_KROW
#undef NA_LOAD
#undef NA_STORE
        { const float lt = lrun + __shfl_xor(lrun, 32); const float inv = 1.0f / lt;
          bf16_t* op = ATT + (size_t)qtok * DM + h * 64;
#pragma unroll
          for (int eb = 0; eb < 2; ++eb)
#pragma unroll
              for (int g4 = 0; g4 < 4; ++g4) {
                  const int e = 32 * eb + 8 * g4 + 4 * hi;
                  u32x2 w; w.x = cvt_pk_bf16(o[eb][4 * g4] * inv, o[eb][4 * g4 + 1] * inv); w.y = cvt_pk_bf16(o[eb][4 * g4 + 2] * inv, o[eb][4 * g4 + 3] * inv);
                  *(u32x2*)(op + e) = w;
              } }
        (void)is_ctx;
    }
}

#define XB_TMO      128
#define XB_XCNT(j)  (256  + 64 * (j))
#define XB_XSUB(j)  (1280 + 64 * (j))
#define XB_XGEN(j)  (2304 + 64 * (j))
#define XB_TOP      3328
#define XB_TOPGEN   3392
#define XCD_BAR_WORDS 3456
#define XB_SPIN_CAP (1u << 22)
__device__ __forceinline__ unsigned xb_ld(unsigned* p)              { return __hip_atomic_load(p, __ATOMIC_RELAXED, __HIP_MEMORY_SCOPE_AGENT); }
__device__ __forceinline__ unsigned xb_add(unsigned* p, unsigned v) { return __hip_atomic_fetch_add(p, v, __ATOMIC_RELAXED, __HIP_MEMORY_SCOPE_AGENT); }
__device__ __forceinline__ unsigned xb_xcc_id() { return (unsigned)__builtin_amdgcn_s_getreg((3 << 11) | 20) & 0xFu; }
#define XB_SPIN(cond, bar) do { unsigned _sp = 0; while (cond) { __builtin_amdgcn_s_sleep(1); \
    if ((++_sp & 255u) == 0u) { if (xb_ld(&(bar)[XB_TMO])) break; if (_sp > XB_SPIN_CAP) { atomicAdd(&(bar)[XB_TMO], 1u); break; } } } } while (0)
struct XcdBarrier { unsigned* bar; unsigned x; volatile LAS unsigned* st; };
__device__ __forceinline__ void xcd_barrier_complete(unsigned* bar, unsigned x, unsigned G, unsigned& nloc, unsigned& nx) {
    unsigned sum, cnt, mine, sp = 0u;
    for (;;) {
        sum = 0u; cnt = 0u; mine = 0u;
#pragma unroll
        for (unsigned j = 0; j < 16; ++j) { const unsigned c = xb_ld(&bar[XB_XCNT(j)]); sum += c; cnt += (c > 0u) ? 1u : 0u; mine = (j == x) ? c : mine; }
        if (sum == G) break;
        __builtin_amdgcn_s_sleep(1);
        if ((++sp & 255u) == 0u) { if (xb_ld(&bar[XB_TMO])) break; if (sp > XB_SPIN_CAP) { atomicAdd(&bar[XB_TMO], 1u); break; } }
    }
    nloc = mine > 0u ? mine : 1u; nx = cnt > 0u ? cnt : 1u;
}
__device__ __forceinline__ void xcd_barrier(const XcdBarrier& b, int tid, unsigned G) {
    asm volatile("s_waitcnt vmcnt(0)" ::: "memory");
    __syncthreads();
    if (tid == 0) {
        unsigned* bar = b.bar;
        __builtin_amdgcn_s_waitcnt(0);
        unsigned nloc = b.st[0], nx = b.st[1];
        if (nloc == 0u) { xcd_barrier_complete(bar, b.x, G, nloc, nx); b.st[0] = nloc; b.st[1] = nx; }
        const unsigned old = xb_add(&bar[XB_XSUB(b.x)], 1u);
        const unsigned gen = old / nloc;
        if (old + 1u == (gen + 1u) * nloc) {
            __builtin_amdgcn_fence(__ATOMIC_RELEASE, "agent");
            asm volatile("s_waitcnt vmcnt(0)" ::: "memory");
            const unsigned og = xb_add(&bar[XB_TOP], 1u);
            const unsigned tg = og / nx;
            if (og + 1u == (tg + 1u) * nx) xb_add(&bar[XB_TOPGEN], 1u);
            else XB_SPIN(xb_ld(&bar[XB_TOPGEN]) == tg, bar);
            __builtin_amdgcn_fence(__ATOMIC_ACQUIRE, "agent");
            xb_add(&bar[XB_XGEN(b.x)], 1u);
            asm volatile("s_waitcnt vmcnt(0)" ::: "memory");
        } else {
            XB_SPIN(xb_ld(&bar[XB_XGEN(b.x)]) == gen, bar);
            __builtin_amdgcn_fence(__ATOMIC_ACQUIRE, "agent");
            asm volatile("s_waitcnt vmcnt(0)" ::: "memory");
        }
    }
    __syncthreads();
}

__global__ void __launch_bounds__(512, 2) fwd_megakernel(Args args) {
    extern __shared__ __attribute__((aligned(16))) unsigned char lds_raw[];
    cg::grid_group grid = cg::this_grid();
    Ctx F;
    F.lds = (LAS unsigned char*)lds_raw;
    F.wave_s = __builtin_amdgcn_readfirstlane((int)threadIdx.x >> 6);
    F.refresh();
    F.G = gridDim.x; F.bid = blockIdx.x;
    unsigned char* ws = args.ws;
    h16_t* X = (h16_t*)(ws + WS_X);
    bf16_t* H = (bf16_t*)(ws + WS_H);
    bf16_t* HID = (bf16_t*)(ws + WS_BIG);
    bf16_t* Qb = (bf16_t*)(ws + WS_BIG);
    bf16_t* Kb = (bf16_t*)(ws + WS_BIG + QKV_STRIDE);
    bf16_t* Vtb = (bf16_t*)(ws + WS_BIG + 2 * QKV_STRIDE);
    const float* mod = (const float*)(ws + WS_MOD);
    const float* rope = (const float*)(ws + WS_ROPE);
    const float* zeros = (const float*)(ws + WS_CONST); const float* ones = zeros + 3072; const float* halves = zeros + 4096;

    volatile LAS unsigned* xst = (volatile LAS unsigned*)(F.lds + LDS_BYTES - 64);
    if (F.tid < 16) xst[F.tid] = 0u;
    __syncthreads();
    XcdBarrier xbar; xbar.bar = (unsigned*)ws; xbar.x = xb_xcc_id(); xbar.st = xst;
    if (F.bid == 0) { for (int i = F.tid; i < 4096; i += 512) ((unsigned*)ws)[i] = 0u; }
#define GSYNC() do { Ctx Fs_ = F; Fs_.refresh(); xcd_barrier(xbar, Fs_.tid, (unsigned)F.G); } while (0)

    prologue_phase(F, args);
    grid.sync();
    if (F.tid == 0) (void)xb_add(&xbar.bar[XB_XCNT(xbar.x)], 1u);

    h16_t* PART = (h16_t*)(ws + WS_PART);
    for (int layer = 0; layer < 4; ++layer) {
        const int kind = layer % 3, jj = layer / 3;
        const bool pend_in = (layer >= 1 && layer <= 2);
        const bool last = (layer == 3);
        const bool update_ctx = !last;
        const int T = last ? TL : TA;
        const int Tp = layer < 2 ? TA : TL;
        const bool ctx_after = layer < 2;
        const float* modL = mod + (size_t)layer * 5 * NMODV;
        const float* ng = args.in[6] + (size_t)layer * 3 * DM;

        normmod_phase(F, X, T, ng, modL, 0, 1, H, pend_in ? PART : nullptr, mod + (size_t)(layer - 1) * 5 * NMODV + 4 * NMODV + 8 * 1024);
        GSYNC();
        { pg8::Gemm g{H, (const bf16_t*)(ws + WS_WIN) + (size_t)(layer * 2) * 5632 * 1024, DM, DM, DM, 0};
          pg8::StaticOrder S; S.init(T, 5632, F.G, F.bid);
          pg8::EpiSwiglu E{HID, DFF};
          for (int rep = 0; rep < REP_G1; ++rep) pg8::gemm_phase<pg8::EpiSwiglu>(F.lds, F.wave_s, g, S, E); }
        GSYNC();
        { const bf16_t* Wt = (const bf16_t*)(ws + WS_WOUT) + (size_t)(layer * 2) * 1024 * DFF;
          { pg8::Gemm g{HID, Wt, DFF, DFF, DFF, 0};
            pg8::StaticOrder S; S.init(TL, DM, F.G, F.bid);
            pg8::EpiResid E{X, modL + 2 * 1024, zeros, halves};
            pg8::gemm_phase<pg8::EpiResid>(F.lds, F.wave_s, g, S, E); }
          if (T > TL) {
            pg8::Gemm g{HID, Wt, DFF, DFF, 256, 0};
            pg8::StaticOrder S; S.init(TC, 44 * 256, F.G, F.bid, 128);
            pg8::EpiPartial E{PART, 11 * DM};
            pg8::gemm_phase<pg8::EpiPartial, 4, 512>(F.lds, F.wave_s, g, S, E); } }
        GSYNC();

        normmod_phase(F, X, T, ng + DM, modL, 3, 4, H, T > TL ? PART : nullptr, modL + 4 * NMODV + 2 * 1024);
        GSYNC();
        if (kind == 0) {
            bf16_t* Dd = Qb;
            pool_diff_phase(F, H, Dd, Tp);
            GSYNC();
            { pg8::Gemm g{Dd, (const bf16_t*)(ws + WS_WPOOL) + (size_t)jj * 1024 * 256, DM, 256, 256, 512};
              pg8::StaticOrder S; S.init(Tp, DM, F.G, F.bid);
              pg8::EpiResid E{X, modL + 5 * 1024, zeros, args.in[10] + (size_t)jj * DM};
              pg8::gemm_phase<pg8::EpiResid>(F.lds, F.wave_s, g, S, E); }
            GSYNC();
        } else {
            const bf16_t* Wqkv = (const bf16_t*)(ws + WS_WQKV) + (size_t)(kind - 1) * 3072 * 1024;
            { pg8::Gemm g{H, Wqkv, DM, DM, DM, 0};
              pg8::StaticOrder S; S.init(T, 2048, F.G, F.bid);
              pg8::EpiQK E{Qb, Kb, rope, kind == 2 ? args.in[16] : zeros, kind - 1};
              pg8::gemm_phase<pg8::EpiQK>(F.lds, F.wave_s, g, S, E); }
            { pg8::Gemm g{Wqkv + (size_t)2048 * 1024, H, DM, DM, DM, 0};
              pg8::StaticOrder S; S.init(DM, T, F.G, (F.bid + (F.G >> 1)) % F.G);
              pg8::EpiVt E{Vtb, TA, kind == 2 ? args.in[16] + 2048 : zeros};
              pg8::gemm_phase<pg8::EpiVt>(F.lds, F.wave_s, g, S, E); }
            GSYNC();
            if (kind == 1) {
                const float lam_init = 0.8f - 0.6f * expf(-0.3f * (float)layer);
                for (int rep = 0; rep < REP_DIFF; ++rep) diff_attn_phase(F, Qb, Kb, Vtb, H, args.in[12] + (size_t)jj * 256, args.in[13] + (size_t)jj * 128, lam_init, ctx_after);
            } else {
                for (int rep = 0; rep < REP_NAT; ++rep) nat_attn_phase(F, Qb, Kb, Vtb, H, args.in[17] + (size_t)jj * 16 * 15 * 31, ctx_after);
            }
            GSYNC();
            { pg8::Gemm g{H, (const bf16_t*)(ws + WS_WO) + (size_t)(kind - 1) * 1024 * 1024, DM, DM, DM, 0};
              pg8::StaticOrder S; S.init(Tp, DM, F.G, F.bid);
              pg8::EpiResid E{X, modL + 5 * 1024, kind == 2 ? args.in[19] + (size_t)jj * DM : zeros, ones};
              pg8::gemm_phase<pg8::EpiResid>(F.lds, F.wave_s, g, S, E); }
            GSYNC();
        }

        normmod_phase(F, X, Tp, ng + 2 * DM, modL, 6, 7, H, nullptr, zeros);
        GSYNC();
        { pg8::Gemm g{H, (const bf16_t*)(ws + WS_WIN) + (size_t)(layer * 2 + 1) * 5632 * 1024, DM, DM, DM, 0};
          pg8::StaticOrder S; S.init(Tp, 5632, F.G, F.bid);
          pg8::EpiSwiglu E{HID, DFF};
          for (int rep = 0; rep < REP_G1; ++rep) pg8::gemm_phase<pg8::EpiSwiglu>(F.lds, F.wave_s, g, S, E); }
        GSYNC();
        { const bf16_t* Wt = (const bf16_t*)(ws + WS_WOUT) + (size_t)(layer * 2 + 1) * 1024 * DFF;
          { pg8::Gemm g{HID, Wt, DFF, DFF, DFF, 0};
            pg8::StaticOrder S; S.init(TL, DM, F.G, F.bid);
            pg8::EpiResid E{X, modL + 8 * 1024, zeros, halves};
            pg8::gemm_phase<pg8::EpiResid>(F.lds, F.wave_s, g, S, E); }
          if (Tp > TL) {
            pg8::Gemm g{HID, Wt, DFF, DFF, 256, 0};
            pg8::StaticOrder S; S.init(TC, 44 * 256, F.G, F.bid, 128);
            pg8::EpiPartial E{PART, 11 * DM};
            pg8::gemm_phase<pg8::EpiPartial, 4, 512>(F.lds, F.wave_s, g, S, E); } }
        GSYNC();
    }
    final_norm_phase(F, X, args.in[20], args.out);
}

extern "C" void kernel_launch(void* const* d_in, const int* in_sizes, int n_in, void* d_out, int out_size, void* d_ws, size_t ws_size, hipStream_t stream) {
    static int grid = 0;
    if (grid == 0) {
        if (n_in != 21 || ws_size < WS_END) { fprintf(stderr, "kernel_launch: unexpected inputs (n_in %d, ws %zu)\n", n_in, ws_size); grid = -1; return; }
        int dev = 0, cus = 0, per_cu = 0;
        hipGetDevice(&dev);
        hipDeviceGetAttribute(&cus, hipDeviceAttributeMultiprocessorCount, dev);
        hipFuncSetAttribute((const void*)fwd_megakernel, hipFuncAttributeMaxDynamicSharedMemorySize, LDS_BYTES);
        hipOccupancyMaxActiveBlocksPerMultiprocessor(&per_cu, (const void*)fwd_megakernel, 512, LDS_BYTES);
        if (per_cu < 1) per_cu = 1;
        grid = cus * per_cu;
        if (grid > 256) grid = 256;
        grid &= ~7;
        (void)hipGetLastError();
    }
    if (grid <= 0) return;
    Args a{};
    for (int i = 0; i < 21; ++i) a.in[i] = (const float*)d_in[i];
    a.out = (float*)d_out; a.ws = (unsigned char*)d_ws;
    void* kargs[] = {&a};
    hipError_t e = hipLaunchCooperativeKernel((const void*)fwd_megakernel, dim3(grid), dim3(512), kargs, LDS_BYTES, stream);
    if (e != hipSuccess) fprintf(stderr, "cooperative launch failed: %s (grid %d)\n", hipGetErrorString(e), grid);
}
```
